# Optimizing an MI355X kernel written in HIP

```python
import math
import jax, jax.numpy as jnp
from jax import lax
import numpy as np

D_MODEL = 1024
BATCH = 4
SEQ = 4096
DEPTH = 4

HEAD_DIM = 64
Q_BLOCK = 128
RMS_EPS = 1e-6
NEG_INF = -1e30
A_HEADS = 8
A_LATENT = 256
IDX_HEADS = 8
IDX_DIM = 64
TOPK_MAX = 256
B_HEADS = 4
C_HEADS = 16
REL_BUCKETS = 32
REL_MAX_DIST = 128
REL_HEADS = A_HEADS + B_HEADS
PEER_HEADS = 8
PEER_QDIM = 256
PEER_NKEYS = 128
PEER_EXPERTS = PEER_NKEYS * PEER_NKEYS
PEER_TOPK = 16
PEER_CHUNK = 128
EVEN_SIZES = (A_HEADS * HEAD_DIM, A_LATENT, IDX_HEADS * IDX_DIM, IDX_DIM, IDX_HEADS,
              B_HEADS * 2 * HEAD_DIM, B_HEADS * 2 * HEAD_DIM, B_HEADS * 2 * HEAD_DIM)
EVEN_IN = A_HEADS * HEAD_DIM + A_LATENT + IDX_HEADS * IDX_DIM + IDX_DIM + IDX_HEADS + 3 * B_HEADS * 2 * HEAD_DIM
EVEN_MIX = A_HEADS * HEAD_DIM + B_HEADS * 2 * HEAD_DIM
ODD_SIZES = (C_HEADS * HEAD_DIM, C_HEADS * HEAD_DIM, C_HEADS * HEAD_DIM, C_HEADS)
ODD_IN = 3 * C_HEADS * HEAD_DIM + C_HEADS
ODD_MIX = C_HEADS * HEAD_DIM

kernel_name = "hybrid_dsa_diff_fox_peer_trunk"


def rmsnorm(x, g):
    xf = x.astype(jnp.float32)
    y = xf * lax.rsqrt(jnp.mean(xf * xf, axis=-1, keepdims=True) + RMS_EPS)
    return (y * g.astype(jnp.float32)).astype(x.dtype)


def split_cols(p, sizes):
    points = np.cumsum(np.array(sizes))[:-1].tolist()
    return jnp.split(p, points, axis=-1)


def rel_bucket(dist):
    max_exact = REL_BUCKETS // 2
    d = jnp.maximum(dist, 0)
    df = jnp.maximum(d, 1).astype(jnp.float32)
    large = max_exact + (jnp.log(df / max_exact) / math.log(REL_MAX_DIST / max_exact)
                         * (REL_BUCKETS - max_exact)).astype(jnp.int32)
    large = jnp.minimum(large, REL_BUCKETS - 1)
    return jnp.where(d < max_exact, d, large)


def sweep_blocks(fn, batch, seq_len):
    n = seq_len // Q_BLOCK
    out = lax.map(fn, jnp.arange(n, dtype=jnp.int32) * Q_BLOCK)
    out = jnp.moveaxis(out, 0, 1)
    return out.reshape((batch, seq_len) + out.shape[3:])


def dsa_attention(q, ckv, q_idx, k_idx, w_idx, w_uk, w_uv, bias_a):
    B, S = q.shape[0], q.shape[1]
    topk = min(TOPK_MAX, S // 4)
    key_pos = jnp.arange(S, dtype=jnp.int32)
    scale = HEAD_DIM ** -0.5
    idx_scale = IDX_DIM ** -0.5
    q_lat = jnp.einsum('bthd,chd->bthc', q, w_uk)

    def block(start):
        qpos = start + jnp.arange(Q_BLOCK, dtype=jnp.int32)
        qi = lax.dynamic_slice_in_dim(q_idx, start, Q_BLOCK, axis=1)
        wi = lax.dynamic_slice_in_dim(w_idx, start, Q_BLOCK, axis=1)
        ql = lax.dynamic_slice_in_dim(q_lat, start, Q_BLOCK, axis=1)
        li = jnp.einsum('bthd,bsd->bths', qi, k_idx).astype(jnp.float32) * idx_scale
        iscore = jnp.einsum('bths,bth->bts', jax.nn.relu(li), wi.astype(jnp.float32))
        causal = key_pos[None, :] <= qpos[:, None]
        iscore = jnp.where(causal[None], iscore, -jnp.inf)
        _, sel = lax.top_k(iscore, topk)
        kv_sel = jax.vmap(lambda lat, ix: lat[ix])(ckv, sel)
        dist = qpos[None, :, None] - sel
        s = jnp.einsum('bthc,btkc->bthk', ql, kv_sel).astype(jnp.float32) * scale
        s = s + jnp.moveaxis(bias_a[rel_bucket(dist)], -1, 2).astype(jnp.float32)
        s = jnp.where((dist >= 0)[:, :, None, :], s, NEG_INF)
        p = jax.nn.softmax(s, axis=-1).astype(ckv.dtype)
        o_lat = jnp.einsum('bthk,btkc->bthc', p, kv_sel)
        o = jnp.einsum('bthc,chd->bthd', o_lat, w_uv)
        return o.reshape(B, Q_BLOCK, A_HEADS * HEAD_DIM)

    return sweep_blocks(block, B, S)


def diff_attention(q1, q2, k1, k2, v, lam, lam_init, subln_g, bias_b):
    B, S = q1.shape[0], q1.shape[1]
    key_pos = jnp.arange(S, dtype=jnp.int32)
    scale = HEAD_DIM ** -0.5

    def block(start):
        qpos = start + jnp.arange(Q_BLOCK, dtype=jnp.int32)
        causal = key_pos[None, :] <= qpos[:, None]
        bias = jnp.moveaxis(bias_b[rel_bucket(qpos[:, None] - key_pos[None, :])], -1, 0)
        bias = bias.astype(jnp.float32)

        def probs(q, k):
            qb = lax.dynamic_slice_in_dim(q, start, Q_BLOCK, axis=1)
            s = jnp.einsum('bthd,bshd->bhts', qb, k).astype(jnp.float32) * scale + bias
            return jax.nn.softmax(jnp.where(causal, s, NEG_INF), axis=-1)

        a = probs(q1, k1) - lam * probs(q2, k2)
        return jnp.einsum('bhts,bshe->bthe', a.astype(v.dtype), v)

    o = sweep_blocks(block, B, S)
    o = rmsnorm(o, subln_g) * (1.0 - lam_init)
    return o.reshape(B, S, B_HEADS * 2 * HEAD_DIM)


def forgetting_attention(q, k, v, f_logit):
    B, S = q.shape[0], q.shape[1]
    key_pos = jnp.arange(S, dtype=jnp.int32)
    scale = HEAD_DIM ** -0.5
    cum = jnp.moveaxis(jnp.cumsum(jax.nn.log_sigmoid(f_logit.astype(jnp.float32)), axis=1), -1, 1)

    def block(start):
        qpos = start + jnp.arange(Q_BLOCK, dtype=jnp.int32)
        causal = key_pos[None, :] <= qpos[:, None]
        qb = lax.dynamic_slice_in_dim(q, start, Q_BLOCK, axis=1)
        cq = lax.dynamic_slice_in_dim(cum, start, Q_BLOCK, axis=2)
        s = jnp.einsum('bthd,bshd->bhts', qb, k).astype(jnp.float32) * scale
        s = s + cq[..., :, None] - cum[..., None, :]
        p = jax.nn.softmax(jnp.where(causal, s, NEG_INF), axis=-1).astype(v.dtype)
        return jnp.einsum('bhts,bshd->bthd', p, v)

    return sweep_blocks(block, B, S).reshape(B, S, C_HEADS * HEAD_DIM)


def even_mixer(h, w_in, w_out, kv_norm, w_uk, w_uv, lam_vec, subln_g, rel_bias, lam_init):
    B, S, _ = h.shape
    q_a, ckv, q_i, k_i, w_i, q_b, k_b, v_b = split_cols(h @ w_in, EVEN_SIZES)
    q_a = q_a.reshape(B, S, A_HEADS, HEAD_DIM)
    ckv = rmsnorm(ckv, kv_norm)
    q_i = q_i.reshape(B, S, IDX_HEADS, IDX_DIM)
    w_i = w_i * (IDX_HEADS ** -0.5)
    o_a = dsa_attention(q_a, ckv, q_i, k_i, w_i, w_uk, w_uv, rel_bias[:, :A_HEADS])
    q_b = q_b.reshape(B, S, B_HEADS, 2, HEAD_DIM)
    k_b = k_b.reshape(B, S, B_HEADS, 2, HEAD_DIM)
    v_b = v_b.reshape(B, S, B_HEADS, 2 * HEAD_DIM)
    lv = lam_vec.astype(jnp.float32)
    lam = jnp.exp(jnp.sum(lv[0] * lv[1])) - jnp.exp(jnp.sum(lv[2] * lv[3])) + lam_init
    o_b = diff_attention(q_b[..., 0, :], q_b[..., 1, :], k_b[..., 0, :], k_b[..., 1, :],
                         v_b, lam, lam_init, subln_g, rel_bias[:, A_HEADS:])
    return jnp.concatenate([o_a, o_b], axis=-1) @ w_out


def odd_mixer(h, w_in, b_forget, w_out):
    B, S, _ = h.shape
    q, k, v, f = split_cols(h @ w_in, ODD_SIZES)
    shp = (B, S, C_HEADS, HEAD_DIM)
    o = forgetting_attention(q.reshape(shp), k.reshape(shp), v.reshape(shp), f + b_forget)
    return o @ w_out


def peer_ffn(h, w_q, sub_keys, u, v):
    B, S, D = h.shape
    T = B * S
    ht = h.reshape(T, D)
    q = (ht @ w_q).reshape(T, PEER_HEADS, 2, PEER_QDIM // 2)
    s = jnp.einsum('thpd,pnd->thpn', q, sub_keys).astype(jnp.float32)
    top_s, top_i = lax.top_k(s, PEER_TOPK)
    cand_s = top_s[:, :, 0, :, None] + top_s[:, :, 1, None, :]
    cand_i = top_i[:, :, 0, :, None] * PEER_NKEYS + top_i[:, :, 1, None, :]
    best_s, best_j = lax.top_k(cand_s.reshape(T, PEER_HEADS, -1), PEER_TOPK)
    experts = jnp.take_along_axis(cand_i.reshape(T, PEER_HEADS, -1), best_j, axis=-1)
    gates = jax.nn.softmax(best_s, axis=-1)
    n_chunks = T // PEER_CHUNK
    hk = PEER_HEADS * PEER_TOPK

    def chunk(args):
        xc, ec, gc = args
        act = jax.nn.gelu(jnp.einsum('cd,ced->ce', xc, u[ec]))
        return jnp.einsum('ce,ced->cd', gc.astype(xc.dtype) * act, v[ec])

    out = lax.map(chunk, (ht.reshape(n_chunks, PEER_CHUNK, D),
                          experts.reshape(n_chunks, PEER_CHUNK, hk),
                          gates.reshape(n_chunks, PEER_CHUNK, hk)))
    return out.reshape(B, S, D)


def setup_inputs(seed: int = 0) -> dict:
    key = jax.random.key(seed)
    ks = jax.random.split(key, 24)
    n_even = (DEPTH + 1) // 2
    n_odd = DEPTH // 2

    def nrm(k, shape, scale):
        return jax.random.normal(k, shape, jnp.float32) * scale

    return {
        "x": nrm(ks[0], (BATCH, SEQ, D_MODEL), 1.0),
        "c": nrm(ks[1], (BATCH, D_MODEL), 1.0),
        "rel_bias": nrm(ks[2], (REL_BUCKETS, REL_HEADS), 0.5),
        "ada_w": nrm(ks[3], (DEPTH, D_MODEL, 6 * D_MODEL), 0.5 * D_MODEL ** -0.5),
        "ada_b": nrm(ks[4], (DEPTH, 6 * D_MODEL), 0.02),
        "norm_mix": 1.0 + nrm(ks[5], (DEPTH, D_MODEL), 0.02),
        "norm_ffn": 1.0 + nrm(ks[6], (DEPTH, D_MODEL), 0.02),
        "norm_final": 1.0 + nrm(ks[7], (D_MODEL,), 0.02),
        "even_w_in": nrm(ks[8], (n_even, D_MODEL, EVEN_IN), D_MODEL ** -0.5),
        "even_w_out": nrm(ks[9], (n_even, EVEN_MIX, D_MODEL), EVEN_MIX ** -0.5),
        "a_kv_norm": 1.0 + nrm(ks[10], (n_even, A_LATENT), 0.02),
        "a_w_uk": nrm(ks[11], (n_even, A_LATENT, A_HEADS, HEAD_DIM), A_LATENT ** -0.5),
        "a_w_uv": nrm(ks[12], (n_even, A_LATENT, A_HEADS, HEAD_DIM), A_LATENT ** -0.5),
        "b_lambda": nrm(ks[13], (n_even, 4, HEAD_DIM), 0.1),
        "b_subln": 1.0 + nrm(ks[14], (n_even, 2 * HEAD_DIM), 0.02),
        "odd_w_in": nrm(ks[15], (n_odd, D_MODEL, ODD_IN), D_MODEL ** -0.5),
        "odd_b_forget": 2.0 + nrm(ks[16], (n_odd, C_HEADS), 0.5),
        "odd_w_out": nrm(ks[17], (n_odd, ODD_MIX, D_MODEL), ODD_MIX ** -0.5),
        "peer_w_q": nrm(ks[18], (DEPTH, D_MODEL, PEER_HEADS * PEER_QDIM), D_MODEL ** -0.5),
        "peer_sub_keys": nrm(ks[19], (DEPTH, 2, PEER_NKEYS, PEER_QDIM // 2), (PEER_QDIM // 2) ** -0.5),
        "peer_u": nrm(ks[20], (DEPTH, PEER_EXPERTS, D_MODEL), D_MODEL ** -0.5),
        "peer_v": nrm(ks[21], (DEPTH, PEER_EXPERTS, D_MODEL), PEER_HEADS ** -0.5),
    }


def reference(x, c, rel_bias, ada_w, ada_b, norm_mix, norm_ffn, norm_final,
              even_w_in, even_w_out, a_kv_norm, a_w_uk, a_w_uv, b_lambda, b_subln,
              odd_w_in, odd_b_forget, odd_w_out,
              peer_w_q, peer_sub_keys, peer_u, peer_v):
    c_act = jax.nn.silu(c)
    for layer in range(DEPTH):
        mod = (c_act @ ada_w[layer] + ada_b[layer])[:, None, :]
        sh1, sc1, g1, sh2, sc2, g2 = jnp.split(mod, 6, axis=-1)
        h = rmsnorm(x, norm_mix[layer]) * (1.0 + sc1) + sh1
        if layer % 2 == 0:
            e = layer // 2
            lam_init = 0.8 - 0.6 * math.exp(-0.3 * layer)
            y = even_mixer(h, even_w_in[e], even_w_out[e], a_kv_norm[e], a_w_uk[e], a_w_uv[e],
                           b_lambda[e], b_subln[e], rel_bias, lam_init)
        else:
            o = layer // 2
            y = odd_mixer(h, odd_w_in[o], odd_b_forget[o], odd_w_out[o])
        x = x + g1 * y
        h = rmsnorm(x, norm_ffn[layer]) * (1.0 + sc2) + sh2
        x = x + g2 * peer_ffn(h, peer_w_q[layer], peer_sub_keys[layer], peer_u[layer], peer_v[layer])
    return rmsnorm(x, norm_final)
```

```cpp
#include <hip/hip_runtime.h>
#include <hip/hip_bf16.h>
#include <cstdio>
#include <cstdint>
#include <cmath>
namespace pg8 {
#define PG8_LAS __attribute__((address_space(3)))
typedef unsigned short bf16_t;
typedef short bf16x8 __attribute__((ext_vector_type(8)));
typedef float f32x4 __attribute__((ext_vector_type(4)));
typedef unsigned u32x4 __attribute__((ext_vector_type(4)));
constexpr int BM = 256, BK = 64, HALF = 128, HTB = HALF * BK * 2  , STAGE_BYTES = 8 * HTB, NXCD = 8, WGM = 8;

__host__ __device__ __forceinline__ int lds_byte(int r, int c) { const int st = (r >> 4) * 2 + (c >> 5), rr = r & 15, cc = c & 31, ob = rr * 64 + cc * 2; return st * 1024 + (ob ^ (((ob >> 9) & 1) << 5)); }
__host__ __device__ __forceinline__ void stage_rc(int b, int& R, int& C) { const int st = b / 1024, sb = b % 1024, swz = sb ^ (((sb >> 9) & 1) << 5); R = (st >> 1) * 16 + swz / 64; C = (st & 1) * 32 + (swz % 64) / 2; }
__host__ __device__ __forceinline__ int perm32(int rho) { const int n = rho >> 4, i = rho & 15; return 8 * (i >> 2) + 4 * n + (i & 3); }

struct Unit { int pm, pn; };
struct Gemm { const bf16_t* A; const bf16_t* Bt; int M, N, K; };

struct StaticOrder {
    int nM, nN, nwg, G, c;
    __host__ __device__ void init(int M, int N, int G_, int c_) { nM = M / BM; nN = N / BM; nwg = nM * nN; G = G_; c = c_; }
    __host__ __device__ bool next(int i, Unit& u) const {
        const long L = (long)i * G + c; if (L >= nwg) return false;
        int wgid = (int)L; { const int q = nwg / NXCD, r = nwg % NXCD, xcd = wgid % NXCD, off = wgid / NXCD; wgid = (xcd < r ? xcd * (q + 1) : r * (q + 1) + (xcd - r) * q) + off; }
        const int nig = WGM * nN, gid = wgid / nig, fm = gid * WGM, gsz = (nM - fm) < WGM ? (nM - fm) : WGM;
        u.pm = fm + ((wgid % nig) % gsz); u.pn = (wgid % nig) / gsz; return true;
    }
    __device__ __forceinline__ void a_ready(const Unit&) const {}
    __device__ __forceinline__ void done(const Unit&) const {}
};

__device__ __forceinline__ unsigned cvt_pk_bf16(float lo, float hi) { unsigned r; asm volatile("v_cvt_pk_bf16_f32 %0, %1, %2" : "=v"(r) : "v"(lo), "v"(hi)); return r; }
typedef float f32x2 __attribute__((ext_vector_type(2)));
__device__ __forceinline__ f32x2 gelu_pk(f32x2 v) {
    const f32x2 av = __builtin_elementwise_abs(v), d = av * 0.2316418882f + 1.0f;
    f32x2 t; t.x = __builtin_amdgcn_rcpf(d.x); t.y = __builtin_amdgcn_rcpf(d.y);
    f32x2 q = t * 0.5307027145f + (-0.7265760135f); q = q * t + 0.7107068705f; q = q * t + (-0.142248368f); q = q * t + 0.127414796f; q = q * t;
    const f32x2 s = (v * v) * (-0.72134752044f);
    f32x2 e; e.x = __builtin_amdgcn_exp2f(s.x); e.y = __builtin_amdgcn_exp2f(s.y);
    const f32x2 m = v * (q * e), r = v - m;
    f32x2 o; o.x = v.x < 0.f ? m.x : r.x; o.y = v.y < 0.f ? m.y : r.y; return o;
}

template <int ACT  > struct EpiBf16 {
    static constexpr bool PERM = true, AFTER_DRAIN = false; static_assert(ACT == 0 || ACT == 1, "EpiBf16: ACT is 0 (none) or 1 (gelu_pk)");
    bf16_t* O; int ldc; const float* bias; int split_cols; size_t split_stride; float scale0;
    __device__ __forceinline__ void operator()(const f32x4 (&acc)[2][2][4][2], const Unit& u, int wr, int wc, int fr, int fq) const {
        const int row0 = u.pm * BM + wr * 64 + fr; int colt = u.pn * BM; bf16_t* base = O;
        float sc = 1.f; if (split_cols) { const int t = colt / split_cols; base += (size_t)t * split_stride; colt -= t * split_cols; if (t == 0) sc = scale0; }
        const int col0 = colt + wc * 32 + 8 * fq, bcol0 = u.pn * BM + wc * 32 + 8 * fq;
        f32x4 bv[2][2];
#pragma unroll
        for (int bj = 0; bj < 2; ++bj)
#pragma unroll
            for (int n = 0; n < 2; ++n) bv[bj][n] = bias ? *(const f32x4*)(bias + bcol0 + bj * HALF + 4 * n) : (f32x4){0.f, 0.f, 0.f, 0.f};
#pragma unroll
        for (int ai = 0; ai < 2; ++ai)
#pragma unroll
            for (int m = 0; m < 4; ++m) { bf16_t* rowp = base + (size_t)(row0 + ai * HALF + m * 16) * ldc + col0;
#pragma unroll
                for (int bj = 0; bj < 2; ++bj) { f32x4 v0 = acc[ai][bj][m][0] + bv[bj][0], v1 = acc[ai][bj][m][1] + bv[bj][1];
                    if (ACT == 1) { f32x2 a = gelu_pk((f32x2){v0[0], v0[1]}), b = gelu_pk((f32x2){v0[2], v0[3]}), c = gelu_pk((f32x2){v1[0], v1[1]}), d = gelu_pk((f32x2){v1[2], v1[3]});
                        v0 = (f32x4){a.x, a.y, b.x, b.y}; v1 = (f32x4){c.x, c.y, d.x, d.y}; }
                    v0 = v0 * sc; v1 = v1 * sc; u32x4 w; w.x = cvt_pk_bf16(v0[0], v0[1]); w.y = cvt_pk_bf16(v0[2], v0[3]); w.z = cvt_pk_bf16(v1[0], v1[1]); w.w = cvt_pk_bf16(v1[2], v1[3]);
                    *(u32x4*)(rowp + bj * HALF) = w; } }
    }
};
template <class Epi, class Sched, bool ALIGN_EPI = false, bool SP2 = false>
__device__ __forceinline__ void gemm_phase(PG8_LAS unsigned char* lds, const Gemm g, const Sched& S, const Epi& E) {
    int tid_ = threadIdx.x; asm volatile("" : "+v"(tid_)); const int tid = tid_, wid = __builtin_amdgcn_readfirstlane(tid >> 6), lane = tid & 63, wr = wid >> 2, wc = wid & 3, fr = lane & 15, fq = lane >> 4;
    const int K = g.K, nt = K / BK;
    unsigned voffA[2], voffB[2];
#pragma unroll
    for (int i = 0; i < 2; ++i) { int R, C; stage_rc(tid * 16 + i * 8192, R, C); const int Rb = Epi::PERM ? ((R & ~31) + perm32(R & 31)) : R;
        voffA[i] = (unsigned)(R * K + C) * 2u; voffB[i] = (unsigned)(Rb * K + C) * 2u; }
    const size_t kstep = (size_t)(BK * 2);
    const size_t hstep = (size_t)HALF * K * 2;
    const size_t tstep = 2 * hstep;
    const unsigned ldsw = (unsigned)wid * 1024u;
    const int aoff = lds_byte(wr * 64 + fr, fq * 8), boff = lds_byte(wc * 32 + fr, fq * 8);
#define PG8_SA(b, h) (((b) * 2 + (h)) * HTB)
#define PG8_SB(b, h) ((4 + (b) * 2 + (h)) * HTB)
#define PG8_STAGE(bufoff, gbase, voff) do { _Pragma("unroll") for (int _i = 0; _i < 2; ++_i) \
        __builtin_amdgcn_global_load_lds((const unsigned*)((const char*)(gbase) + (voff)[_i]), (PG8_LAS unsigned*)(lds + (bufoff) + ldsw + _i * 8192), 16, 0, 0); } while (0)
#define PG8_LDA(dst, b, h) do { _Pragma("unroll") for (int m = 0; m < 4; ++m) _Pragma("unroll") for (int k = 0; k < 2; ++k) dst[m][k] = *(const PG8_LAS bf16x8*)(lds + PG8_SA(b, h) + aoff + m * 2048 + k * 1024); } while (0)
#define PG8_LDB(dst, b, h) do { _Pragma("unroll") for (int n = 0; n < 2; ++n) _Pragma("unroll") for (int k = 0; k < 2; ++k) dst[n][k] = *(const PG8_LAS bf16x8*)(lds + PG8_SB(b, h) + boff + n * 2048 + k * 1024); } while (0)
#define PG8_MMA(ai, bj, At, Bt) do { __builtin_amdgcn_s_setprio(1); _Pragma("unroll") for (int m = 0; m < 4; ++m) _Pragma("unroll") for (int n = 0; n < 2; ++n) _Pragma("unroll") for (int k = 0; k < 2; ++k) \
        acc[ai][bj][m][n] = __builtin_amdgcn_mfma_f32_16x16x32_bf16(Bt[n][k], At[m][k], acc[ai][bj][m][n], 0, 0, 0); __builtin_amdgcn_s_setprio(0); } while (0)
#define PG8_WAIT_V(n) asm volatile("s_waitcnt vmcnt(" #n ")" ::: "memory")
#define PG8_WAIT_L(n) asm volatile("s_waitcnt lgkmcnt(" #n ")" ::: "memory")
#define PG8_BAR __builtin_amdgcn_s_barrier()
#define PG8_SCHED __builtin_amdgcn_sched_barrier(0)
    Unit cur, nxt; int ui = 0;
    if (!S.next(0, cur)) return;
    f32x4 acc[2][2][4][2];
#pragma unroll
    for (int a = 0; a < 2; ++a)
#pragma unroll
        for (int b = 0; b < 2; ++b)
#pragma unroll
            for (int m = 0; m < 4; ++m)
#pragma unroll
                for (int n = 0; n < 2; ++n) acc[a][b][m][n] = (f32x4){0.f, 0.f, 0.f, 0.f};
    bf16x8 At[4][2], B0[2][2], B1[2][2];
    const char* cA = (const char*)g.A + (size_t)cur.pm * tstep; const char* cB = (const char*)g.Bt + (size_t)cur.pn * tstep;
    S.a_ready(cur);
    if constexpr (SP2) {
        PG8_STAGE(PG8_SB(0, 0), cB, voffB); PG8_STAGE(PG8_SB(0, 1), cB + hstep, voffB); PG8_STAGE(PG8_SA(0, 0), cA, voffA); PG8_STAGE(PG8_SA(0, 1), cA + hstep, voffA);
        if (wr == 1) PG8_BAR;
        PG8_WAIT_V(2); PG8_BAR;
        PG8_STAGE(PG8_SB(1, 0), cB + kstep, voffB); PG8_STAGE(PG8_SA(1, 0), cA + kstep, voffA); PG8_STAGE(PG8_SB(1, 1), cB + hstep + kstep, voffB);
        PG8_WAIT_V(6); PG8_BAR;
    } else {
        PG8_STAGE(PG8_SB(0, 0), cB, voffB); PG8_STAGE(PG8_SA(0, 0), cA, voffA); PG8_STAGE(PG8_SB(0, 1), cB + hstep, voffB); PG8_STAGE(PG8_SA(0, 1), cA + hstep, voffA);
        if (wr == 1) PG8_BAR;
        PG8_WAIT_V(4); PG8_BAR;
        PG8_STAGE(PG8_SB(1, 0), cB + kstep, voffB); PG8_STAGE(PG8_SA(1, 0), cA + kstep, voffA); PG8_STAGE(PG8_SB(1, 1), cB + hstep + kstep, voffB);
        PG8_WAIT_V(6); PG8_BAR;
    }
    for (;;) {
        const bool has_next = S.next(ui + 1, nxt);
        const char* nA = has_next ? (const char*)g.A + (size_t)nxt.pm * tstep : cA; const char* nB = has_next ? (const char*)g.Bt + (size_t)nxt.pn * tstep : cB;
        for (int t = 0; t < nt; t += 2) {
            const bool last = (t == nt - 2);
            const char* a1 = cA + (size_t)(t + 1) * kstep;
            const char* a2 = last ? nA : cA + (size_t)(t + 2) * kstep; const char* b2 = last ? nB : cB + (size_t)(t + 2) * kstep;
            const char* a3 = a2 + kstep; const char* b3 = b2 + kstep;
            if (last && has_next) S.a_ready(nxt);
            if constexpr (SP2) {
            PG8_LDB(B0, 0, 0); PG8_LDB(B1, 0, 1); PG8_SCHED; PG8_LDA(At, 0, 0); PG8_STAGE(PG8_SA(1, 1), a1 + hstep, voffA);
            PG8_WAIT_V(8); PG8_WAIT_L(0); PG8_BAR; PG8_MMA(0, 0, At, B0); PG8_MMA(0, 1, At, B1); PG8_BAR; PG8_SCHED;
            PG8_LDA(At, 0, 1); PG8_STAGE(PG8_SB(0, 0), b2, voffB); PG8_STAGE(PG8_SB(0, 1), b2 + hstep, voffB); PG8_STAGE(PG8_SA(0, 0), a2, voffA);
            PG8_WAIT_V(8); PG8_WAIT_L(0); PG8_BAR; PG8_MMA(1, 0, At, B0); PG8_MMA(1, 1, At, B1); PG8_BAR; PG8_SCHED;
            PG8_LDB(B0, 1, 0); PG8_LDB(B1, 1, 1); PG8_SCHED; PG8_LDA(At, 1, 0); PG8_STAGE(PG8_SA(0, 1), a2 + hstep, voffA);
            PG8_WAIT_V(8); PG8_WAIT_L(0); PG8_BAR; PG8_MMA(0, 0, At, B0); PG8_MMA(0, 1, At, B1); PG8_BAR; PG8_SCHED;
            PG8_LDA(At, 1, 1); PG8_STAGE(PG8_SB(1, 0), b3, voffB); PG8_STAGE(PG8_SB(1, 1), b3 + hstep, voffB); PG8_STAGE(PG8_SA(1, 0), a3, voffA);
            PG8_WAIT_V(8); PG8_WAIT_L(0); PG8_BAR; PG8_MMA(1, 0, At, B0); PG8_MMA(1, 1, At, B1); PG8_BAR; PG8_SCHED;
            } else {
            PG8_LDB(B0, 0, 0); PG8_SCHED; PG8_LDA(At, 0, 0); PG8_STAGE(PG8_SA(1, 1), a1 + hstep, voffA);
            PG8_WAIT_L(8); PG8_BAR; PG8_WAIT_L(0); PG8_MMA(0, 0, At, B0); PG8_BAR; PG8_SCHED;
            PG8_LDB(B1, 0, 1); PG8_STAGE(PG8_SB(0, 0), b2, voffB);
            PG8_BAR; PG8_WAIT_L(0); PG8_MMA(0, 1, At, B1); PG8_BAR;
            PG8_LDA(At, 0, 1); PG8_STAGE(PG8_SA(0, 0), a2, voffA);
            PG8_BAR; PG8_WAIT_L(0); PG8_MMA(1, 0, At, B0); PG8_BAR; PG8_SCHED;
            PG8_STAGE(PG8_SB(0, 1), b2 + hstep, voffB);
            PG8_WAIT_V(6); PG8_BAR; PG8_MMA(1, 1, At, B1); PG8_BAR;
            PG8_LDB(B0, 1, 0); PG8_SCHED; PG8_LDA(At, 1, 0); PG8_STAGE(PG8_SA(0, 1), a2 + hstep, voffA);
            PG8_WAIT_L(8); PG8_BAR; PG8_WAIT_L(0); PG8_MMA(0, 0, At, B0); PG8_BAR; PG8_SCHED;
            PG8_LDB(B1, 1, 1); PG8_STAGE(PG8_SB(1, 0), b3, voffB);
            PG8_BAR; PG8_WAIT_L(0); PG8_MMA(0, 1, At, B1); PG8_BAR;
            PG8_LDA(At, 1, 1); PG8_STAGE(PG8_SA(1, 0), a3, voffA);
            PG8_BAR; PG8_WAIT_L(0); PG8_MMA(1, 0, At, B0); PG8_BAR; PG8_SCHED;
            PG8_STAGE(PG8_SB(1, 1), b3 + hstep, voffB);
            PG8_WAIT_V(6); PG8_BAR; PG8_MMA(1, 1, At, B1); PG8_BAR;
            }
        }
        if constexpr (ALIGN_EPI) { if (wr == 0) PG8_BAR; }
        if constexpr (!Epi::AFTER_DRAIN) { E(acc, cur, wr, wc, fr, fq); S.done(cur); }
        if (!has_next) break;
#pragma unroll
        for (int a = 0; a < 2; ++a)
#pragma unroll
            for (int b = 0; b < 2; ++b)
#pragma unroll
                for (int m = 0; m < 4; ++m)
#pragma unroll
                    for (int n = 0; n < 2; ++n) acc[a][b][m][n] = (f32x4){0.f, 0.f, 0.f, 0.f};
        cur = nxt; cA = nA; cB = nB; ++ui;
        if constexpr (ALIGN_EPI) { if (wr == 1) PG8_BAR; }
    }
    PG8_WAIT_V(0);
    if constexpr (!ALIGN_EPI) { if (wr == 0) PG8_BAR; }
    PG8_BAR;
    if constexpr (Epi::AFTER_DRAIN) { E.fused(acc, cur, wr, wc, fr, fq, lds, wid, lane); S.done(cur); }
#undef PG8_SA
#undef PG8_SB
#undef PG8_STAGE
#undef PG8_LDA
#undef PG8_LDB
#undef PG8_MMA
#undef PG8_WAIT_V
#undef PG8_WAIT_L
#undef PG8_BAR
#undef PG8_SCHED
}
}
#define GAS __attribute__((address_space(1)))
#define LAS __attribute__((address_space(3)))
typedef unsigned short bf16;
typedef unsigned v4u __attribute__((ext_vector_type(4)));
typedef float f32x4 __attribute__((ext_vector_type(4)));
typedef short bf16x8 __attribute__((ext_vector_type(8)));
typedef GAS unsigned gu32;
typedef GAS unsigned long long gu64;
#define RLX_AGENT __ATOMIC_RELAXED, __HIP_MEMORY_SCOPE_AGENT
#define LDS_WAIT() asm volatile("s_waitcnt lgkmcnt(0)" ::: "memory")
#define VM_WAIT() asm volatile("s_waitcnt vmcnt(0)" ::: "memory")
__device__ __forceinline__ unsigned long long rt() { return __builtin_amdgcn_s_memrealtime(); }
__device__ __forceinline__ unsigned f2bf(float f) { unsigned u = __builtin_bit_cast(unsigned, f); return (u + 0x7fffu + ((u >> 16) & 1u)) >> 16; }
__device__ __forceinline__ unsigned pk2(float lo, float hi) { return f2bf(lo) | (f2bf(hi) << 16); }

#define XB_TMO      128
#define XB_XCNT(j)  (256  + 64 * (j))
#define XB_XSUB(j)  (1280 + 64 * (j))
#define XB_XGEN(j)  (2304 + 64 * (j))
#define XB_TOP      3328
#define XB_TOPGEN   3392
#define XCD_BAR_WORDS 3456
#define XB_SPIN_CAP (1u << 18)

__device__ __forceinline__ unsigned xb_ld(unsigned* p)              { return __hip_atomic_load(p, __ATOMIC_RELAXED, __HIP_MEMORY_SCOPE_AGENT); }
__device__ __forceinline__ unsigned xb_add(unsigned* p, unsigned v) { return __hip_atomic_fetch_add(p, v, __ATOMIC_RELAXED, __HIP_MEMORY_SCOPE_AGENT); }
__device__ __forceinline__ unsigned xb_xcc_id() { return (unsigned)__builtin_amdgcn_s_getreg((3 << 11) | 20) & 0xFu; }
#define XB_SPIN(cond, bar) do { unsigned _sp = 0; while (cond) { __builtin_amdgcn_s_sleep(1); \
    if ((++_sp & 255u) == 0u) { if (xb_ld(&(bar)[XB_TMO])) break; if (_sp > XB_SPIN_CAP) { atomicAdd(&(bar)[XB_TMO], 1u); break; } } } } while (0)

struct XcdBarrier {
    unsigned* bar; unsigned x;
    volatile LAS unsigned* st;
};

__device__ __forceinline__ XcdBarrier xcd_barrier_post(unsigned* bar, volatile LAS unsigned* st) {
    XcdBarrier b; b.bar = bar; b.x = xb_xcc_id(); b.st = st;
    if (threadIdx.x == 0) (void)xb_add(&bar[XB_XCNT(b.x)], 1u);
    return b;
}
__device__ __forceinline__ void xcd_barrier_complete(unsigned* bar, unsigned x, unsigned& nloc, unsigned& nx) {
    const unsigned G = gridDim.x * gridDim.y * gridDim.z;
    unsigned sum, cnt, mine, sp = 0u;
    for (;;) {
        sum = 0u; cnt = 0u; mine = 0u;
#pragma unroll
        for (unsigned j = 0; j < 16; ++j) { const unsigned c = xb_ld(&bar[XB_XCNT(j)]); sum += c; cnt += (c > 0u) ? 1u : 0u; mine = (j == x) ? c : mine; }
        if (sum == G) break;
        __builtin_amdgcn_s_sleep(1);
        if ((++sp & 255u) == 0u) { if (xb_ld(&bar[XB_TMO])) break; if (sp > XB_SPIN_CAP) { atomicAdd(&bar[XB_TMO], 1u); break; } }
    }
    nloc = mine > 0u ? mine : 1u; nx = cnt > 0u ? cnt : 1u;
}

__device__ __forceinline__ void xcd_barrier(const XcdBarrier& b) {
    asm volatile("s_waitcnt vmcnt(0)" ::: "memory");
    __syncthreads();
    if (threadIdx.x == 0) {
        unsigned* bar = b.bar;
        __builtin_amdgcn_s_waitcnt(0);
        unsigned nloc = b.st[0], nx = b.st[1];
        if (nloc == 0u) { xcd_barrier_complete(bar, b.x, nloc, nx); b.st[0] = nloc; b.st[1] = nx; }
        const unsigned old = xb_add(&bar[XB_XSUB(b.x)], 1u);
        const unsigned gen = old / nloc;
        if (old + 1u == (gen + 1u) * nloc) {
            __builtin_amdgcn_fence(__ATOMIC_RELEASE, "agent");
            asm volatile("s_waitcnt vmcnt(0)" ::: "memory");
            const unsigned og = xb_add(&bar[XB_TOP], 1u);
            const unsigned tg = og / nx;
            if (og + 1u == (tg + 1u) * nx) xb_add(&bar[XB_TOPGEN], 1u);
            else XB_SPIN(xb_ld(&bar[XB_TOPGEN]) == tg, bar);
            __builtin_amdgcn_fence(__ATOMIC_ACQUIRE, "agent");
            xb_add(&bar[XB_XGEN(b.x)], 1u);
            asm volatile("s_waitcnt vmcnt(0)" ::: "memory");
        } else {
            XB_SPIN(xb_ld(&bar[XB_XGEN(b.x)]) == gen, bar);
            __builtin_amdgcn_fence(__ATOMIC_ACQUIRE, "agent");
            asm volatile("s_waitcnt vmcnt(0)" ::: "memory");
        }
    }
    __syncthreads();
}
constexpr int NB = 4, SEQ = 4096, T = NB * SEQ, DM = 1024, DEPTH = 4;
constexpr int NE = 4608, NO = 3328;
constexpr int EC_QLAT = 0, EC_CKV = 2048, EC_QI = 2304, EC_KI = 2816, EC_QB = 2880, EC_KB = 3392, EC_VB = 3904, EC_WI = 4416;
constexpr int OC_Q = 0, OC_K = 1024, OC_V = 2048, OC_F = 3072;
constexpr int KEO = 2560;
constexpr int EVEN_IN = 2888, ODD_IN = 3088;
constexpr float RMS_EPS = 1e-6f;
constexpr float LOG2E = 1.4426950408889634f;
constexpr float C2 = 0.125f * LOG2E;
constexpr int NWAVES = 8, NTHR = 512;

constexpr size_t MiB = 1u << 20;
constexpr size_t WS_CTL = 0, CTL_ZERO_BYTES = 1 * MiB;
constexpr size_t WS_MOD = 1 * MiB;
constexpr size_t WS_FCUM = 3 * MiB;
constexpr size_t WS_WEIN = 4 * MiB;
constexpr size_t WS_WOIN = 22 * MiB;
constexpr size_t WS_WEOUT = 35 * MiB;
constexpr size_t WS_WOOUT = 45 * MiB;
constexpr size_t WS_WPQ = 49 * MiB;
constexpr size_t WS_WSK = 65 * MiB;
constexpr size_t WS_PU = 66 * MiB, WS_PV = 98 * MiB;
constexpr size_t WS_X = 130 * MiB;
constexpr size_t WS_H = 194 * MiB;
constexpr size_t WS_P = 226 * MiB;
constexpr size_t WS_AO = 370 * MiB;
constexpr size_t WS_CKV = 450 * MiB;
constexpr size_t WS_SEL = 458 * MiB;
constexpr size_t WS_PE = 466 * MiB;
constexpr size_t WS_PG = 474 * MiB;
constexpr size_t WS_END = 482 * MiB;
constexpr int CW_BAR = 4096;

constexpr int RING_BYTES = 131072;
constexpr int LDS_BYTES = 163840;
constexpr int MISC_OFF = LDS_BYTES - 512;
constexpr int XTRA_OFF = RING_BYTES;

__device__ __constant__ unsigned char T5_BUCKET[128] = {
  0, 1, 2, 3, 4, 5, 6, 7, 8, 9, 10, 11, 12, 13, 14, 15, 16, 16, 16, 17, 17, 18, 18, 18, 19, 19, 19, 20, 20, 20, 20, 21, 21, 21, 21, 22, 22, 22, 22, 22,
  23, 23, 23, 23, 23, 23, 24, 24, 24, 24, 24, 24, 25, 25, 25, 25, 25, 25, 25, 26, 26, 26, 26, 26, 26, 26, 26, 27, 27, 27, 27, 27, 27, 27, 27, 27, 27,
  28, 28, 28, 28, 28, 28, 28, 28, 28, 28, 29, 29, 29, 29, 29, 29, 29, 29, 29, 29, 29, 29, 30, 30, 30, 30, 30, 30, 30, 30, 30, 30, 30, 30, 30, 30,
  31, 31, 31, 31, 31, 31, 31, 31, 31, 31, 31, 31, 31, 31, 31};
__device__ __forceinline__ int t5_bucket(int d) { return d >= 128 ? 31 : (int)T5_BUCKET[d]; }
typedef float f32x16 __attribute__((ext_vector_type(16)));
typedef short s16x4 __attribute__((ext_vector_type(4)));
typedef unsigned u32x2 __attribute__((ext_vector_type(2)));
typedef unsigned u32x4 __attribute__((ext_vector_type(4)));
typedef int i32x4 __attribute__((ext_vector_type(4)));
#define KAS __attribute__((address_space(4)))
struct Frame {
    LAS unsigned char* lds;
    volatile LAS unsigned* MISC;
    gu32* ctl;
    int tid, lane, wave;
    int vcu, G, vcu0;
    unsigned char* ws;
    const KAS char* ka; const KAS char* ka0;
    float* out;
    __device__ __forceinline__ const float* inp(int i) const { return *(const float* const KAS*)(ka + 8 * i); }
};
#define PHASE_BEGIN(F) do { const KAS char* ka_ = (F).ka0; asm volatile("" : "+s"(ka_)); (F).ka = ka_; (F).out = *(float* const KAS*)(ka_ + 176); (F).ws = *(unsigned char* const KAS*)(ka_ + 184); \
    (F).ctl = (gu32*)((F).ws + WS_CTL); int t_ = threadIdx.x; asm volatile("" : "+v"(t_)); (F).tid = t_; (F).lane = t_ & 63; (F).wave = __builtin_amdgcn_readfirstlane(t_ >> 6); \
    int v_ = (F).vcu0; asm volatile("" : "+s"(v_)); (F).vcu = v_; } while (0)
__device__ __forceinline__ float wave_sum(float v) {
#pragma unroll
    for (int o = 1; o < 64; o <<= 1) v += __shfl_xor(v, o);
    return v;
}
__device__ __forceinline__ float bf2f(unsigned h) { return __uint_as_float(h << 16); }
__device__ __forceinline__ float bflo(unsigned w) { return __uint_as_float(w << 16); }
__device__ __forceinline__ float bfhi(unsigned w) { return __uint_as_float(w & 0xffff0000u); }
__device__ __forceinline__ float siluf(float x) { return x / (1.f + __expf(-x)); }
__device__ __forceinline__ float gelu_tanh(float x) {
    const float u = 0.7978845608028654f * (x + 0.044715f * x * x * x);
    const float e = __expf(2.f * u);
    const float th = 1.f - 2.f / (e + 1.f);
    return 0.5f * x * (1.f + th);
}
enum { I_X = 0, I_C, I_RELB, I_ADAW, I_ADAB, I_NMIX, I_NFFN, I_NFIN, I_EWIN, I_EWOUT, I_KVN, I_WUK, I_WUV, I_LAM, I_SUBLN, I_OWIN, I_BF, I_OWOUT, I_PWQ, I_PSK, I_PU, I_PV };

__device__ __forceinline__ void tr_item(const float* W, int ldw, int sc0, int ncols, bf16* WT, int ldt, int dr0, int dc0, float scale, LAS float* scr, int kb, int nb, int lane) {
    const int k0 = 64 * kb, n0 = 32 * nb;
    const int nn = lane & 31; const bool ok = (n0 + nn) < ncols;
#pragma unroll 8
    for (int i = 0; i < 32; ++i) { const int kk = 2 * i + (lane >> 5); scr[kk * 33 + nn] = ok ? W[(size_t)(k0 + kk) * ldw + sc0 + n0 + nn] * scale : 0.f; }
    LDS_WAIT(); asm volatile("" ::: "memory");
    const int c = lane & 7;
#pragma unroll
    for (int j = 0; j < 4; ++j) { const int n = (lane >> 3) + 8 * j; const LAS float* s = scr + (8 * c) * 33 + n;
        v4u o; o.x = pk2(s[0 * 33], s[1 * 33]); o.y = pk2(s[2 * 33], s[3 * 33]); o.z = pk2(s[4 * 33], s[5 * 33]); o.w = pk2(s[6 * 33], s[7 * 33]);
        if (n0 + n < ncols) *(GAS v4u*)(WT + (size_t)(dr0 + n0 + n) * ldt + dc0 + k0 + 8 * c) = o; }
    LDS_WAIT(); asm volatile("" ::: "memory");
}
struct TrJob { const float* W; int ldw, sc0, ncols, K; bf16* WT; int ldt, dr0, dc0; float scale; };
__device__ __forceinline__ TrJob get_trjob(const Frame& F, int j) {
    TrJob J;
    if (j < 14) { const int e = j / 7, s = j % 7;
        const int sc0[7] = {512, 768, 1280, 1344, 1352, 1864, 2376}; const int nc[7] = {256, 512, 64, 8, 512, 512, 512};
        const int dr[7] = {EC_CKV, EC_QI, EC_KI, EC_WI, EC_QB, EC_KB, EC_VB}; const float sc[7] = {1.f, 0.125f, 1.f, 0.35355339059327373f, C2, 1.f, 1.f};
        int a = 0, b = 0, c = 0; float d = 1.f;
#pragma unroll
        for (int q = 0; q < 7; ++q) if (q == s) { a = sc0[q]; b = nc[q]; c = dr[q]; d = sc[q]; }
        J.W = F.inp(I_EWIN) + (size_t)e * DM * EVEN_IN; J.ldw = EVEN_IN; J.sc0 = a; J.ncols = b; J.K = DM; J.WT = (bf16*)(F.ws + WS_WEIN) + (size_t)e * NE * DM; J.ldt = DM; J.dr0 = c; J.dc0 = 0; J.scale = d;
    } else if (j < 22) { const int o = (j - 14) / 4, s = (j - 14) % 4;
        J.W = F.inp(I_OWIN) + (size_t)o * DM * ODD_IN; J.ldw = ODD_IN; J.sc0 = 1024 * s; J.ncols = (s == 3) ? 16 : 1024; J.K = DM; J.WT = (bf16*)(F.ws + WS_WOIN) + (size_t)o * NO * DM; J.ldt = DM; J.dr0 = 1024 * s; J.dc0 = 0; J.scale = (s == 0) ? C2 : 1.f;
    } else if (j < 24) { const int e = j - 22;
        J.W = F.inp(I_EWOUT) + (size_t)e * DM * DM + (size_t)512 * DM; J.ldw = DM; J.sc0 = 0; J.ncols = DM; J.K = 512; J.WT = (bf16*)(F.ws + WS_WEOUT) + (size_t)e * DM * KEO; J.ldt = KEO; J.dr0 = 0; J.dc0 = 2048; J.scale = 1.f;
    } else if (j < 26) { const int o = j - 24;
        J.W = F.inp(I_OWOUT) + (size_t)o * DM * DM; J.ldw = DM; J.sc0 = 0; J.ncols = DM; J.K = DM; J.WT = (bf16*)(F.ws + WS_WOOUT) + (size_t)o * DM * DM; J.ldt = DM; J.dr0 = 0; J.dc0 = 0; J.scale = 1.f;
    } else { const int l = j - 26;
        J.W = F.inp(I_PWQ) + (size_t)l * DM * 2048; J.ldw = 2048; J.sc0 = 0; J.ncols = 2048; J.K = DM; J.WT = (bf16*)(F.ws + WS_WPQ) + (size_t)l * 2048 * DM; J.ldt = DM; J.dr0 = 0; J.dc0 = 0; J.scale = 1.f;
    }
    return J;
}
constexpr int N_TRJOBS = 30;
__device__ __forceinline__ int trjob_items(int j) {
    if (j < 14) { const int s = j % 7; const int nb[7] = {8, 16, 2, 1, 16, 16, 16}; int r = 0;
#pragma unroll
        for (int q = 0; q < 7; ++q) if (q == s) r = nb[q]; return 16 * r; }
    if (j < 22) return 16 * (((j - 14) % 4 == 3) ? 1 : 32);
    if (j < 24) return 8 * 32;
    if (j < 26) return 16 * 32;
    return 16 * 64;
}
__device__ __forceinline__ void p0_transposes(Frame& F) { PHASE_BEGIN(F);
    LAS float* scr = (LAS float*)(F.lds + F.wave * 16384);
    const int gw = F.vcu * NWAVES + F.wave, NGW = F.G * NWAVES;
    int base = 0;
    for (int j = 0; j < N_TRJOBS; ++j) {
        const int ni = trjob_items(j);
        int it = ((gw - base) % NGW + NGW) % NGW;
        if (it < ni) { const TrJob J = get_trjob(F, j); const int nblk = (J.ncols + 31) / 32;
            for (; it < ni; it += NGW) tr_item(J.W, J.ldw, J.sc0, J.ncols, J.WT, J.ldt, J.dr0, J.dc0, J.scale, scr, it / nblk, it % nblk, F.lane); }
        base += ni;
    }
    const int gt = F.vcu * NTHR + F.tid, NGT = F.G * NTHR;
    for (int e = 0; e < 2; ++e) { GAS v4u* p = (GAS v4u*)((bf16*)(F.ws + WS_WEIN) + (size_t)e * NE * DM + (size_t)4424 * DM); const int n = (NE - 4424) * DM / 8;
        for (int i = gt; i < n; i += NGT) p[i] = (v4u){0u, 0u, 0u, 0u}; }
    for (int o = 0; o < 2; ++o) { GAS v4u* p = (GAS v4u*)((bf16*)(F.ws + WS_WOIN) + (size_t)o * NO * DM + (size_t)ODD_IN * DM); const int n = (NO - ODD_IN) * DM / 8;
        for (int i = gt; i < n; i += NGT) p[i] = (v4u){0u, 0u, 0u, 0u}; }
    { const float* s = F.inp(I_PSK); bf16* d = (bf16*)(F.ws + WS_WSK); const int n = DEPTH * 2 * 128 * 128 / 4;
        for (int i = gt; i < n; i += NGT) { const f32x4 v = *(const GAS f32x4*)(s + (size_t)i * 4); u32x2 w; w.x = pk2(v.x, v.y); w.y = pk2(v.z, v.w); *(GAS u32x2*)(d + (size_t)i * 4) = w; } }
}
template <int kind> __device__ __forceinline__ void p0_fused_weights_k(Frame& F) { PHASE_BEGIN(F);
    LAS float* At = (LAS float*)F.lds;
    for (int it = F.vcu; it < 256; it += F.G) {
        const int e = (it >> 7) & 1, h = (it >> 4) & 7, blk = it & 15;
        __syncthreads();
        if (kind == 0) {
            const float* W = F.inp(I_EWIN) + (size_t)e * DM * EVEN_IN;
            for (int i = F.tid; i < 4096; i += NTHR) { const int kk = i >> 6, d = i & 63; At[kk * 65 + d] = W[(size_t)(64 * blk + kk) * EVEN_IN + 64 * h + d]; }
        } else {
            const float* W = F.inp(I_EWOUT) + (size_t)e * DM * DM;
            for (int i = F.tid; i < 4096; i += NTHR) { const int d = i >> 6, nn = i & 63; At[nn * 65 + d] = W[(size_t)(64 * h + d) * DM + 64 * blk + nn]; }
        }
        __syncthreads();
        const int c = F.tid & 255, half = F.tid >> 8;
        const float* Bsrc = (kind == 0 ? F.inp(I_WUK) : F.inp(I_WUV)) + (((size_t)e * 256 + c) * 8 + h) * 64;
        float br[64];
#pragma unroll
        for (int d4 = 0; d4 < 16; ++d4) { const f32x4 v = *(const GAS f32x4*)(Bsrc + 4 * d4); br[4 * d4] = v.x; br[4 * d4 + 1] = v.y; br[4 * d4 + 2] = v.z; br[4 * d4 + 3] = v.w; }
        if (kind == 0) {
            bf16* dst = (bf16*)(F.ws + WS_WEIN) + (size_t)e * NE * DM + (size_t)(h * 256 + c) * DM + 64 * blk + 32 * half;
#pragma unroll 1
            for (int kq = 0; kq < 16; ++kq) { const LAS float* a0 = At + (32 * half + 2 * kq) * 65; float s0 = 0.f, s1 = 0.f;
#pragma unroll
                for (int d = 0; d < 64; ++d) { s0 += a0[d] * br[d]; s1 += a0[65 + d] * br[d]; }
                *(GAS unsigned*)(dst + 2 * kq) = pk2(s0 * C2, s1 * C2); }
        } else {
            bf16* dst = (bf16*)(F.ws + WS_WEOUT) + (size_t)e * DM * KEO + (size_t)(64 * blk + 32 * half) * KEO + h * 256 + c;
#pragma unroll 1
            for (int q = 0; q < 32; ++q) { const LAS float* a = At + (32 * half + q) * 65; float s = 0.f;
#pragma unroll
                for (int d = 0; d < 64; ++d) s += a[d] * br[d];
                dst[(size_t)q * KEO] = (bf16)f2bf(s); }
        }
    }
    __syncthreads();
}
__device__ __forceinline__ void p0_fused_weights(Frame& F) { p0_fused_weights_k<0>(F); p0_fused_weights_k<1>(F); }
__device__ __forceinline__ void p0_mod(Frame& F) { PHASE_BEGIN(F);
    LAS float* cs = (LAS float*)F.lds;
    LAS float* red = (LAS float*)(F.lds + 16384);
    for (int i = F.tid; i < 4 * DM; i += NTHR) cs[i] = siluf(F.inp(I_C)[i]);
    __syncthreads();
    float* mod = (float*)(F.ws + WS_MOD);
    for (int it = F.vcu; it < DEPTH * 96; it += F.G) {
        const int l = it / 96, j0 = 64 * (it % 96);
        const float* W = F.inp(I_ADAW) + (size_t)l * DM * 6144 + j0 + F.lane;
        float a0 = 0.f, a1 = 0.f, a2 = 0.f, a3 = 0.f;
        const int kb = 128 * F.wave;
#pragma unroll 16
        for (int k = 0; k < 128; ++k) { const float w = W[(size_t)(kb + k) * 6144]; a0 += cs[kb + k] * w; a1 += cs[1024 + kb + k] * w; a2 += cs[2048 + kb + k] * w; a3 += cs[3072 + kb + k] * w; }
        red[(F.wave * 4 + 0) * 64 + F.lane] = a0; red[(F.wave * 4 + 1) * 64 + F.lane] = a1; red[(F.wave * 4 + 2) * 64 + F.lane] = a2; red[(F.wave * 4 + 3) * 64 + F.lane] = a3;
        __syncthreads();
        if (F.tid < 256) { const int b = F.tid >> 6, jj = F.tid & 63; float s = F.inp(I_ADAB)[(size_t)l * 6144 + j0 + jj];
#pragma unroll
            for (int w = 0; w < 8; ++w) s += red[(w * 4 + b) * 64 + jj];
            mod[((size_t)l * 4 + b) * 6144 + j0 + jj] = s; }
        __syncthreads();
    }
}
__device__ __forceinline__ void conv_peer_tables(Frame& F, int layer) { PHASE_BEGIN(F);
    const int gt = F.vcu * NTHR + F.tid, NGT = F.G * NTHR;
    const size_t n8 = (size_t)16384 * 1024 / 8;
    for (int w = 0; w < 2; ++w) {
        const float* s = F.inp(w == 0 ? I_PU : I_PV) + (size_t)layer * 16384 * 1024; bf16* d = (bf16*)(F.ws + (w == 0 ? WS_PU : WS_PV));
        for (size_t i = gt; i < n8; i += NGT) { const f32x4 a = __builtin_nontemporal_load((const GAS f32x4*)(s + i * 8)), b = __builtin_nontemporal_load((const GAS f32x4*)(s + i * 8 + 4));
            v4u o; o.x = pk2(a.x, a.y); o.y = pk2(a.z, a.w); o.z = pk2(b.x, b.y); o.w = pk2(b.z, b.w); *(GAS v4u*)(d + i * 8) = o; }
    }
}
__device__ __forceinline__ void norm_mod_row(const float* xrow, const float* g, const float* sc, const float* sh, bf16* orow, int lane) {
    const GAS f32x4* xr = (const GAS f32x4*)xrow + lane;
    f32x4 v[4]; float s2 = 0.f;
#pragma unroll
    for (int j = 0; j < 4; ++j) { v[j] = xr[64 * j]; s2 += (v[j].x * v[j].x + v[j].y * v[j].y) + (v[j].z * v[j].z + v[j].w * v[j].w); }
    const float rstd = 1.f / sqrtf(wave_sum(s2) * (1.f / DM) + RMS_EPS);
    GAS unsigned long long* o8 = (GAS unsigned long long*)orow + lane;
#pragma unroll
    for (int j = 0; j < 4; ++j) { const f32x4 gg = *((const GAS f32x4*)g + lane + 64 * j), cc = *((const GAS f32x4*)sc + lane + 64 * j), hh = *((const GAS f32x4*)sh + lane + 64 * j);
        const f32x4 y = v[j] * rstd * gg * (cc + 1.f) + hh;
        o8[64 * j] = (unsigned long long)pk2(y.x, y.y) | ((unsigned long long)pk2(y.z, y.w) << 32); }
}
__device__ __forceinline__ void norm_mod_phase(Frame& F, const float* X, int layer, int which) { PHASE_BEGIN(F);
    const int gw = F.vcu * NWAVES + F.wave, NGW = F.G * NWAVES;
    const float* g = F.inp(which == 0 ? I_NMIX : I_NFFN) + (size_t)layer * DM;
    const float* mod = (const float*)(F.ws + WS_MOD) + (size_t)layer * 4 * 6144;
    bf16* H = (bf16*)(F.ws + WS_H);
    if (X == nullptr) X = (which == 0) ? F.inp(I_X) : (const float*)(F.ws + WS_X);
    for (int m = gw; m < T; m += NGW) { const float* mb = mod + (size_t)(m / SEQ) * 6144 + (which == 0 ? 0 : 3 * DM);
        norm_mod_row(X + (size_t)m * DM, g, mb + DM, mb, H + (size_t)m * DM, F.lane); }
}
__device__ __forceinline__ unsigned f2sort(float x) { const unsigned u = __float_as_uint(x); return (u & 0x80000000u) ? ~u : (u | 0x80000000u); }
__device__ __forceinline__ float sort2f(unsigned k) { return __uint_as_float((k & 0x80000000u) ? (k & 0x7fffffffu) : ~k); }
__device__ __forceinline__ unsigned mbcnt64(unsigned long long m) { return __builtin_amdgcn_mbcnt_hi((unsigned)(m >> 32), __builtin_amdgcn_mbcnt_lo((unsigned)m, 0u)); }
#define LDS_FENCE() asm volatile("s_waitcnt lgkmcnt(0)" ::: "memory")

__device__ __forceinline__ void topk_unit(Frame& F, int b, int t0) {
    const int lane = F.lane, wid = F.wave, r32 = lane & 31, hi = lane >> 5;
    const bf16* P = (const bf16*)(F.ws + WS_P) + (size_t)b * SEQ * NE;
    LAS float* scores = (LAS float*)F.lds;
    LAS unsigned* minmax = (LAS unsigned*)(F.lds + XTRA_OFF + 24576);
    if (F.tid < 16) minmax[F.tid] = (F.tid & 1) ? 0xffffffffu : 0u;
    bf16x8 qa[2][4];
#pragma unroll
    for (int rt = 0; rt < 2; ++rt)
#pragma unroll
        for (int d0 = 0; d0 < 4; ++d0) qa[rt][d0] = *(const GAS bf16x8*)(P + (size_t)(t0 + 4 * rt + (r32 >> 3)) * NE + EC_QI + (r32 & 7) * 64 + 16 * d0 + 8 * hi);
    float wv[2][4][4];
#pragma unroll
    for (int rt = 0; rt < 2; ++rt)
#pragma unroll
        for (int g = 0; g < 4; ++g) { const u32x2 w = *(const GAS u32x2*)(P + (size_t)(t0 + 4 * rt + g) * NE + EC_WI + 4 * hi);
            wv[rt][g][0] = bflo(w.x); wv[rt][g][1] = bfhi(w.x); wv[rt][g][2] = bflo(w.y); wv[rt][g][3] = bfhi(w.y); }
    float mn[4], mx[4];
#pragma unroll
    for (int g = 0; g < 4; ++g) { mn[g] = INFINITY; mx[g] = -INFINITY; }
    const int nkt = (t0 + 8 + 31) >> 5;
    for (int kt = wid; kt < nkt; kt += NWAVES) {
        const int key = 32 * kt + r32;
        bf16x8 kb[4];
#pragma unroll
        for (int d0 = 0; d0 < 4; ++d0) kb[d0] = *(const GAS bf16x8*)(P + (size_t)key * NE + EC_KI + 16 * d0 + 8 * hi);
        f32x16 acc[2];
#pragma unroll
        for (int rt = 0; rt < 2; ++rt) { acc[rt] = (f32x16){};
#pragma unroll
            for (int d0 = 0; d0 < 4; ++d0) acc[rt] = __builtin_amdgcn_mfma_f32_32x32x16_bf16(qa[rt][d0], kb[d0], acc[rt], 0, 0, 0); }
#pragma unroll
        for (int g = 0; g < 4; ++g) {
            float s0 = 0.f, s1 = 0.f;
#pragma unroll
            for (int j = 0; j < 4; ++j) { s0 += wv[0][g][j] * fmaxf(acc[0][4 * g + j], 0.f); s1 += wv[1][g][j] * fmaxf(acc[1][4 * g + j], 0.f); }
            s0 += __shfl_xor(s0, 32); s1 += __shfl_xor(s1, 32);
            const float v = (hi ? s1 : s0) + 0.f;
            const int tok = 4 * hi + g;
            scores[tok * 4096 + key] = v;
            if (key <= t0 + tok) { mn[g] = fminf(mn[g], v); mx[g] = fmaxf(mx[g], v); }
        }
    }
#pragma unroll
    for (int g = 0; g < 4; ++g) {
#pragma unroll
        for (int o = 1; o < 32; o <<= 1) { mn[g] = fminf(mn[g], __shfl_xor(mn[g], o)); mx[g] = fmaxf(mx[g], __shfl_xor(mx[g], o)); }
    }
    __syncthreads();
    if (r32 == 0) {
#pragma unroll
        for (int g = 0; g < 4; ++g) { if (mx[g] >= mn[g]) { __hip_atomic_fetch_max(&minmax[(4 * hi + g) * 2], f2sort(mx[g]), __ATOMIC_RELAXED, __HIP_MEMORY_SCOPE_WORKGROUP);
                __hip_atomic_fetch_min(&minmax[(4 * hi + g) * 2 + 1], f2sort(mn[g]), __ATOMIC_RELAXED, __HIP_MEMORY_SCOPE_WORKGROUP); } }
    }
    __syncthreads();
    {
        const int t = t0 + wid, n = t + 1;
        unsigned short* selg = (unsigned short*)(F.ws + WS_SEL) + (size_t)(b * SEQ + t) * 256;
        if (n <= 256) {
#pragma unroll
            for (int q = 0; q < 4; ++q) { const int i = lane + 64 * q; selg[i] = (unsigned short)((i < n) ? i : 0xffff); }
        } else {
            const LAS float* sr = scores + wid * 4096;
            LAS unsigned* hist = (LAS unsigned*)(F.lds + XTRA_OFF + 3072 * wid);
            LAS unsigned* cand = hist + 512;
            LAS unsigned short* outl = (LAS unsigned short*)(hist + 640);
            const float hif = sort2f(minmax[wid * 2]), lof = sort2f(minmax[wid * 2 + 1]);
            const float scale = (hif > lof) ? 1024.f / (hif - lof) : 0.f;
#pragma unroll
            for (int q = 0; q < 8; ++q) hist[lane + 64 * q] = 0u;
            LDS_FENCE();
            for (int i0 = 0; i0 < n; i0 += 64) { const int i = i0 + lane;
                if (i < n) { int bb = (int)((sr[i] - lof) * scale); bb = bb > 1023 ? 1023 : bb;
                    __hip_atomic_fetch_add(&hist[bb >> 1], (bb & 1) ? 65536u : 1u, __ATOMIC_RELAXED, __HIP_MEMORY_SCOPE_WORKGROUP); } }
            LDS_FENCE();
            unsigned hw[8]; unsigned tot = 0;
#pragma unroll
            for (int q = 0; q < 8; ++q) { hw[q] = hist[8 * lane + q]; tot += (hw[q] & 0xffffu) + (hw[q] >> 16); }
            unsigned suf = tot;
#pragma unroll
            for (int o = 1; o < 64; o <<= 1) { const unsigned v = __shfl_down(suf, o); if (lane + o < 64) suf += v; }
            const unsigned long long pm = __ballot(suf >= 256u);
            const int Ls = 63 - __builtin_clzll(pm | 1ull);
            unsigned above = __shfl(suf - tot, Ls);
            int bstar = 16 * Ls; unsigned cstar = 0; bool found = false;
#pragma unroll
            for (int q = 7; q >= 0; --q) { const unsigned w = __shfl(hw[q], Ls);
                { const unsigned c = w >> 16; if (!found) { if (above + c >= 256u) { found = true; bstar = 16 * Ls + 2 * q + 1; cstar = c; } else above += c; } }
                { const unsigned c = w & 0xffffu; if (!found) { if (above + c >= 256u) { found = true; bstar = 16 * Ls + 2 * q; cstar = c; } else above += c; } } }
            const unsigned need = 256u - above;
            unsigned pos = 0;
            if (cstar <= 64u) {
                unsigned ncand = 0;
                for (int i0 = 0; i0 < n; i0 += 64) { const int i = i0 + lane; const bool valid = i < n; const float x = valid ? sr[i] : 0.f;
                    int bb = (int)((x - lof) * scale); bb = bb > 1023 ? 1023 : bb;
                    const bool ab = valid && bb > bstar; const unsigned long long ma = __ballot(ab);
                    if (ab) outl[pos + mbcnt64(ma)] = (unsigned short)i;
                    pos += (unsigned)__builtin_popcountll(ma);
                    const bool ic = valid && bb == bstar; const unsigned long long mc = __ballot(ic);
                    if (ic) { const unsigned sl = ncand + mbcnt64(mc); if (sl < 64u) { cand[sl] = f2sort(x); cand[64 + sl] = (unsigned)i; } }
                    ncand += (unsigned)__builtin_popcountll(mc); }
                LDS_FENCE();
                const bool v = (unsigned)lane < ncand; const unsigned key = v ? cand[lane] : 0u; const unsigned cidx = cand[64 + lane];
                unsigned prefix = 0u;
                for (int bit = 31; bit >= 0; --bit) { const unsigned trial = prefix | (1u << bit);
                    const unsigned cnt = (unsigned)__builtin_popcountll(__ballot(v && key >= trial)); if (cnt >= need) prefix = trial; }
                const bool gt = v && key > prefix; const unsigned ngt = (unsigned)__builtin_popcountll(__ballot(gt));
                const bool eq = v && key == prefix; const unsigned long long meq = __ballot(eq);
                const bool sc = gt || (eq && mbcnt64(meq) < need - ngt);
                const unsigned long long ms = __ballot(sc);
                if (sc) { const unsigned sl = pos + mbcnt64(ms); if (sl < 256u) outl[sl] = (unsigned short)cidx; }
                pos += (unsigned)__builtin_popcountll(ms);
            } else {
                unsigned prefix = 0u;
                for (int bit = 31; bit >= 0; --bit) { const unsigned trial = prefix | (1u << bit); unsigned cnt = 0;
                    for (int i0 = 0; i0 < n; i0 += 64) { const int i = i0 + lane; cnt += (unsigned)__builtin_popcountll(__ballot(i < n && f2sort(sr[i < n ? i : 0]) >= trial)); }
                    if (cnt >= 256u) prefix = trial; }
                unsigned ngt = 0;
                for (int i0 = 0; i0 < n; i0 += 64) { const int i = i0 + lane; ngt += (unsigned)__builtin_popcountll(__ballot(i < n && f2sort(sr[i < n ? i : 0]) > prefix)); }
                const unsigned need_eq = 256u - ngt; unsigned eqseen = 0;
                for (int i0 = 0; i0 < n; i0 += 64) { const int i = i0 + lane; const bool valid = i < n; const unsigned k = f2sort(sr[valid ? i : 0]);
                    const bool gt = valid && k > prefix, eq = valid && k == prefix; const unsigned long long meq = __ballot(eq);
                    const bool sc = gt || (eq && eqseen + mbcnt64(meq) < need_eq); const unsigned long long ms = __ballot(sc);
                    if (sc) { const unsigned sl = pos + mbcnt64(ms); if (sl < 256u) outl[sl] = (unsigned short)i; }
                    pos += (unsigned)__builtin_popcountll(ms); eqseen += (unsigned)__builtin_popcountll(meq); }
            }
            LDS_FENCE();
            *(GAS unsigned long long*)(selg + 4 * lane) = *(const LAS unsigned long long*)(outl + 4 * lane);
        }
    }
    __syncthreads();
}
__device__ __forceinline__ void topk_phase(Frame& F) { PHASE_BEGIN(F);
    for (int idx = F.vcu; idx < 2048; idx += F.G) { const int r = idx >> 8, g = idx & 255; const int u = (r & 1) ? (r + 1) * 256 - 1 - g : r * 256 + g;
        topk_unit(F, u >> 9, (u & 511) * 8); }
}
__device__ __forceinline__ void ckv_norm_phase(Frame& F, int e) { PHASE_BEGIN(F);
    const int gw = F.vcu * NWAVES + F.wave, NGW = F.G * NWAVES;
    const bf16* P = (const bf16*)(F.ws + WS_P); bf16* CK = (bf16*)(F.ws + WS_CKV);
    const f32x4 g = *((const GAS f32x4*)(F.inp(I_KVN) + (size_t)e * 256) + F.lane);
    for (int m = gw; m < T; m += NGW) { const u32x2 w = *((const GAS u32x2*)(P + (size_t)m * NE + EC_CKV) + F.lane);
        const float a = bflo(w.x), b = bfhi(w.x), c = bflo(w.y), d = bfhi(w.y);
        const float rstd = 1.f / sqrtf(wave_sum((a * a + b * b) + (c * c + d * d)) * (1.f / 256.f) + RMS_EPS);
        u32x2 o; o.x = pk2(a * rstd * g.x, b * rstd * g.y); o.y = pk2(c * rstd * g.z, d * rstd * g.w);
        *((GAS u32x2*)(CK + (size_t)m * 256) + F.lane) = o; }
}
namespace fa {
__device__ __forceinline__ int crow(int r, int hi) { return (r & 3) + 8 * (r >> 2) + 4 * hi; }
__device__ __forceinline__ void glds16(const void* gsrc, unsigned lds_dst) { unsigned keep;
    asm volatile("s_mov_b32 %0, m0\n\ts_mov_b32 m0, %2\n\ts_nop 0\n\tglobal_load_lds_dwordx4 %1, off\n\ts_mov_b32 m0, %0" : "=&s"(keep) : "v"(gsrc), "s"(lds_dst) : "memory"); }
typedef __bf16 bf16x2_t __attribute__((ext_vector_type(2))); typedef float f32x2_t __attribute__((ext_vector_type(2)));
__device__ __forceinline__ unsigned cvtpk(float lo, float hi) { f32x2_t v = {lo, hi}; bf16x2_t b = __builtin_convertvector(v, bf16x2_t); return __builtin_bit_cast(unsigned, b); }
typedef short v4i16_t __attribute__((ext_vector_type(4)));
__device__ __forceinline__ s16x4 vtr(const LAS char* p) { return __builtin_bit_cast(s16x4, __builtin_amdgcn_ds_read_tr16_b64_v4i16((LAS v4i16_t*)p)); }
constexpr int KSLOT = 8192, THR = 8;
constexpr int L_V = 16384, L_WS = 49152, L_KB = 51200, FA_LDS = 51200 + 16384;

template <int VD, int MODE>
__device__ __forceinline__ void unit(LAS char* lds, const bf16* Qh, const bf16* Kh, const bf16* Vh, int pitch, int q0, bf16* Oh, int opitch) {
    constexpr int NDB = VD / 32, VSLOT = VD * 128;
    int tid_ = threadIdx.x; asm volatile("" : "+v"(tid_)); const int tid = tid_, lane = tid & 63, r32 = lane & 31, hi = lane >> 5; const int wid = __builtin_amdgcn_readfirstlane(tid >> 6);
    const unsigned lds0 = (unsigned)(uintptr_t)lds;
    LAS float* wsf = (LAS float*)(lds + L_WS) + wid * 64;
    const LAS float* kbl = (const LAS float*)(lds + L_KB);
    const int NT = (q0 + 256) / 64;
    const int qw0 = q0 + 32 * wid, NTw = (qw0 + 31) / 64 + 1;
    const bf16* ksrc = Kh + (size_t)lane * pitch + wid * 8;
#define FA_DMA(t, s) do { fa::glds16(ksrc + (size_t)(t) * 64 * pitch, (unsigned)__builtin_amdgcn_readfirstlane(lds0 + (s) * fa::KSLOT + wid * 1024)); \
    _Pragma("unroll") for (int i_ = 0; i_ < NDB / 2; ++i_) { const int ci_ = i_ * 8 + wid; \
        fa::glds16(Vh + (size_t)((t) * 64 + 16 * (ci_ & 3) + (lane >> 2)) * pitch + (ci_ >> 2) * 32 + (lane & 3) * 8, (unsigned)__builtin_amdgcn_readfirstlane(lds0 + fa::L_V + (s) * VSLOT + ci_ * 1024)); } } while (0)
    FA_DMA(0, 0);
    bf16x8 qr[4];
#pragma unroll
    for (int d0 = 0; d0 < 4; ++d0) qr[d0] = *(const GAS bf16x8*)(Qh + (size_t)(qw0 + r32) * pitch + d0 * 16 + hi * 8);
    f32x16 o[NDB];
#pragma unroll
    for (int d = 0; d < NDB; ++d) o[d] = (f32x16){};
    float mhat = 0.f, l_reg = 0.f;
    asm volatile("s_waitcnt lgkmcnt(0)\n\ts_barrier" ::: "memory");
    const float farb = (MODE == 0) ? kbl[128] : 0.f;
    for (int j = 0; j < NT; ++j) {
        asm volatile("s_waitcnt vmcnt(0) lgkmcnt(0)\n\ts_barrier" ::: "memory");
        if (j + 1 < NT) FA_DMA(j + 1, (j + 1) & 1);
        if (j < NTw) {
            const int k0 = 64 * j;
            const LAS char* Ks = lds + (j & 1) * KSLOT + hi * 1024 + r32 * 16;
            f32x16 p0, p1;
            if (MODE == 1) {
#pragma unroll
                for (int g = 0; g < 4; ++g) { const f32x4 a = *(const LAS f32x4*)(kbl + k0 + 8 * g + 4 * hi), c = *(const LAS f32x4*)(kbl + k0 + 32 + 8 * g + 4 * hi);
                    p0[4 * g] = a.x - mhat; p0[4 * g + 1] = a.y - mhat; p0[4 * g + 2] = a.z - mhat; p0[4 * g + 3] = a.w - mhat;
                    p1[4 * g] = c.x - mhat; p1[4 * g + 1] = c.y - mhat; p1[4 * g + 2] = c.z - mhat; p1[4 * g + 3] = c.w - mhat; }
            } else { const float c = farb - mhat;
#pragma unroll
                for (int r = 0; r < 16; ++r) { p0[r] = c; p1[r] = c; } }
#pragma unroll
            for (int d0 = 0; d0 < 4; ++d0) { const bf16x8 b0 = *(const LAS bf16x8*)(Ks + d0 * 2048), b1 = *(const LAS bf16x8*)(Ks + d0 * 2048 + 512);
                p0 = __builtin_amdgcn_mfma_f32_32x32x16_bf16(b0, qr[d0], p0, 0, 0, 0); p1 = __builtin_amdgcn_mfma_f32_32x32x16_bf16(b1, qr[d0], p1, 0, 0, 0); }
            const int q = qw0 + r32;
            if (MODE == 0 && (k0 + 63 + 128 > qw0)) {
#pragma unroll
                for (int r = 0; r < 16; ++r) { int d0_ = q - (k0 + crow(r, hi)), d1_ = d0_ - 32; d0_ = d0_ < 0 ? 0 : (d0_ > 128 ? 128 : d0_); d1_ = d1_ < 0 ? 0 : (d1_ > 128 ? 128 : d1_);
                    p0[r] += kbl[d0_] - farb; p1[r] += kbl[d1_] - farb; } }
            if (k0 + 63 > qw0) {
#pragma unroll
                for (int r = 0; r < 16; ++r) { const int kv = k0 + crow(r, hi); if (kv > q) p0[r] = -INFINITY; if (kv + 32 > q) p1[r] = -INFINITY; } }
            float rm = fmaxf(p0[0], p1[0]);
#pragma unroll
            for (int r = 1; r < 16; ++r) rm = fmaxf(rm, fmaxf(p0[r], p1[r]));
            rm = fmaxf(rm, __shfl_xor(rm, 32));
            const bool first = (j == 0);
            if (first || __any(rm > (float)THR)) {
                const float dl = first ? rm : fmaxf(rm, 0.f);
                mhat += dl;
#pragma unroll
                for (int r = 0; r < 16; ++r) { p0[r] -= dl; p1[r] -= dl; }
                if (!first) { const float f = __builtin_amdgcn_exp2f(-dl); l_reg *= f; if (hi == 0) wsf[r32] = f; LDS_FENCE();
#pragma unroll
                    for (int r = 0; r < 16; ++r) { const float ff = wsf[crow(r, hi)];
#pragma unroll
                        for (int d = 0; d < NDB; ++d) o[d][r] *= ff; }
                    LDS_FENCE(); }
            }
            float sacc = 0.f;
#pragma unroll
            for (int r = 0; r < 16; ++r) { p0[r] = __builtin_amdgcn_exp2f(p0[r]); p1[r] = __builtin_amdgcn_exp2f(p1[r]); sacc += p0[r] + p1[r]; }
            l_reg += sacc;
            u32x4 pw[4];
#pragma unroll
            for (int i = 0; i < 4; ++i) { pw[0][i] = cvtpk(p0[2 * i], p0[2 * i + 1]); pw[1][i] = cvtpk(p0[8 + 2 * i], p0[8 + 2 * i + 1]); pw[2][i] = cvtpk(p1[2 * i], p1[2 * i + 1]); pw[3][i] = cvtpk(p1[8 + 2 * i], p1[8 + 2 * i + 1]); }
            const LAS char* vp = lds + L_V + (j & 1) * VSLOT + ((lane >> 4) & 1) * 32 + (lane & 3) * 8 + (4 * hi + ((lane & 15) >> 2)) * 64;
#pragma unroll
            for (int d = 0; d < NDB; ++d) {
#pragma unroll
                for (int ks = 0; ks < 4; ++ks) { const s16x4 lo = vtr(vp + d * 4096 + ks * 1024), hh = vtr(vp + d * 4096 + ks * 1024 + 512);
                    const bf16x8 vf = (bf16x8){lo[0], lo[1], lo[2], lo[3], hh[0], hh[1], hh[2], hh[3]};
                    o[d] = __builtin_amdgcn_mfma_f32_32x32x16_bf16(__builtin_bit_cast(bf16x8, pw[ks]), vf, o[d], 0, 0, 0); } }
        }
    }
#undef FA_DMA
    l_reg += __shfl_xor(l_reg, 32);
    if (hi == 0) wsf[32 + r32] = l_reg;
    LDS_FENCE();
#pragma unroll
    for (int r = 0; r < 16; ++r) { const float rl = 1.f / wsf[32 + crow(r, hi)]; bf16* orow = Oh + (size_t)(qw0 + crow(r, hi)) * opitch + r32;
#pragma unroll
        for (int d = 0; d < NDB; ++d) orow[32 * d] = (bf16)f2bf(o[d][r] * rl); }
    asm volatile("s_waitcnt lgkmcnt(0)\n\ts_barrier" ::: "memory");
}
}
__device__ __forceinline__ void fox_phase(Frame& F) { PHASE_BEGIN(F);
    LAS char* lds = (LAS char*)F.lds;
    const bf16* P = (const bf16*)(F.ws + WS_P); bf16* AO = (bf16*)(F.ws + WS_AO);
    const float* FC = (const float*)(F.ws + WS_FCUM);
    for (int idx = F.vcu; idx < 512; idx += F.G) {
        const int bh = idx >> 3, s = idx & 7, b = bh >> 4, h = bh & 15;
        for (int half = 0; half < 2; ++half) { const int qb = half ? 15 - s : s;
            LAS float* kbl = (LAS float*)(lds + fa::L_KB);
            for (int i = F.tid; i < (qb + 1) * 256; i += NTHR) kbl[i] = FC[((size_t)b * 16 + h) * SEQ + i];
            const size_t rb = (size_t)b * SEQ;
            fa::unit<64, 1>(lds, P + rb * NO + OC_Q + h * 64, P + rb * NO + OC_K + h * 64, P + rb * NO + OC_V + h * 64, NO, qb * 256, AO + rb * DM + h * 64, DM); }
    }
}
__device__ __forceinline__ void diff_phase(Frame& F) { PHASE_BEGIN(F);
    LAS char* lds = (LAS char*)F.lds;
    const bf16* P = (const bf16*)(F.ws + WS_P); bf16* DO = (bf16*)(F.ws + WS_H);
    for (int idx = F.vcu; idx < 256; idx += F.G) {
        const int bhm = idx >> 3, s = idx & 7, b = bhm >> 3, h = (bhm >> 1) & 3, mp = bhm & 1;
        for (int half = 0; half < 2; ++half) { const int qb = half ? 15 - s : s;
            LAS float* tab = (LAS float*)(lds + fa::L_KB);
            if (F.tid < 129) tab[F.tid] = F.inp(I_RELB)[t5_bucket(F.tid) * 12 + 8 + h] * LOG2E;
            const size_t rb = (size_t)b * SEQ;
            fa::unit<128, 0>(lds, P + rb * NE + EC_QB + h * 128 + mp * 64, P + rb * NE + EC_KB + h * 128 + mp * 64, P + rb * NE + EC_VB + h * 128, NE, qb * 256, DO + rb * DM + (h * 2 + mp) * 128, DM); }
    }
}
__device__ __forceinline__ void fcum_phase(Frame& F, int o) { PHASE_BEGIN(F);
    const int gw = F.vcu * NWAVES + F.wave, NGW = F.G * NWAVES;
    const bf16* P = (const bf16*)(F.ws + WS_P); float* FC = (float*)(F.ws + WS_FCUM);
    for (int it = gw; it < NB * 16; it += NGW) { const int b = it >> 4, h = it & 15; const float bfg = F.inp(I_BF)[o * 16 + h];
        const bf16* src = P + ((size_t)b * SEQ + 64 * F.lane) * NO + OC_F + h;
        float loc = 0.f;
        for (int i = 0; i < 64; ++i) { const float x = bf2f(src[(size_t)i * NO]) + bfg; loc += fminf(x, 0.f) - log1pf(__expf(-fabsf(x))); }
        float inc = loc;
#pragma unroll
        for (int of = 1; of < 64; of <<= 1) { const float v = __shfl_up(inc, of); if (F.lane >= of) inc += v; }
        float run = inc - loc;
        float* dst = FC + ((size_t)b * 16 + h) * SEQ + 64 * F.lane;
        for (int i = 0; i < 64; ++i) { const float x = bf2f(src[(size_t)i * NO]) + bfg; run += fminf(x, 0.f) - log1pf(__expf(-fabsf(x))); dst[i] = -run * LOG2E; }
    }
}
typedef float f32x4v __attribute__((ext_vector_type(4)));
__device__ __forceinline__ void sparse_phase(Frame& F, int e) { PHASE_BEGIN(F);
    const int lane = F.lane, wid = F.wave, g = lane >> 4, hd = lane & 15, hi = lane >> 5;
    LAS char* lds = (LAS char*)F.lds;
    LAS float* tabA = (LAS float*)(lds + XTRA_OFF);
    LAS int* selw = (LAS int*)(lds + XTRA_OFF + 8192 + wid * 128);
    LAS char* buf = lds + wid * 16384;
    const unsigned buf0 = (unsigned)(uintptr_t)buf;
    for (int i = F.tid; i < 8 * 129; i += NTHR) { const int h = i / 129, d = i % 129; tabA[h * 132 + d] = F.inp(I_RELB)[t5_bucket(d) * 12 + h] * LOG2E; }
    __syncthreads();
    const bf16* P = (const bf16*)(F.ws + WS_P); const bf16* CK = (const bf16*)(F.ws + WS_CKV); bf16* AO = (bf16*)(F.ws + WS_AO);
    const unsigned short* SEL = (const unsigned short*)(F.ws + WS_SEL);
    const int gw = F.vcu * NWAVES + wid, NGW = F.G * NWAVES;
    {
        const float* lv = F.inp(I_LAM) + (size_t)e * 256;
        const float s1 = wave_sum(lv[lane] * lv[64 + lane]), s2 = wave_sum(lv[128 + lane] * lv[192 + lane]);
        const float lam_init = (e == 0) ? 0.2f : 0.47071303836235146f;
        const float lam = __expf(s1) - __expf(s2) + lam_init;
        const bf16* DO = (const bf16*)(F.ws + WS_H);
        const int h = lane >> 4, d0 = (lane & 15) * 8;
        float sg[8];
#pragma unroll
        for (int j = 0; j < 8; ++j) sg[j] = F.inp(I_SUBLN)[(size_t)e * 128 + d0 + j] * (1.f - lam_init);
        for (int t = gw; t < T; t += NGW) {
            const v4u a = *(const GAS v4u*)(DO + (size_t)t * DM + (h * 2) * 128 + d0), b = *(const GAS v4u*)(DO + (size_t)t * DM + (h * 2 + 1) * 128 + d0);
            float o[8];
            o[0] = bflo(a.x) - lam * bflo(b.x); o[1] = bfhi(a.x) - lam * bfhi(b.x); o[2] = bflo(a.y) - lam * bflo(b.y); o[3] = bfhi(a.y) - lam * bfhi(b.y);
            o[4] = bflo(a.z) - lam * bflo(b.z); o[5] = bfhi(a.z) - lam * bfhi(b.z); o[6] = bflo(a.w) - lam * bflo(b.w); o[7] = bfhi(a.w) - lam * bfhi(b.w);
            float ss = 0.f;
#pragma unroll
            for (int j = 0; j < 8; ++j) ss += o[j] * o[j];
            ss += __shfl_xor(ss, 1); ss += __shfl_xor(ss, 2); ss += __shfl_xor(ss, 4); ss += __shfl_xor(ss, 8);
            const float rstd = 1.f / sqrtf(ss * (1.f / 128.f) + RMS_EPS);
            v4u w; w.x = pk2(o[0] * rstd * sg[0], o[1] * rstd * sg[1]); w.y = pk2(o[2] * rstd * sg[2], o[3] * rstd * sg[3]); w.z = pk2(o[4] * rstd * sg[4], o[5] * rstd * sg[5]); w.w = pk2(o[6] * rstd * sg[6], o[7] * rstd * sg[7]);
            *(GAS v4u*)(AO + (size_t)t * KEO + 2048 + h * 128 + d0) = w;
        }
    }
    for (int t = gw; t < T; t += NGW) {
        const int b = t / SEQ, tl = t % SEQ;
        const int cnt = tl + 1 < 256 ? tl + 1 : 256, nch = (cnt + 31) >> 5;
        bf16x8 bq[8];
#pragma unroll
        for (int ks = 0; ks < 8; ++ks) { bq[ks] = (bf16x8){0, 0, 0, 0, 0, 0, 0, 0}; if (hd < 8) bq[ks] = *(const GAS bf16x8*)(P + (size_t)t * NE + EC_QLAT + hd * 256 + 32 * ks + 8 * g); }
        f32x4v oacc[16];
#pragma unroll
        for (int ct = 0; ct < 16; ++ct) oacc[ct] = (f32x4v){0.f, 0.f, 0.f, 0.f};
        float m = 0.f, l = 0.f;
        const float* tb = nullptr; (void)tb;
        for (int ch = 0; ch < nch; ++ch) {
            const int svu = (int)SEL[(size_t)t * 256 + 32 * ch + (lane & 31)];
            const int sv = (svu == 0xffff) ? -1 : svu;
            LDS_FENCE();
            if (lane < 32) selw[lane] = sv;
#pragma unroll
            for (int i = 0; i < 16; ++i) { const int ra = __builtin_amdgcn_readlane(sv, 2 * i), rb = __builtin_amdgcn_readlane(sv, 2 * i + 1);
                int r = hi ? rb : ra; r = r < 0 ? 0 : r; const int row = 2 * i + hi;
                fa::glds16(CK + ((size_t)b * SEQ + r) * 256 + 8 * ((lane & 31) ^ (row & 15)), (unsigned)__builtin_amdgcn_readfirstlane(buf0 + i * 1024)); }
            asm volatile("s_waitcnt vmcnt(0) lgkmcnt(0)" ::: "memory");
            f32x4v s[2];
#pragma unroll
            for (int rt = 0; rt < 2; ++rt) { s[rt] = (f32x4v){0.f, 0.f, 0.f, 0.f}; const int row = 16 * rt + hd; const LAS char* rp = buf + row * 512;
#pragma unroll
                for (int ks = 0; ks < 8; ++ks) { const bf16x8 a = *(const LAS bf16x8*)(rp + (((4 * ks + g) ^ (row & 15)) << 4));
                    s[rt] = __builtin_amdgcn_mfma_f32_16x16x32_bf16(a, bq[ks], s[rt], 0, 0, 0); } }
            float rm = -INFINITY;
#pragma unroll
            for (int rt = 0; rt < 2; ++rt) { const i32x4 kp = *(const LAS i32x4*)(selw + 16 * rt + 4 * g); const int kq[4] = {kp.x, kp.y, kp.z, kp.w};
#pragma unroll
                for (int r = 0; r < 4; ++r) { int d = tl - kq[r]; d = d > 128 ? 128 : (d < 0 ? 0 : d); float v = s[rt][r] + tabA[(hd & 7) * 132 + d]; v = kq[r] < 0 ? -INFINITY : v; s[rt][r] = v; rm = fmaxf(rm, v); } }
            rm = fmaxf(rm, __shfl_xor(rm, 16)); rm = fmaxf(rm, __shfl_xor(rm, 32));
            if (ch == 0) m = rm;
            else if (__any(rm - m > 8.f)) { const float mn = fmaxf(m, rm), f = __builtin_amdgcn_exp2f(m - mn); m = mn; l *= f;
#pragma unroll
                for (int ct = 0; ct < 16; ++ct) oacc[ct] = oacc[ct] * f; }
            float p[2][4]; float ps = 0.f;
#pragma unroll
            for (int rt = 0; rt < 2; ++rt)
#pragma unroll
                for (int r = 0; r < 4; ++r) { p[rt][r] = __builtin_amdgcn_exp2f(s[rt][r] - m); ps += p[rt][r]; }
            l += ps;
            u32x4 pbw; pbw.x = fa::cvtpk(p[0][0], p[0][1]); pbw.y = fa::cvtpk(p[0][2], p[0][3]); pbw.z = fa::cvtpk(p[1][0], p[1][1]); pbw.w = fa::cvtpk(p[1][2], p[1][3]);
            const bf16x8 pb = __builtin_bit_cast(bf16x8, pbw);
            const int q4 = hd >> 2, p4 = hd & 3; const int r0 = 4 * g + q4;
            const LAS char* v0 = buf + r0 * 512 + 8 * (p4 & 1); const LAS char* v1 = v0 + 16 * 512;
#pragma unroll
            for (int ct = 0; ct < 16; ++ct) { const int co = ((2 * ct + (p4 >> 1)) ^ (r0 & 15)) << 4;
                const s16x4 lo = fa::vtr(v0 + co), hh = fa::vtr(v1 + co);
                const bf16x8 a = (bf16x8){lo[0], lo[1], lo[2], lo[3], hh[0], hh[1], hh[2], hh[3]};
                oacc[ct] = __builtin_amdgcn_mfma_f32_16x16x32_bf16(a, pb, oacc[ct], 0, 0, 0); }
        }
        l += __shfl_xor(l, 16); l += __shfl_xor(l, 32);
#ifdef DBG_ZERO_SPARSE
        const float rl = 0.f;
#else
        const float rl = 1.f / l;
#endif
        if (hd < 8) { bf16* orow = AO + (size_t)t * KEO + hd * 256 + 4 * g;
#pragma unroll
            for (int ct = 0; ct < 16; ++ct) { u32x2 w; w.x = pk2(oacc[ct][0] * rl, oacc[ct][1] * rl); w.y = pk2(oacc[ct][2] * rl, oacc[ct][3] * rl); *(GAS u32x2*)(orow + 16 * ct) = w; } }
    }
    LDS_FENCE();
    __syncthreads();
}
template <int N> __device__ __forceinline__ void bitonic_desc(unsigned* v) {
#pragma unroll
    for (int k = 2; k <= N; k <<= 1)
#pragma unroll
        for (int j = k >> 1; j > 0; j >>= 1)
#pragma unroll
            for (int i = 0; i < N; ++i) { const int l = i ^ j; if (l > i) { const bool up = (i & k) != 0; const unsigned a = v[i], b = v[l]; const unsigned mx = a > b ? a : b, mn = a > b ? b : a; v[i] = up ? mn : mx; v[l] = up ? mx : mn; } }
}
__device__ __forceinline__ void merge16_desc(unsigned* a, const unsigned* b) {
#pragma unroll
    for (int i = 0; i < 16; ++i) { const unsigned x = a[i], y = b[15 - i]; a[i] = x > y ? x : y; }
#pragma unroll
    for (int j = 8; j > 0; j >>= 1)
#pragma unroll
        for (int i = 0; i < 16; ++i) { const int l = i ^ j; if (l > i) { const unsigned x = a[i], y = a[l]; a[i] = x > y ? x : y; a[l] = x > y ? y : x; } }
}
__device__ __forceinline__ void top16_of_64(unsigned* v) {
    bitonic_desc<16>(v); bitonic_desc<16>(v + 16); bitonic_desc<16>(v + 32); bitonic_desc<16>(v + 48);
    merge16_desc(v, v + 16); merge16_desc(v + 32, v + 48); merge16_desc(v, v + 32);
}
__device__ __forceinline__ void peer_route_phase(Frame& F, int layer) { PHASE_BEGIN(F);
    const int lane = F.lane, r32 = lane & 31, hi = lane >> 5;
    const bf16* PQ = (const bf16*)(F.ws + WS_P); const bf16* SK = (const bf16*)(F.ws + WS_WSK) + (size_t)layer * 2 * 128 * 128;
    int* PE = (int*)(F.ws + WS_PE); float* PG = (float*)(F.ws + WS_PG);
    const int gw = F.vcu * NWAVES + F.wave, NGW = F.G * NWAVES;
    LAS char* lds = (LAS char*)F.lds;
    for (int i = F.tid; i < 256 * 16; i += NTHR) { const int row = i >> 4, ch = i & 15; *(LAS v4u*)(lds + row * 272 + ch * 16) = *(const GAS v4u*)(SK + (size_t)row * 128 + ch * 8); }
    __syncthreads();
    for (int task = gw; task < T / 4; task += NGW) {
        const int t = 4 * task + (r32 >> 3), h = r32 & 7;
        unsigned top0[16], top1[16];
#pragma unroll
        for (int i = 0; i < 16; ++i) { top0[i] = 0u; top1[i] = 0u; }
#pragma unroll 1
        for (int p = 0; p < 2; ++p) {
            bf16x8 bq[8];
#pragma unroll
            for (int d0 = 0; d0 < 8; ++d0) bq[d0] = *(const GAS bf16x8*)(PQ + (size_t)t * 2048 + h * 256 + p * 128 + 16 * d0 + 8 * hi);
            unsigned v[64];
            const LAS char* ab = lds + (p * 128 + r32) * 272 + hi * 16;
#pragma unroll
            for (int kt = 0; kt < 4; ++kt) { f32x16 acc = (f32x16){};
#pragma unroll
                for (int d0 = 0; d0 < 8; ++d0) { const bf16x8 a = *(const LAS bf16x8*)(ab + kt * 32 * 272 + d0 * 32);
                    acc = __builtin_amdgcn_mfma_f32_32x32x16_bf16(a, bq[d0], acc, 0, 0, 0); }
#pragma unroll
                for (int r = 0; r < 16; ++r) { const int key = 32 * kt + (r & 3) + 8 * (r >> 2) + 4 * hi; v[16 * kt + r] = (f2sort(acc[r]) & ~127u) | (unsigned)(127 - key); } }
            top16_of_64(v);
            unsigned o[16];
#pragma unroll
            for (int i = 0; i < 16; ++i) o[i] = (unsigned)__shfl_xor((int)v[i], 32);
            merge16_desc(v, o);
#pragma unroll
            for (int i = 0; i < 16; ++i) { top0[i] = (p == 0) ? v[i] : top0[i]; top1[i] = (p == 1) ? v[i] : top1[i]; }
        }
        float s0[16], s1[16];
#pragma unroll
        for (int i = 0; i < 16; ++i) { s0[i] = sort2f(top0[i] & ~127u); s1[i] = sort2f(top1[i] & ~127u); }
        unsigned c[64]; int nc = 0;
#pragma unroll
        for (int a = 0; a < 16; ++a)
#pragma unroll
            for (int b = 0; b < 16; ++b) if ((a + 1) * (b + 1) <= 16) { c[nc] = (f2sort(s0[a] + s1[b]) & ~255u) | (unsigned)(255 - (a * 16 + b)); ++nc; }
#pragma unroll
        for (int i = nc; i < 64; ++i) c[i] = 0u;
        top16_of_64(c);
        float gsum = 0.f; float gt[16]; int ex[16];
        const float smax = sort2f(c[0] & ~255u);
#pragma unroll
        for (int j = 0; j < 16; ++j) { const float sj = sort2f(c[j] & ~255u); gt[j] = __expf(sj - smax); gsum += gt[j];
            const int id = 255 - (int)(c[j] & 255u), a = id >> 4, b = id & 15; unsigned ka = top0[0], kb = top1[0];
#pragma unroll
            for (int q = 1; q < 16; ++q) { ka = (a == q) ? top0[q] : ka; kb = (b == q) ? top1[q] : kb; }
            ex[j] = (127 - (int)(ka & 127u)) * 128 + (127 - (int)(kb & 127u)); }
        const float rg = 1.f / gsum;
        if (hi == 0) { int* d = PE + (size_t)t * 128 + h * 16;
#pragma unroll
            for (int q = 0; q < 4; ++q) *(GAS i32x4*)(d + 4 * q) = (i32x4){ex[4 * q], ex[4 * q + 1], ex[4 * q + 2], ex[4 * q + 3]}; }
        else { float* d = PG + (size_t)t * 128 + h * 16;
#pragma unroll
            for (int q = 0; q < 4; ++q) *(GAS f32x4*)(d + 4 * q) = (f32x4){gt[4 * q] * rg, gt[4 * q + 1] * rg, gt[4 * q + 2] * rg, gt[4 * q + 3] * rg}; }
    }
    __syncthreads();
}
__device__ __forceinline__ void peer_expert_phase(Frame& F, int layer) { PHASE_BEGIN(F);
    const int lane = F.lane;
    const bf16* H = (const bf16*)(F.ws + WS_H); const bf16* U = (const bf16*)(F.ws + WS_PU); const bf16* V = (const bf16*)(F.ws + WS_PV);
    const int* PE = (const int*)(F.ws + WS_PE); const float* PG = (const float*)(F.ws + WS_PG);
    float* X = (float*)(F.ws + WS_X); bf16* Hn = (bf16*)(F.ws + WS_H);
    const float* mod = (const float*)(F.ws + WS_MOD);
    const int gw = F.vcu * NWAVES + F.wave, NGW = F.G * NWAVES;
    for (int t = gw; t < T; t += NGW) {
        const int b = t / SEQ;
        float xf[16];
        { const v4u a = *(const GAS v4u*)(H + (size_t)t * DM + 8 * lane), c = *(const GAS v4u*)(H + (size_t)t * DM + 512 + 8 * lane);
          xf[0] = bflo(a.x); xf[1] = bfhi(a.x); xf[2] = bflo(a.y); xf[3] = bfhi(a.y); xf[4] = bflo(a.z); xf[5] = bfhi(a.z); xf[6] = bflo(a.w); xf[7] = bfhi(a.w);
          xf[8] = bflo(c.x); xf[9] = bfhi(c.x); xf[10] = bflo(c.y); xf[11] = bfhi(c.y); xf[12] = bflo(c.z); xf[13] = bfhi(c.z); xf[14] = bflo(c.w); xf[15] = bfhi(c.w); }
        const int ea = PE[(size_t)t * 128 + lane], eb = PE[(size_t)t * 128 + 64 + lane];
        const float ga = PG[(size_t)t * 128 + lane], gb = PG[(size_t)t * 128 + 64 + lane];
        float out[16];
#pragma unroll
        for (int i = 0; i < 16; ++i) out[i] = 0.f;
        for (int grp = 0; grp < 16; ++grp) {
            const int ev = grp < 8 ? ea : eb; const float gv = grp < 8 ? ga : gb; const int jb = (8 * grp) & 63;
            int ei[8]; float d[8];
#pragma unroll
            for (int k = 0; k < 8; ++k) { ei[k] = __builtin_amdgcn_readlane(ev, jb + k);
                const v4u a = *(const GAS v4u*)(U + (size_t)ei[k] * DM + 8 * lane), c = *(const GAS v4u*)(U + (size_t)ei[k] * DM + 512 + 8 * lane);
                float s = xf[0] * bflo(a.x); s += xf[1] * bfhi(a.x); s += xf[2] * bflo(a.y); s += xf[3] * bfhi(a.y); s += xf[4] * bflo(a.z); s += xf[5] * bfhi(a.z); s += xf[6] * bflo(a.w); s += xf[7] * bfhi(a.w);
                s += xf[8] * bflo(c.x); s += xf[9] * bfhi(c.x); s += xf[10] * bflo(c.y); s += xf[11] * bfhi(c.y); s += xf[12] * bflo(c.z); s += xf[13] * bfhi(c.z); s += xf[14] * bflo(c.w); s += xf[15] * bfhi(c.w);
                d[k] = s; }
            float e4[4], e2[2], e1;
#pragma unroll
            for (int k = 0; k < 4; ++k) { const float keep = (lane & 1) ? d[2 * k + 1] : d[2 * k], send = (lane & 1) ? d[2 * k] : d[2 * k + 1]; e4[k] = keep + __shfl_xor(send, 1); }
#pragma unroll
            for (int k = 0; k < 2; ++k) { const float keep = (lane & 2) ? e4[2 * k + 1] : e4[2 * k], send = (lane & 2) ? e4[2 * k] : e4[2 * k + 1]; e2[k] = keep + __shfl_xor(send, 2); }
            { const float keep = (lane & 4) ? e2[1] : e2[0], send = (lane & 4) ? e2[0] : e2[1]; e1 = keep + __shfl_xor(send, 4); }
            e1 += __shfl_xor(e1, 8); e1 += __shfl_xor(e1, 16); e1 += __shfl_xor(e1, 32);
            const float gate = __shfl(gv, jb + (lane & 7));
            const float act = gelu_tanh(e1) * gate;
#pragma unroll
            for (int k = 0; k < 8; ++k) { const float cf = __uint_as_float((unsigned)__builtin_amdgcn_readlane((int)__float_as_uint(act), k));
                const v4u a = *(const GAS v4u*)(V + (size_t)ei[k] * DM + 8 * lane), c = *(const GAS v4u*)(V + (size_t)ei[k] * DM + 512 + 8 * lane);
                out[0] += cf * bflo(a.x); out[1] += cf * bfhi(a.x); out[2] += cf * bflo(a.y); out[3] += cf * bfhi(a.y); out[4] += cf * bflo(a.z); out[5] += cf * bfhi(a.z); out[6] += cf * bflo(a.w); out[7] += cf * bfhi(a.w);
                out[8] += cf * bflo(c.x); out[9] += cf * bfhi(c.x); out[10] += cf * bflo(c.y); out[11] += cf * bfhi(c.y); out[12] += cf * bflo(c.z); out[13] += cf * bfhi(c.z); out[14] += cf * bflo(c.w); out[15] += cf * bfhi(c.w); }
        }
#ifdef DBG_NEG_PEER
#pragma unroll
        for (int i = 0; i < 16; ++i) out[i] = -out[i];
#endif
#ifdef DBG_SKIP_PEER
#pragma unroll
        for (int i = 0; i < 16; ++i) out[i] = 0.f;
#endif
        const float* g2 = mod + ((size_t)layer * 4 + b) * 6144 + 5 * DM;
        float* xr = X + (size_t)t * DM; float xn[16]; float ss = 0.f;
#pragma unroll
        for (int hlf = 0; hlf < 2; ++hlf)
#pragma unroll
            for (int q = 0; q < 2; ++q) { const int col = 512 * hlf + 8 * lane + 4 * q; const f32x4 xv = *(const GAS f32x4*)(xr + col), gg = *(const GAS f32x4*)(g2 + col);
                f32x4 r; r.x = xv.x + gg.x * out[8 * hlf + 4 * q]; r.y = xv.y + gg.y * out[8 * hlf + 4 * q + 1]; r.z = xv.z + gg.z * out[8 * hlf + 4 * q + 2]; r.w = xv.w + gg.w * out[8 * hlf + 4 * q + 3];
                *(GAS f32x4*)(xr + col) = r; xn[8 * hlf + 4 * q] = r.x; xn[8 * hlf + 4 * q + 1] = r.y; xn[8 * hlf + 4 * q + 2] = r.z; xn[8 * hlf + 4 * q + 3] = r.w;
                ss += (r.x * r.x + r.y * r.y) + (r.z * r.z + r.w * r.w); }
        const float rstd = 1.f / sqrtf(wave_sum(ss) * (1.f / DM) + RMS_EPS);
        if (layer + 1 < DEPTH) {
            const float* gn = F.inp(I_NMIX) + (size_t)(layer + 1) * DM; const float* mb = mod + ((size_t)(layer + 1) * 4 + b) * 6144;
#pragma unroll
            for (int hlf = 0; hlf < 2; ++hlf) { const int col = 512 * hlf + 8 * lane; float y[8];
#pragma unroll
                for (int q = 0; q < 8; ++q) y[q] = xn[8 * hlf + q] * rstd * gn[col + q] * (1.f + mb[DM + col + q]) + mb[col + q];
                v4u w; w.x = pk2(y[0], y[1]); w.y = pk2(y[2], y[3]); w.z = pk2(y[4], y[5]); w.w = pk2(y[6], y[7]); *(GAS v4u*)(Hn + (size_t)t * DM + col) = w; }
        } else {
            const float* gn = F.inp(I_NFIN);
#pragma unroll
            for (int hlf = 0; hlf < 2; ++hlf)
#pragma unroll
                for (int q = 0; q < 2; ++q) { const int col = 512 * hlf + 8 * lane + 4 * q; const f32x4 gg = *(const GAS f32x4*)(gn + col);
                    f32x4 r; r.x = xn[8 * hlf + 4 * q] * rstd * gg.x; r.y = xn[8 * hlf + 4 * q + 1] * rstd * gg.y; r.z = xn[8 * hlf + 4 * q + 2] * rstd * gg.z; r.w = xn[8 * hlf + 4 * q + 3] * rstd * gg.w;
                    *(GAS f32x4*)(F.out + (size_t)t * DM + col) = r; }
        }
    }
}
namespace pg8 {
struct EpiResid {
    static constexpr bool PERM = false, AFTER_DRAIN = false;
    const float* xin; float* xout; const float* gate; float mul;
    __device__ __forceinline__ void operator()(const f32x4 (&acc)[2][2][4][2], const Unit& u, int wr, int wc, int fr, int fq) const {
        const int col0 = u.pn * BM + wc * 32 + 4 * fq; const float* gb = gate + (size_t)((u.pm * BM) / 4096) * 6144 + col0;
        f32x4 gv[2][2];
#pragma unroll
        for (int bj = 0; bj < 2; ++bj)
#pragma unroll
            for (int n = 0; n < 2; ++n) gv[bj][n] = *(const f32x4*)(gb + bj * HALF + n * 16);
#pragma unroll
        for (int ai = 0; ai < 2; ++ai)
#pragma unroll
            for (int m = 0; m < 4; ++m) { const size_t off = (size_t)(u.pm * BM + ai * HALF + wr * 64 + m * 16 + fr) * 1024 + col0;
#pragma unroll
                for (int bj = 0; bj < 2; ++bj)
#pragma unroll
                    for (int n = 0; n < 2; ++n) { const f32x4 xv = *(const f32x4*)(xin + off + bj * HALF + n * 16); *(f32x4*)(xout + off + bj * HALF + n * 16) = xv + gv[bj][n] * acc[ai][bj][m][n] * mul; } }
    }
};
}

struct Args { const float* in[22]; float* out; unsigned char* ws; int stop_after; int pad; };
__global__ void __launch_bounds__(NTHR, 2) fwd_megakernel(Args args) {
    extern __shared__ __attribute__((aligned(16))) unsigned char lds[];
    Frame F;
    F.lds = (LAS unsigned char*)lds;
    F.MISC = (volatile LAS unsigned*)(F.lds + MISC_OFF);
    F.G = gridDim.x; { const int bx = blockIdx.x; F.vcu0 = (F.G % 8 == 0) ? (bx % 8) * (F.G / 8) + bx / 8 : bx; }
    F.ka0 = (const KAS char*)__builtin_amdgcn_kernarg_segment_ptr();
    PHASE_BEGIN(F);
    for (int u = F.tid; u < (LDS_BYTES - MISC_OFF) / 4; u += NTHR) ((LAS unsigned*)(F.lds + MISC_OFF))[u] = 0u;
    __syncthreads();
    XcdBarrier bar = xcd_barrier_post((unsigned*)(F.ctl + CW_BAR), F.MISC + 8);
#define GRID_BAR() xcd_barrier(bar)

    p0_transposes(F);
    p0_fused_weights(F);
    p0_mod(F);
    conv_peer_tables(F, 0);
    GRID_BAR();
    norm_mod_phase(F, nullptr, 0, 0);
    GRID_BAR();

    for (int layer = 0; layer < DEPTH; ++layer) {
        const int half = layer >> 1; const bool even = (layer & 1) == 0;
        PHASE_BEGIN(F);
        bf16* Hb = (bf16*)(F.ws + WS_H); bf16* Pb = (bf16*)(F.ws + WS_P);
        if (even) { pg8::Gemm g{Hb, (const bf16*)(F.ws + WS_WEIN) + (size_t)half * NE * DM, T, NE, DM}; pg8::StaticOrder S; S.init(T, NE, F.G, (int)blockIdx.x);
            pg8::EpiBf16<0> E{Pb, NE, nullptr, 0, 0, 1.f}; pg8::gemm_phase<pg8::EpiBf16<0>, pg8::StaticOrder, true, true>(F.lds, g, S, E); }
        else { pg8::Gemm g{Hb, (const bf16*)(F.ws + WS_WOIN) + (size_t)half * NO * DM, T, NO, DM}; pg8::StaticOrder S; S.init(T, NO, F.G, (int)blockIdx.x);
            pg8::EpiBf16<0> E{Pb, NO, nullptr, 0, 0, 1.f}; pg8::gemm_phase<pg8::EpiBf16<0>, pg8::StaticOrder, true, true>(F.lds, g, S, E); }
        GRID_BAR();
        if (even) {
            ckv_norm_phase(F, half);
            topk_phase(F);
            diff_phase(F);
            GRID_BAR();
            sparse_phase(F, half);
        } else {
            fcum_phase(F, half);
            GRID_BAR();
            fox_phase(F);
        }
        GRID_BAR();
        { PHASE_BEGIN(F); bf16* AOb = (bf16*)(F.ws + WS_AO); float* Xb = (float*)(F.ws + WS_X); const float* mod = (const float*)(F.ws + WS_MOD);
          const float* xin = (layer == 0) ? F.inp(I_X) : Xb; const float* g1 = mod + (size_t)layer * 4 * 6144 + 2 * DM;
          pg8::EpiResid E{xin, Xb, g1, 1.f};
#ifdef DBG_SKIP_EVEN_MIX
          if (even) E.mul = 0.f;
#endif
#ifdef DBG_SKIP_ODD_MIX
          if (!even) E.mul = 0.f;
#endif
          if (even) { pg8::Gemm g{AOb, (const bf16*)(F.ws + WS_WEOUT) + (size_t)half * DM * KEO, T, DM, KEO}; pg8::StaticOrder S; S.init(T, DM, F.G, (int)blockIdx.x);
              pg8::gemm_phase<pg8::EpiResid, pg8::StaticOrder, false, true>(F.lds, g, S, E); }
          else { pg8::Gemm g{AOb, (const bf16*)(F.ws + WS_WOOUT) + (size_t)half * DM * DM, T, DM, DM}; pg8::StaticOrder S; S.init(T, DM, F.G, (int)blockIdx.x);
              pg8::gemm_phase<pg8::EpiResid, pg8::StaticOrder, false, true>(F.lds, g, S, E); } }
        GRID_BAR();
        norm_mod_phase(F, nullptr, layer, 1);
        if (layer > 0) conv_peer_tables(F, layer);
        GRID_BAR();
        { PHASE_BEGIN(F); bf16* Hb = (bf16*)(F.ws + WS_H); bf16* Pb = (bf16*)(F.ws + WS_P);
          pg8::Gemm g{Hb, (const bf16*)(F.ws + WS_WPQ) + (size_t)layer * 2048 * DM, T, 2048, DM}; pg8::StaticOrder S; S.init(T, 2048, F.G, (int)blockIdx.x);
          pg8::EpiBf16<0> E{Pb, 2048, nullptr, 0, 0, 1.f}; pg8::gemm_phase<pg8::EpiBf16<0>, pg8::StaticOrder, true, true>(F.lds, g, S, E); }
        GRID_BAR();
        peer_route_phase(F, layer);
        GRID_BAR();
        peer_expert_phase(F, layer);
        if (layer + 1 < DEPTH) GRID_BAR();
    }
#undef GRID_BAR
}

extern "C" void kernel_launch(void* const* d_in, const int* in_sizes, int n_in, void* d_out, int out_size, void* d_ws, size_t ws_size, hipStream_t stream) {
    static int grid = 0;
    if (grid == 0) {
        if (n_in != 22 || in_sizes[0] != T * DM || out_size != T * DM || ws_size < WS_END) { fprintf(stderr, "kernel_launch: unexpected problem (n_in %d, in0 %d, out %d, ws %zu)\n", n_in, n_in > 0 ? in_sizes[0] : -1, out_size, ws_size); grid = -1; return; }
        int dev = 0, cus = 0, per_cu = 0;
        if (hipGetDevice(&dev) != hipSuccess || hipDeviceGetAttribute(&cus, hipDeviceAttributeMultiprocessorCount, dev) != hipSuccess) { grid = -1; return; }
        if (hipFuncSetAttribute((const void*)fwd_megakernel, hipFuncAttributeMaxDynamicSharedMemorySize, LDS_BYTES) != hipSuccess) { fprintf(stderr, "kernel_launch: hipFuncSetAttribute failed\n"); grid = -1; return; }
        if (hipOccupancyMaxActiveBlocksPerMultiprocessor(&per_cu, (const void*)fwd_megakernel, NTHR, LDS_BYTES) != hipSuccess || per_cu < 1) fprintf(stderr, "kernel_launch: occupancy query says %d\n", per_cu);
        (void)hipGetLastError();
        grid = cus;
    }
    if (grid < 0) return;
    if (hipMemsetAsync((char*)d_ws + WS_CTL, 0, CTL_ZERO_BYTES, stream) != hipSuccess) return;
    Args a{};
    for (int i = 0; i < 22; ++i) a.in[i] = (const float*)d_in[i];
    a.out = (float*)d_out; a.ws = (unsigned char*)d_ws; a.stop_after = 0; a.pad = 0;
    hipLaunchKernelGGL(fwd_megakernel, dim3(grid), dim3(NTHR), LDS_BYTES, stream, a);
}
```

```cpp
#include <hip/hip_runtime.h>
#include <hip/hip_bf16.h>
#include <cstdio>
#include <cstdint>
#include <cmath>
namespace pg8 {
#define PG8_LAS __attribute__((address_space(3)))
typedef unsigned short bf16_t;
typedef short bf16x8 __attribute__((ext_vector_type(8)));
typedef float f32x4 __attribute__((ext_vector_type(4)));
typedef unsigned u32x4 __attribute__((ext_vector_type(4)));
constexpr int BM = 256, BK = 64, HALF = 128, HTB = HALF * BK * 2  , STAGE_BYTES = 8 * HTB, NXCD = 8, WGM = 8;

__host__ __device__ __forceinline__ int lds_byte(int r, int c) { const int st = (r >> 4) * 2 + (c >> 5), rr = r & 15, cc = c & 31, ob = rr * 64 + cc * 2; return st * 1024 + (ob ^ (((ob >> 9) & 1) << 5)); }
__host__ __device__ __forceinline__ void stage_rc(int b, int& R, int& C) { const int st = b / 1024, sb = b % 1024, swz = sb ^ (((sb >> 9) & 1) << 5); R = (st >> 1) * 16 + swz / 64; C = (st & 1) * 32 + (swz % 64) / 2; }
__host__ __device__ __forceinline__ int perm32(int rho) { const int n = rho >> 4, i = rho & 15; return 8 * (i >> 2) + 4 * n + (i & 3); }

struct Unit { int pm, pn; };
struct Gemm { const bf16_t* A; const bf16_t* Bt; int M, N, K; };

struct StaticOrder {
    int nM, nN, nwg, G, c;
    __host__ __device__ void init(int M, int N, int G_, int c_) { nM = M / BM; nN = N / BM; nwg = nM * nN; G = G_; c = c_; }
    __host__ __device__ bool next(int i, Unit& u) const {
        const long L = (long)i * G + c; if (L >= nwg) return false;
        int wgid = (int)L; { const int q = nwg / NXCD, r = nwg % NXCD, xcd = wgid % NXCD, off = wgid / NXCD; wgid = (xcd < r ? xcd * (q + 1) : r * (q + 1) + (xcd - r) * q) + off; }
        const int nig = WGM * nN, gid = wgid / nig, fm = gid * WGM, gsz = (nM - fm) < WGM ? (nM - fm) : WGM;
        u.pm = fm + ((wgid % nig) % gsz); u.pn = (wgid % nig) / gsz; return true;
    }
    __device__ __forceinline__ void a_ready(const Unit&) const {}
    __device__ __forceinline__ void done(const Unit&) const {}
};

__device__ __forceinline__ unsigned cvt_pk_bf16(float lo, float hi) { unsigned r; asm volatile("v_cvt_pk_bf16_f32 %0, %1, %2" : "=v"(r) : "v"(lo), "v"(hi)); return r; }
typedef float f32x2 __attribute__((ext_vector_type(2)));
__device__ __forceinline__ f32x2 gelu_pk(f32x2 v) {
    const f32x2 av = __builtin_elementwise_abs(v), d = av * 0.2316418882f + 1.0f;
    f32x2 t; t.x = __builtin_amdgcn_rcpf(d.x); t.y = __builtin_amdgcn_rcpf(d.y);
    f32x2 q = t * 0.5307027145f + (-0.7265760135f); q = q * t + 0.7107068705f; q = q * t + (-0.142248368f); q = q * t + 0.127414796f; q = q * t;
    const f32x2 s = (v * v) * (-0.72134752044f);
    f32x2 e; e.x = __builtin_amdgcn_exp2f(s.x); e.y = __builtin_amdgcn_exp2f(s.y);
    const f32x2 m = v * (q * e), r = v - m;
    f32x2 o; o.x = v.x < 0.f ? m.x : r.x; o.y = v.y < 0.f ? m.y : r.y; return o;
}

template <int ACT  > struct EpiBf16 {
    static constexpr bool PERM = true, AFTER_DRAIN = false; static_assert(ACT == 0 || ACT == 1, "EpiBf16: ACT is 0 (none) or 1 (gelu_pk)");
    bf16_t* O; int ldc; const float* bias; int split_cols; size_t split_stride; float scale0;
    __device__ __forceinline__ void operator()(const f32x4 (&acc)[2][2][4][2], const Unit& u, int wr, int wc, int fr, int fq) const {
        const int row0 = u.pm * BM + wr * 64 + fr; int colt = u.pn * BM; bf16_t* base = O;
        float sc = 1.f; if (split_cols) { const int t = colt / split_cols; base += (size_t)t * split_stride; colt -= t * split_cols; if (t == 0) sc = scale0; }
        const int col0 = colt + wc * 32 + 8 * fq, bcol0 = u.pn * BM + wc * 32 + 8 * fq;
        f32x4 bv[2][2];
#pragma unroll
        for (int bj = 0; bj < 2; ++bj)
#pragma unroll
            for (int n = 0; n < 2; ++n) bv[bj][n] = bias ? *(const f32x4*)(bias + bcol0 + bj * HALF + 4 * n) : (f32x4){0.f, 0.f, 0.f, 0.f};
#pragma unroll
        for (int ai = 0; ai < 2; ++ai)
#pragma unroll
            for (int m = 0; m < 4; ++m) { bf16_t* rowp = base + (size_t)(row0 + ai * HALF + m * 16) * ldc + col0;
#pragma unroll
                for (int bj = 0; bj < 2; ++bj) { f32x4 v0 = acc[ai][bj][m][0] + bv[bj][0], v1 = acc[ai][bj][m][1] + bv[bj][1];
                    if (ACT == 1) { f32x2 a = gelu_pk((f32x2){v0[0], v0[1]}), b = gelu_pk((f32x2){v0[2], v0[3]}), c = gelu_pk((f32x2){v1[0], v1[1]}), d = gelu_pk((f32x2){v1[2], v1[3]});
                        v0 = (f32x4){a.x, a.y, b.x, b.y}; v1 = (f32x4){c.x, c.y, d.x, d.y}; }
                    v0 = v0 * sc; v1 = v1 * sc; u32x4 w; w.x = cvt_pk_bf16(v0[0], v0[1]); w.y = cvt_pk_bf16(v0[2], v0[3]); w.z = cvt_pk_bf16(v1[0], v1[1]); w.w = cvt_pk_bf16(v1[2], v1[3]);
                    *(u32x4*)(rowp + bj * HALF) = w; } }
    }
};
template <class Epi, class Sched, bool ALIGN_EPI = false, bool SP2 = false>
__device__ __forceinline__ void gemm_phase(PG8_LAS unsigned char* lds, const Gemm g, const Sched& S, const Epi& E, int tid_in) {
    const int tid = tid_in, wid = __builtin_amdgcn_readfirstlane(tid >> 6), lane = tid & 63, wr = wid >> 2, wc = wid & 3, fr = lane & 15, fq = lane >> 4;
    const int K = g.K, nt = K / BK;
    unsigned voffA[2], voffB[2];
#pragma unroll
    for (int i = 0; i < 2; ++i) { int R, C; stage_rc(tid * 16 + i * 8192, R, C); const int Rb = Epi::PERM ? ((R & ~31) + perm32(R & 31)) : R;
        voffA[i] = (unsigned)(R * K + C) * 2u; voffB[i] = (unsigned)(Rb * K + C) * 2u; }
    const size_t kstep = (size_t)(BK * 2);
    const size_t hstep = (size_t)HALF * K * 2;
    const size_t tstep = 2 * hstep;
    const unsigned ldsw = (unsigned)wid * 1024u;
    const int aoff = lds_byte(wr * 64 + fr, fq * 8), boff = lds_byte(wc * 32 + fr, fq * 8);
#define PG8_SA(b, h) (((b) * 2 + (h)) * HTB)
#define PG8_SB(b, h) ((4 + (b) * 2 + (h)) * HTB)
#define PG8_STAGE(bufoff, gbase, voff) do { _Pragma("unroll") for (int _i = 0; _i < 2; ++_i) \
        __builtin_amdgcn_global_load_lds((const unsigned*)((const char*)(gbase) + (voff)[_i]), (PG8_LAS unsigned*)(lds + (bufoff) + ldsw + _i * 8192), 16, 0, 0); } while (0)
#define PG8_LDA(dst, b, h) do { _Pragma("unroll") for (int m = 0; m < 4; ++m) _Pragma("unroll") for (int k = 0; k < 2; ++k) dst[m][k] = *(const PG8_LAS bf16x8*)(lds + PG8_SA(b, h) + aoff + m * 2048 + k * 1024); } while (0)
#define PG8_LDB(dst, b, h) do { _Pragma("unroll") for (int n = 0; n < 2; ++n) _Pragma("unroll") for (int k = 0; k < 2; ++k) dst[n][k] = *(const PG8_LAS bf16x8*)(lds + PG8_SB(b, h) + boff + n * 2048 + k * 1024); } while (0)
#define PG8_MMA(ai, bj, At, Bt) do { __builtin_amdgcn_s_setprio(1); _Pragma("unroll") for (int m = 0; m < 4; ++m) _Pragma("unroll") for (int n = 0; n < 2; ++n) _Pragma("unroll") for (int k = 0; k < 2; ++k) \
        acc[ai][bj][m][n] = __builtin_amdgcn_mfma_f32_16x16x32_bf16(Bt[n][k], At[m][k], acc[ai][bj][m][n], 0, 0, 0); __builtin_amdgcn_s_setprio(0); } while (0)
#define PG8_WAIT_V(n) asm volatile("s_waitcnt vmcnt(" #n ")" ::: "memory")
#define PG8_WAIT_L(n) asm volatile("s_waitcnt lgkmcnt(" #n ")" ::: "memory")
#define PG8_BAR __builtin_amdgcn_s_barrier()
#define PG8_SCHED __builtin_amdgcn_sched_barrier(0)
    Unit cur, nxt; int ui = 0;
    if (!S.next(0, cur)) return;
    f32x4 acc[2][2][4][2];
#pragma unroll
    for (int a = 0; a < 2; ++a)
#pragma unroll
        for (int b = 0; b < 2; ++b)
#pragma unroll
            for (int m = 0; m < 4; ++m)
#pragma unroll
                for (int n = 0; n < 2; ++n) acc[a][b][m][n] = (f32x4){0.f, 0.f, 0.f, 0.f};
    bf16x8 At[4][2], B0[2][2], B1[2][2];
    const char* cA = (const char*)g.A + (size_t)cur.pm * tstep; const char* cB = (const char*)g.Bt + (size_t)cur.pn * tstep;
    S.a_ready(cur);
    if constexpr (SP2) {
        PG8_STAGE(PG8_SB(0, 0), cB, voffB); PG8_STAGE(PG8_SB(0, 1), cB + hstep, voffB); PG8_STAGE(PG8_SA(0, 0), cA, voffA); PG8_STAGE(PG8_SA(0, 1), cA + hstep, voffA);
        if (wr == 1) PG8_BAR;
        PG8_WAIT_V(2); PG8_BAR;
        PG8_STAGE(PG8_SB(1, 0), cB + kstep, voffB); PG8_STAGE(PG8_SA(1, 0), cA + kstep, voffA); PG8_STAGE(PG8_SB(1, 1), cB + hstep + kstep, voffB);
        PG8_WAIT_V(6); PG8_BAR;
    } else {
        PG8_STAGE(PG8_SB(0, 0), cB, voffB); PG8_STAGE(PG8_SA(0, 0), cA, voffA); PG8_STAGE(PG8_SB(0, 1), cB + hstep, voffB); PG8_STAGE(PG8_SA(0, 1), cA + hstep, voffA);
        if (wr == 1) PG8_BAR;
        PG8_WAIT_V(4); PG8_BAR;
        PG8_STAGE(PG8_SB(1, 0), cB + kstep, voffB); PG8_STAGE(PG8_SA(1, 0), cA + kstep, voffA); PG8_STAGE(PG8_SB(1, 1), cB + hstep + kstep, voffB);
        PG8_WAIT_V(6); PG8_BAR;
    }
    for (;;) {
        const bool has_next = S.next(ui + 1, nxt);
        const char* nA = has_next ? (const char*)g.A + (size_t)nxt.pm * tstep : cA; const char* nB = has_next ? (const char*)g.Bt + (size_t)nxt.pn * tstep : cB;
        for (int t = 0; t < nt; t += 2) {
            const bool last = (t == nt - 2);
            const char* a1 = cA + (size_t)(t + 1) * kstep;
            const char* a2 = last ? nA : cA + (size_t)(t + 2) * kstep; const char* b2 = last ? nB : cB + (size_t)(t + 2) * kstep;
            const char* a3 = a2 + kstep; const char* b3 = b2 + kstep;
            if (last && has_next) S.a_ready(nxt);
            if constexpr (SP2) {
            PG8_LDB(B0, 0, 0); PG8_LDB(B1, 0, 1); PG8_SCHED; PG8_LDA(At, 0, 0); PG8_STAGE(PG8_SA(1, 1), a1 + hstep, voffA);
            PG8_WAIT_V(8); PG8_WAIT_L(0); PG8_BAR; PG8_MMA(0, 0, At, B0); PG8_MMA(0, 1, At, B1); PG8_BAR; PG8_SCHED;
            PG8_LDA(At, 0, 1); PG8_STAGE(PG8_SB(0, 0), b2, voffB); PG8_STAGE(PG8_SB(0, 1), b2 + hstep, voffB); PG8_STAGE(PG8_SA(0, 0), a2, voffA);
            PG8_WAIT_V(8); PG8_WAIT_L(0); PG8_BAR; PG8_MMA(1, 0, At, B0); PG8_MMA(1, 1, At, B1); PG8_BAR; PG8_SCHED;
            PG8_LDB(B0, 1, 0); PG8_LDB(B1, 1, 1); PG8_SCHED; PG8_LDA(At, 1, 0); PG8_STAGE(PG8_SA(0, 1), a2 + hstep, voffA);
            PG8_WAIT_V(8); PG8_WAIT_L(0); PG8_BAR; PG8_MMA(0, 0, At, B0); PG8_MMA(0, 1, At, B1); PG8_BAR; PG8_SCHED;
            PG8_LDA(At, 1, 1); PG8_STAGE(PG8_SB(1, 0), b3, voffB); PG8_STAGE(PG8_SB(1, 1), b3 + hstep, voffB); PG8_STAGE(PG8_SA(1, 0), a3, voffA);
            PG8_WAIT_V(8); PG8_WAIT_L(0); PG8_BAR; PG8_MMA(1, 0, At, B0); PG8_MMA(1, 1, At, B1); PG8_BAR; PG8_SCHED;
            } else {
            PG8_LDB(B0, 0, 0); PG8_SCHED; PG8_LDA(At, 0, 0); PG8_STAGE(PG8_SA(1, 1), a1 + hstep, voffA);
            PG8_WAIT_L(8); PG8_BAR; PG8_WAIT_L(0); PG8_MMA(0, 0, At, B0); PG8_BAR; PG8_SCHED;
            PG8_LDB(B1, 0, 1); PG8_STAGE(PG8_SB(0, 0), b2, voffB);
            PG8_BAR; PG8_WAIT_L(0); PG8_MMA(0, 1, At, B1); PG8_BAR;
            PG8_LDA(At, 0, 1); PG8_STAGE(PG8_SA(0, 0), a2, voffA);
            PG8_BAR; PG8_WAIT_L(0); PG8_MMA(1, 0, At, B0); PG8_BAR; PG8_SCHED;
            PG8_STAGE(PG8_SB(0, 1), b2 + hstep, voffB);
            PG8_WAIT_V(6); PG8_BAR; PG8_MMA(1, 1, At, B1); PG8_BAR;
            PG8_LDB(B0, 1, 0); PG8_SCHED; PG8_LDA(At, 1, 0); PG8_STAGE(PG8_SA(0, 1), a2 + hstep, voffA);
            PG8_WAIT_L(8); PG8_BAR; PG8_WAIT_L(0); PG8_MMA(0, 0, At, B0); PG8_BAR; PG8_SCHED;
            PG8_LDB(B1, 1, 1); PG8_STAGE(PG8_SB(1, 0), b3, voffB);
            PG8_BAR; PG8_WAIT_L(0); PG8_MMA(0, 1, At, B1); PG8_BAR;
            PG8_LDA(At, 1, 1); PG8_STAGE(PG8_SA(1, 0), a3, voffA);
            PG8_BAR; PG8_WAIT_L(0); PG8_MMA(1, 0, At, B0); PG8_BAR; PG8_SCHED;
            PG8_STAGE(PG8_SB(1, 1), b3 + hstep, voffB);
            PG8_WAIT_V(6); PG8_BAR; PG8_MMA(1, 1, At, B1); PG8_BAR;
            }
        }
        if constexpr (ALIGN_EPI) { if (wr == 0) PG8_BAR; }
        if constexpr (!Epi::AFTER_DRAIN) { E(acc, cur, wr, wc, fr, fq); S.done(cur); }
        if (!has_next) break;
#pragma unroll
        for (int a = 0; a < 2; ++a)
#pragma unroll
            for (int b = 0; b < 2; ++b)
#pragma unroll
                for (int m = 0; m < 4; ++m)
#pragma unroll
                    for (int n = 0; n < 2; ++n) acc[a][b][m][n] = (f32x4){0.f, 0.f, 0.f, 0.f};
        cur = nxt; cA = nA; cB = nB; ++ui;
        if constexpr (ALIGN_EPI) { if (wr == 1) PG8_BAR; }
    }
    PG8_WAIT_V(0);
    if constexpr (!ALIGN_EPI) { if (wr == 0) PG8_BAR; }
    PG8_BAR;
    if constexpr (Epi::AFTER_DRAIN) { E.fused(acc, cur, wr, wc, fr, fq, lds, wid, lane); S.done(cur); }
#undef PG8_SA
#undef PG8_SB
#undef PG8_STAGE
#undef PG8_LDA
#undef PG8_LDB
#undef PG8_MMA
#undef PG8_WAIT_V
#undef PG8_WAIT_L
#undef PG8_BAR
#undef PG8_SCHED
}
}
#define GAS __attribute__((address_space(1)))
#define LAS __attribute__((address_space(3)))
typedef unsigned short bf16;
typedef unsigned v4u __attribute__((ext_vector_type(4)));
typedef float f32x4 __attribute__((ext_vector_type(4)));
typedef short bf16x8 __attribute__((ext_vector_type(8)));
typedef GAS unsigned gu32;
typedef GAS unsigned long long gu64;
#define RLX_AGENT __ATOMIC_RELAXED, __HIP_MEMORY_SCOPE_AGENT
#define LDS_WAIT() asm volatile("s_waitcnt lgkmcnt(0)" ::: "memory")
#define VM_WAIT() asm volatile("s_waitcnt vmcnt(0)" ::: "memory")
__device__ __forceinline__ unsigned long long rt() { return __builtin_amdgcn_s_memrealtime(); }
__device__ __forceinline__ unsigned f2bf(float f) { unsigned u = __builtin_bit_cast(unsigned, f); return (u + 0x7fffu + ((u >> 16) & 1u)) >> 16; }
__device__ __forceinline__ unsigned pk2(float lo, float hi) { return f2bf(lo) | (f2bf(hi) << 16); }

#define XB_TMO      128
#define XB_XCNT(j)  (256  + 64 * (j))
#define XB_XSUB(j)  (1280 + 64 * (j))
#define XB_XGEN(j)  (2304 + 64 * (j))
#define XB_TOP      3328
#define XB_TOPGEN   3392
#define XCD_BAR_WORDS 3456
#define XB_SPIN_CAP (1u << 18)

__device__ __forceinline__ unsigned xb_ld(unsigned* p)              { return __hip_atomic_load(p, __ATOMIC_RELAXED, __HIP_MEMORY_SCOPE_AGENT); }
__device__ __forceinline__ unsigned xb_add(unsigned* p, unsigned v) { return __hip_atomic_fetch_add(p, v, __ATOMIC_RELAXED, __HIP_MEMORY_SCOPE_AGENT); }
__device__ __forceinline__ unsigned xb_xcc_id() { return (unsigned)__builtin_amdgcn_s_getreg((3 << 11) | 20) & 0xFu; }
#define XB_SPIN(cond, bar) do { unsigned _sp = 0; while (cond) { __builtin_amdgcn_s_sleep(1); \
    if ((++_sp & 255u) == 0u) { if (xb_ld(&(bar)[XB_TMO])) break; if (_sp > XB_SPIN_CAP) { atomicAdd(&(bar)[XB_TMO], 1u); break; } } } } while (0)

struct XcdBarrier {
    unsigned* bar; unsigned x;
    volatile LAS unsigned* st;
};

__device__ __forceinline__ XcdBarrier xcd_barrier_post(unsigned* bar, volatile LAS unsigned* st) {
    XcdBarrier b; b.bar = bar; b.x = xb_xcc_id(); b.st = st;
    if (threadIdx.x == 0) (void)xb_add(&bar[XB_XCNT(b.x)], 1u);
    return b;
}
__device__ __forceinline__ void xcd_barrier_complete(unsigned* bar, unsigned x, unsigned& nloc, unsigned& nx) {
    const unsigned G = gridDim.x * gridDim.y * gridDim.z;
    unsigned sum, cnt, mine, sp = 0u;
    for (;;) {
        sum = 0u; cnt = 0u; mine = 0u;
#pragma unroll
        for (unsigned j = 0; j < 16; ++j) { const unsigned c = xb_ld(&bar[XB_XCNT(j)]); sum += c; cnt += (c > 0u) ? 1u : 0u; mine = (j == x) ? c : mine; }
        if (sum == G) break;
        __builtin_amdgcn_s_sleep(1);
        if ((++sp & 255u) == 0u) { if (xb_ld(&bar[XB_TMO])) break; if (sp > XB_SPIN_CAP) { atomicAdd(&bar[XB_TMO], 1u); break; } }
    }
    nloc = mine > 0u ? mine : 1u; nx = cnt > 0u ? cnt : 1u;
}

__device__ __forceinline__ void xcd_barrier(const XcdBarrier& b) {
    asm volatile("s_waitcnt vmcnt(0)" ::: "memory");
    __syncthreads();
    if (threadIdx.x == 0) {
        unsigned* bar = b.bar;
        __builtin_amdgcn_s_waitcnt(0);
        unsigned nloc = b.st[0], nx = b.st[1];
        if (nloc == 0u) { xcd_barrier_complete(bar, b.x, nloc, nx); b.st[0] = nloc; b.st[1] = nx; }
        const unsigned old = xb_add(&bar[XB_XSUB(b.x)], 1u);
        const unsigned gen = old / nloc;
        if (old + 1u == (gen + 1u) * nloc) {
            __builtin_amdgcn_fence(__ATOMIC_RELEASE, "agent");
            asm volatile("s_waitcnt vmcnt(0)" ::: "memory");
            const unsigned og = xb_add(&bar[XB_TOP], 1u);
            const unsigned tg = og / nx;
            if (og + 1u == (tg + 1u) * nx) xb_add(&bar[XB_TOPGEN], 1u);
            else XB_SPIN(xb_ld(&bar[XB_TOPGEN]) == tg, bar);
            __builtin_amdgcn_fence(__ATOMIC_ACQUIRE, "agent");
            xb_add(&bar[XB_XGEN(b.x)], 1u);
            asm volatile("s_waitcnt vmcnt(0)" ::: "memory");
        } else {
            XB_SPIN(xb_ld(&bar[XB_XGEN(b.x)]) == gen, bar);
            __builtin_amdgcn_fence(__ATOMIC_ACQUIRE, "agent");
            asm volatile("s_waitcnt vmcnt(0)" ::: "memory");
        }
    }
    __syncthreads();
}
constexpr int NB = 4, SEQ = 4096, T = NB * SEQ, DM = 1024, DEPTH = 4;
constexpr int NE = 4608, NO = 3328;
constexpr int EC_QLAT = 0, EC_CKV = 2048, EC_QI = 2304, EC_KI = 2816, EC_QB = 2880, EC_KB = 3392, EC_VB = 3904, EC_WI = 4416;
constexpr int OC_Q = 0, OC_K = 1024, OC_V = 2048, OC_F = 3072;
constexpr int KEO = 2560;
constexpr int EVEN_IN = 2888, ODD_IN = 3088;
constexpr float RMS_EPS = 1e-6f;
constexpr float LOG2E = 1.4426950408889634f;
constexpr float C2 = 0.125f * LOG2E;
constexpr int NWAVES = 8, NTHR = 512;

constexpr size_t MiB = 1u << 20;
constexpr size_t WS_CTL = 0, CTL_ZERO_BYTES = 1 * MiB;
constexpr size_t WS_MOD = 1 * MiB;
constexpr size_t WS_FCUM = 3 * MiB;
constexpr size_t WS_WEIN = 4 * MiB;
constexpr size_t WS_WOIN = 22 * MiB;
constexpr size_t WS_WEOUT = 35 * MiB;
constexpr size_t WS_WOOUT = 45 * MiB;
constexpr size_t WS_WPQ = 49 * MiB;
constexpr size_t WS_WSK = 65 * MiB;
constexpr size_t WS_PU = 66 * MiB, WS_PV = 98 * MiB;
constexpr size_t WS_U8 = 66 * MiB;
constexpr size_t WS_V8 = 82 * MiB;
constexpr size_t WS_SU = 98 * MiB, WS_SV = 99 * MiB;
constexpr size_t WS_ACT = 100 * MiB;
constexpr size_t WS_X = 130 * MiB;
constexpr size_t WS_H = 194 * MiB;
constexpr size_t WS_P = 226 * MiB;
constexpr size_t WS_AO = 370 * MiB;
constexpr size_t WS_CKV = 450 * MiB;
constexpr size_t WS_SEL = 458 * MiB;
constexpr size_t WS_PE = 466 * MiB;
constexpr size_t WS_PG = 474 * MiB;
constexpr size_t WS_END = 482 * MiB;
constexpr int CW_BAR = 4096;

constexpr int RING_BYTES = 131072;
constexpr int LDS_BYTES = 163840;
constexpr int MISC_OFF = LDS_BYTES - 512;
constexpr int XTRA_OFF = RING_BYTES;

__device__ __constant__ unsigned char T5_BUCKET[128] = {
  0, 1, 2, 3, 4, 5, 6, 7, 8, 9, 10, 11, 12, 13, 14, 15, 16, 16, 16, 17, 17, 18, 18, 18, 19, 19, 19, 20, 20, 20, 20, 21, 21, 21, 21, 22, 22, 22, 22, 22,
  23, 23, 23, 23, 23, 23, 24, 24, 24, 24, 24, 24, 25, 25, 25, 25, 25, 25, 25, 26, 26, 26, 26, 26, 26, 26, 26, 27, 27, 27, 27, 27, 27, 27, 27, 27, 27,
  28, 28, 28, 28, 28, 28, 28, 28, 28, 28, 29, 29, 29, 29, 29, 29, 29, 29, 29, 29, 29, 29, 30, 30, 30, 30, 30, 30, 30, 30, 30, 30, 30, 30, 30, 30,
  31, 31, 31, 31, 31, 31, 31, 31, 31, 31, 31, 31, 31, 31, 31};
__device__ __forceinline__ int t5_bucket(int d) { return d >= 128 ? 31 : (int)T5_BUCKET[d]; }
typedef float f32x16 __attribute__((ext_vector_type(16)));
typedef short s16x4 __attribute__((ext_vector_type(4)));
typedef unsigned u32x2 __attribute__((ext_vector_type(2)));
typedef unsigned u32x4 __attribute__((ext_vector_type(4)));
typedef int i32x4 __attribute__((ext_vector_type(4)));
#define KAS __attribute__((address_space(4)))
struct Frame {
    LAS unsigned char* lds;
    volatile LAS unsigned* MISC;
    gu32* ctl;
    int tid, lane, wave;
    int vcu, G, vcu0, wave0;
    unsigned char* ws;
    const KAS char* ka; const KAS char* ka0;
    float* out;
    __device__ __forceinline__ const float* inp(int i) const { return *(const float* const KAS*)(ka + 8 * i); }
};
#define PHASE_BEGIN(F) do { const KAS char* ka_ = (F).ka0; asm volatile("" : "+s"(ka_)); (F).ka = ka_; (F).out = *(float* const KAS*)(ka_ + 176); (F).ws = *(unsigned char* const KAS*)(ka_ + 184); \
    (F).ctl = (gu32*)((F).ws + WS_CTL); int t_ = threadIdx.x; asm volatile("" : "+v"(t_)); (F).tid = t_; (F).lane = t_ & 63; (F).wave = __builtin_amdgcn_readfirstlane(t_ >> 6); \
    int v_ = (F).vcu0; asm volatile("" : "+s"(v_)); (F).vcu = v_; } while (0)
__device__ __forceinline__ float wave_sum(float v) {
#pragma unroll
    for (int o = 1; o < 64; o <<= 1) v += __shfl_xor(v, o);
    return v;
}
__device__ __forceinline__ float bf2f(unsigned h) { return __uint_as_float(h << 16); }
__device__ __forceinline__ float bflo(unsigned w) { return __uint_as_float(w << 16); }
__device__ __forceinline__ float bfhi(unsigned w) { return __uint_as_float(w & 0xffff0000u); }
__device__ __forceinline__ float siluf(float x) { return x / (1.f + __expf(-x)); }
__device__ __forceinline__ float gelu_tanh(float x) {
    const float u = 0.7978845608028654f * (x + 0.044715f * x * x * x);
    const float e = __expf(2.f * u);
    const float th = 1.f - 2.f / (e + 1.f);
    return 0.5f * x * (1.f + th);
}
enum { I_X = 0, I_C, I_RELB, I_ADAW, I_ADAB, I_NMIX, I_NFFN, I_NFIN, I_EWIN, I_EWOUT, I_KVN, I_WUK, I_WUV, I_LAM, I_SUBLN, I_OWIN, I_BF, I_OWOUT, I_PWQ, I_PSK, I_PU, I_PV };

__device__ __forceinline__ void tr_item(const float* W, int ldw, int sc0, int ncols, bf16* WT, int ldt, int dr0, int dc0, float scale, LAS float* scr, int kb, int nb, int lane) {
    const int k0 = 64 * kb, n0 = 32 * nb;
    const int nn = lane & 31; const bool ok = (n0 + nn) < ncols;
#pragma unroll 8
    for (int i = 0; i < 32; ++i) { const int kk = 2 * i + (lane >> 5); scr[kk * 33 + nn] = ok ? W[(size_t)(k0 + kk) * ldw + sc0 + n0 + nn] * scale : 0.f; }
    LDS_WAIT(); asm volatile("" ::: "memory");
    const int c = lane & 7;
#pragma unroll
    for (int j = 0; j < 4; ++j) { const int n = (lane >> 3) + 8 * j; const LAS float* s = scr + (8 * c) * 33 + n;
        v4u o; o.x = pk2(s[0 * 33], s[1 * 33]); o.y = pk2(s[2 * 33], s[3 * 33]); o.z = pk2(s[4 * 33], s[5 * 33]); o.w = pk2(s[6 * 33], s[7 * 33]);
        if (n0 + n < ncols) *(GAS v4u*)(WT + (size_t)(dr0 + n0 + n) * ldt + dc0 + k0 + 8 * c) = o; }
    LDS_WAIT(); asm volatile("" ::: "memory");
}
struct TrJob { const float* W; int ldw, sc0, ncols, K; bf16* WT; int ldt, dr0, dc0; float scale; };
__device__ __forceinline__ TrJob get_trjob(const Frame& F, int j) {
    TrJob J;
    if (j < 14) { const int e = j / 7, s = j % 7;
        const int sc0[7] = {512, 768, 1280, 1344, 1352, 1864, 2376}; const int nc[7] = {256, 512, 64, 8, 512, 512, 512};
        const int dr[7] = {EC_CKV, EC_QI, EC_KI, EC_WI, EC_QB, EC_KB, EC_VB}; const float sc[7] = {1.f, 0.125f, 1.f, 0.35355339059327373f, C2, 1.f, 1.f};
        int a = 0, b = 0, c = 0; float d = 1.f;
#pragma unroll
        for (int q = 0; q < 7; ++q) if (q == s) { a = sc0[q]; b = nc[q]; c = dr[q]; d = sc[q]; }
        J.W = F.inp(I_EWIN) + (size_t)e * DM * EVEN_IN; J.ldw = EVEN_IN; J.sc0 = a; J.ncols = b; J.K = DM; J.WT = (bf16*)(F.ws + WS_WEIN) + (size_t)e * NE * DM; J.ldt = DM; J.dr0 = c; J.dc0 = 0; J.scale = d;
    } else if (j < 22) { const int o = (j - 14) / 4, s = (j - 14) % 4;
        J.W = F.inp(I_OWIN) + (size_t)o * DM * ODD_IN; J.ldw = ODD_IN; J.sc0 = 1024 * s; J.ncols = (s == 3) ? 16 : 1024; J.K = DM; J.WT = (bf16*)(F.ws + WS_WOIN) + (size_t)o * NO * DM; J.ldt = DM; J.dr0 = 1024 * s; J.dc0 = 0; J.scale = (s == 0) ? C2 : 1.f;
    } else if (j < 24) { const int e = j - 22;
        J.W = F.inp(I_EWOUT) + (size_t)e * DM * DM + (size_t)512 * DM; J.ldw = DM; J.sc0 = 0; J.ncols = DM; J.K = 512; J.WT = (bf16*)(F.ws + WS_WEOUT) + (size_t)e * DM * KEO; J.ldt = KEO; J.dr0 = 0; J.dc0 = 2048; J.scale = 1.f;
    } else if (j < 26) { const int o = j - 24;
        J.W = F.inp(I_OWOUT) + (size_t)o * DM * DM; J.ldw = DM; J.sc0 = 0; J.ncols = DM; J.K = DM; J.WT = (bf16*)(F.ws + WS_WOOUT) + (size_t)o * DM * DM; J.ldt = DM; J.dr0 = 0; J.dc0 = 0; J.scale = 1.f;
    } else { const int l = j - 26;
        J.W = F.inp(I_PWQ) + (size_t)l * DM * 2048; J.ldw = 2048; J.sc0 = 0; J.ncols = 2048; J.K = DM; J.WT = (bf16*)(F.ws + WS_WPQ) + (size_t)l * 2048 * DM; J.ldt = DM; J.dr0 = 0; J.dc0 = 0; J.scale = 1.f;
    }
    return J;
}
constexpr int N_TRJOBS = 30;
__device__ __forceinline__ int trjob_items(int j) {
    if (j < 14) { const int s = j % 7; const int nb[7] = {8, 16, 2, 1, 16, 16, 16}; int r = 0;
#pragma unroll
        for (int q = 0; q < 7; ++q) if (q == s) r = nb[q]; return 16 * r; }
    if (j < 22) return 16 * (((j - 14) % 4 == 3) ? 1 : 32);
    if (j < 24) return 8 * 32;
    if (j < 26) return 16 * 32;
    return 16 * 64;
}
__device__ __forceinline__ void p0_transposes(Frame& F) { PHASE_BEGIN(F);
    LAS float* scr = (LAS float*)(F.lds + F.wave * 16384);
    const int gw = F.vcu * NWAVES + F.wave, NGW = F.G * NWAVES;
    int base = 0;
    for (int j = 0; j < N_TRJOBS; ++j) {
        const int ni = trjob_items(j);
        int it = ((gw - base) % NGW + NGW) % NGW;
        if (it < ni) { const TrJob J = get_trjob(F, j); const int nblk = (J.ncols + 31) / 32;
            for (; it < ni; it += NGW) tr_item(J.W, J.ldw, J.sc0, J.ncols, J.WT, J.ldt, J.dr0, J.dc0, J.scale, scr, it / nblk, it % nblk, F.lane); }
        base += ni;
    }
    const int gt = F.vcu * NTHR + F.tid, NGT = F.G * NTHR;
    for (int e = 0; e < 2; ++e) { GAS v4u* p = (GAS v4u*)((bf16*)(F.ws + WS_WEIN) + (size_t)e * NE * DM + (size_t)4424 * DM); const int n = (NE - 4424) * DM / 8;
        for (int i = gt; i < n; i += NGT) p[i] = (v4u){0u, 0u, 0u, 0u}; }
    for (int o = 0; o < 2; ++o) { GAS v4u* p = (GAS v4u*)((bf16*)(F.ws + WS_WOIN) + (size_t)o * NO * DM + (size_t)ODD_IN * DM); const int n = (NO - ODD_IN) * DM / 8;
        for (int i = gt; i < n; i += NGT) p[i] = (v4u){0u, 0u, 0u, 0u}; }
    { const float* s = F.inp(I_PSK); bf16* d = (bf16*)(F.ws + WS_WSK); const int n = DEPTH * 2 * 128 * 128 / 4;
        for (int i = gt; i < n; i += NGT) { const f32x4 v = *(const GAS f32x4*)(s + (size_t)i * 4); u32x2 w; w.x = pk2(v.x, v.y); w.y = pk2(v.z, v.w); *(GAS u32x2*)(d + (size_t)i * 4) = w; } }
}
template <int kind> __device__ __forceinline__ void p0_fused_weights_k(Frame& F) { PHASE_BEGIN(F);
    LAS float* At = (LAS float*)F.lds;
    for (int it = F.vcu; it < 256; it += F.G) {
        const int e = (it >> 7) & 1, h = (it >> 4) & 7, blk = it & 15;
        __syncthreads();
        if (kind == 0) {
            const float* W = F.inp(I_EWIN) + (size_t)e * DM * EVEN_IN;
            for (int i = F.tid; i < 4096; i += NTHR) { const int kk = i >> 6, d = i & 63; At[kk * 65 + d] = W[(size_t)(64 * blk + kk) * EVEN_IN + 64 * h + d]; }
        } else {
            const float* W = F.inp(I_EWOUT) + (size_t)e * DM * DM;
            for (int i = F.tid; i < 4096; i += NTHR) { const int d = i >> 6, nn = i & 63; At[nn * 65 + d] = W[(size_t)(64 * h + d) * DM + 64 * blk + nn]; }
        }
        __syncthreads();
        const int c = F.tid & 255, half = F.tid >> 8;
        const float* Bsrc = (kind == 0 ? F.inp(I_WUK) : F.inp(I_WUV)) + (((size_t)e * 256 + c) * 8 + h) * 64;
        float br[64];
#pragma unroll
        for (int d4 = 0; d4 < 16; ++d4) { const f32x4 v = *(const GAS f32x4*)(Bsrc + 4 * d4); br[4 * d4] = v.x; br[4 * d4 + 1] = v.y; br[4 * d4 + 2] = v.z; br[4 * d4 + 3] = v.w; }
        if (kind == 0) {
            bf16* dst = (bf16*)(F.ws + WS_WEIN) + (size_t)e * NE * DM + (size_t)(h * 256 + c) * DM + 64 * blk + 32 * half;
#pragma unroll 1
            for (int kq = 0; kq < 16; ++kq) { const LAS float* a0 = At + (32 * half + 2 * kq) * 65; float s0 = 0.f, s1 = 0.f;
#pragma unroll
                for (int d = 0; d < 64; ++d) { s0 += a0[d] * br[d]; s1 += a0[65 + d] * br[d]; }
                *(GAS unsigned*)(dst + 2 * kq) = pk2(s0 * C2, s1 * C2); }
        } else {
            bf16* dst = (bf16*)(F.ws + WS_WEOUT) + (size_t)e * DM * KEO + (size_t)(64 * blk + 32 * half) * KEO + h * 256 + c;
#pragma unroll 1
            for (int q = 0; q < 32; ++q) { const LAS float* a = At + (32 * half + q) * 65; float s = 0.f;
#pragma unroll
                for (int d = 0; d < 64; ++d) s += a[d] * br[d];
                dst[(size_t)q * KEO] = (bf16)f2bf(s); }
        }
    }
    __syncthreads();
}
__device__ __forceinline__ void p0_fused_weights(Frame& F) { p0_fused_weights_k<0>(F); p0_fused_weights_k<1>(F); }
__device__ __forceinline__ void p0_mod(Frame& F) { PHASE_BEGIN(F);
    LAS float* cs = (LAS float*)F.lds;
    LAS float* red = (LAS float*)(F.lds + 16384);
    for (int i = F.tid; i < 4 * DM; i += NTHR) cs[i] = siluf(F.inp(I_C)[i]);
    __syncthreads();
    float* mod = (float*)(F.ws + WS_MOD);
    for (int it = F.vcu; it < DEPTH * 96; it += F.G) {
        const int l = it / 96, j0 = 64 * (it % 96);
        const float* W = F.inp(I_ADAW) + (size_t)l * DM * 6144 + j0 + F.lane;
        float a0 = 0.f, a1 = 0.f, a2 = 0.f, a3 = 0.f;
        const int kb = 128 * F.wave;
#pragma unroll 16
        for (int k = 0; k < 128; ++k) { const float w = W[(size_t)(kb + k) * 6144]; a0 += cs[kb + k] * w; a1 += cs[1024 + kb + k] * w; a2 += cs[2048 + kb + k] * w; a3 += cs[3072 + kb + k] * w; }
        red[(F.wave * 4 + 0) * 64 + F.lane] = a0; red[(F.wave * 4 + 1) * 64 + F.lane] = a1; red[(F.wave * 4 + 2) * 64 + F.lane] = a2; red[(F.wave * 4 + 3) * 64 + F.lane] = a3;
        __syncthreads();
        if (F.tid < 256) { const int b = F.tid >> 6, jj = F.tid & 63; float s = F.inp(I_ADAB)[(size_t)l * 6144 + j0 + jj];
#pragma unroll
            for (int w = 0; w < 8; ++w) s += red[(w * 4 + b) * 64 + jj];
            mod[((size_t)l * 4 + b) * 6144 + j0 + jj] = s; }
        __syncthreads();
    }
}
typedef float f32x2v __attribute__((ext_vector_type(2)));
__device__ __forceinline__ void conv_peer_tables(Frame& F, int layer) { PHASE_BEGIN(F);
    const int gw = F.vcu * NWAVES + F.wave, NGW = F.G * NWAVES, lane = F.lane;
    const float* pu = F.inp(I_PU) + (size_t)layer * 16384 * 1024; const float* pv = F.inp(I_PV) + (size_t)layer * 16384 * 1024;
    unsigned char* U8 = F.ws + WS_U8; unsigned char* V8 = F.ws + WS_V8; float* SU = (float*)(F.ws + WS_SU); float* SV = (float*)(F.ws + WS_SV);
    for (int row = gw; row < 32768; row += NGW) {
        const int isv = row >> 14, e = row & 16383;
        const float* src = (isv ? pv : pu) + (size_t)e * 1024 + 16 * lane;
        f32x4 x[4]; float mx = 0.f;
#pragma unroll
        for (int q = 0; q < 4; ++q) { x[q] = __builtin_nontemporal_load((const GAS f32x4*)(src + 4 * q)); mx = fmaxf(mx, fmaxf(fmaxf(fabsf(x[q].x), fabsf(x[q].y)), fmaxf(fabsf(x[q].z), fabsf(x[q].w)))); }
#pragma unroll
        for (int o = 1; o < 64; o <<= 1) mx = fmaxf(mx, __shfl_xor(mx, o));
        const float sc = mx > 0.f ? mx * (1.f / 400.f) : 1.f, inv = 1.f / sc;
        v4u w;
#pragma unroll
        for (int q = 0; q < 4; ++q) { int t = __builtin_amdgcn_cvt_pk_fp8_f32(x[q].x * inv, x[q].y * inv, 0, false); t = __builtin_amdgcn_cvt_pk_fp8_f32(x[q].z * inv, x[q].w * inv, t, true); w[q] = (unsigned)t; }
        if (isv) { *(GAS v4u*)(V8 + (size_t)(lane >> 3) * (16384 * 128) + (size_t)e * 128 + (lane & 7) * 16) = w; if (lane == 0) SV[e] = sc; }
        else { *(GAS v4u*)(U8 + (size_t)e * 1024 + 16 * lane) = w; if (lane == 0) SU[e] = sc; }
    }
}
__device__ __forceinline__ void norm_mod_row(const float* xrow, const float* g, const float* sc, const float* sh, bf16* orow, int lane) {
    const GAS f32x4* xr = (const GAS f32x4*)xrow + lane;
    f32x4 v[4]; float s2 = 0.f;
#pragma unroll
    for (int j = 0; j < 4; ++j) { v[j] = xr[64 * j]; s2 += (v[j].x * v[j].x + v[j].y * v[j].y) + (v[j].z * v[j].z + v[j].w * v[j].w); }
    const float rstd = 1.f / sqrtf(wave_sum(s2) * (1.f / DM) + RMS_EPS);
    GAS unsigned long long* o8 = (GAS unsigned long long*)orow + lane;
#pragma unroll
    for (int j = 0; j < 4; ++j) { const f32x4 gg = *((const GAS f32x4*)g + lane + 64 * j), cc = *((const GAS f32x4*)sc + lane + 64 * j), hh = *((const GAS f32x4*)sh + lane + 64 * j);
        const f32x4 y = v[j] * rstd * gg * (cc + 1.f) + hh;
        o8[64 * j] = (unsigned long long)pk2(y.x, y.y) | ((unsigned long long)pk2(y.z, y.w) << 32); }
}
__device__ __forceinline__ void norm_mod_phase(Frame& F, int src_ws, int layer, int which) { PHASE_BEGIN(F);
    const int gw = F.vcu * NWAVES + F.wave, NGW = F.G * NWAVES;
    const float* g = F.inp(which == 0 ? I_NMIX : I_NFFN) + (size_t)layer * DM;
    const float* mod = (const float*)(F.ws + WS_MOD) + (size_t)layer * 4 * 6144;
    bf16* H = (bf16*)(F.ws + WS_H);
    const float* X = src_ws ? (const float*)(F.ws + WS_X) : F.inp(I_X);
    for (int m = gw; m < T; m += NGW) { const float* mb = mod + (size_t)(m / SEQ) * 6144 + (which == 0 ? 0 : 3 * DM);
        norm_mod_row(X + (size_t)m * DM, g, mb + DM, mb, H + (size_t)m * DM, F.lane); }
}
__device__ __forceinline__ void final_norm_phase(Frame& F) { PHASE_BEGIN(F);
    const int gw = F.vcu * NWAVES + F.wave, NGW = F.G * NWAVES;
    const float* X = (const float*)(F.ws + WS_X); const float* g = F.inp(I_NFIN);
    for (int m = gw; m < T; m += NGW) { const GAS f32x4* xr = (const GAS f32x4*)(X + (size_t)m * DM) + F.lane; f32x4 v[4]; float s2 = 0.f;
#pragma unroll
        for (int j = 0; j < 4; ++j) { v[j] = xr[64 * j]; s2 += (v[j].x * v[j].x + v[j].y * v[j].y) + (v[j].z * v[j].z + v[j].w * v[j].w); }
        const float rstd = 1.f / sqrtf(wave_sum(s2) * (1.f / DM) + RMS_EPS);
        GAS f32x4* o = (GAS f32x4*)(F.out + (size_t)m * DM) + F.lane;
#pragma unroll
        for (int j = 0; j < 4; ++j) o[64 * j] = v[j] * rstd * *((const GAS f32x4*)g + F.lane + 64 * j); }
}
__device__ __forceinline__ unsigned f2sort(float x) { const unsigned u = __float_as_uint(x); return (u & 0x80000000u) ? ~u : (u | 0x80000000u); }
__device__ __forceinline__ float sort2f(unsigned k) { return __uint_as_float((k & 0x80000000u) ? (k & 0x7fffffffu) : ~k); }
__device__ __forceinline__ unsigned mbcnt64(unsigned long long m) { return __builtin_amdgcn_mbcnt_hi((unsigned)(m >> 32), __builtin_amdgcn_mbcnt_lo((unsigned)m, 0u)); }
#define LDS_FENCE() asm volatile("s_waitcnt lgkmcnt(0)" ::: "memory")

__device__ __forceinline__ void topk_unit(Frame& F, int b, int t0) {
    const int lane = F.lane, wid = F.wave, r32 = lane & 31, hi = lane >> 5;
    const bf16* P = (const bf16*)(F.ws + WS_P) + (size_t)b * SEQ * NE;
    LAS float* scores = (LAS float*)F.lds;
    LAS unsigned* minmax = (LAS unsigned*)(F.lds + XTRA_OFF + 24576);
    if (F.tid < 16) minmax[F.tid] = (F.tid & 1) ? 0xffffffffu : 0u;
    bf16x8 qa[2][4];
#pragma unroll
    for (int rt = 0; rt < 2; ++rt)
#pragma unroll
        for (int d0 = 0; d0 < 4; ++d0) qa[rt][d0] = *(const GAS bf16x8*)(P + (size_t)(t0 + 4 * rt + (r32 >> 3)) * NE + EC_QI + (r32 & 7) * 64 + 16 * d0 + 8 * hi);
    float wv[2][4][4];
#pragma unroll
    for (int rt = 0; rt < 2; ++rt)
#pragma unroll
        for (int g = 0; g < 4; ++g) { const u32x2 w = *(const GAS u32x2*)(P + (size_t)(t0 + 4 * rt + g) * NE + EC_WI + 4 * hi);
            wv[rt][g][0] = bflo(w.x); wv[rt][g][1] = bfhi(w.x); wv[rt][g][2] = bflo(w.y); wv[rt][g][3] = bfhi(w.y); }
    float mn[4], mx[4];
#pragma unroll
    for (int g = 0; g < 4; ++g) { mn[g] = INFINITY; mx[g] = -INFINITY; }
    const int nkt = (t0 + 8 + 31) >> 5;
    bf16x8 kn[4];
    { const int key0 = 32 * (wid < nkt ? wid : 0) + r32;
#pragma unroll
      for (int d0 = 0; d0 < 4; ++d0) kn[d0] = *(const GAS bf16x8*)(P + (size_t)key0 * NE + EC_KI + 16 * d0 + 8 * hi); }
    for (int kt = wid; kt < nkt; kt += NWAVES) {
        const int key = 32 * kt + r32;
        bf16x8 kb[4];
#pragma unroll
        for (int d0 = 0; d0 < 4; ++d0) kb[d0] = kn[d0];
        { const int keyn = 32 * (kt + NWAVES < nkt ? kt + NWAVES : kt) + r32;
#pragma unroll
          for (int d0 = 0; d0 < 4; ++d0) kn[d0] = *(const GAS bf16x8*)(P + (size_t)keyn * NE + EC_KI + 16 * d0 + 8 * hi); }
        f32x16 acc[2];
#pragma unroll
        for (int rt = 0; rt < 2; ++rt) { acc[rt] = (f32x16){};
#pragma unroll
            for (int d0 = 0; d0 < 4; ++d0) acc[rt] = __builtin_amdgcn_mfma_f32_32x32x16_bf16(qa[rt][d0], kb[d0], acc[rt], 0, 0, 0); }
#pragma unroll
        for (int g = 0; g < 4; ++g) {
            float s0 = 0.f, s1 = 0.f;
#pragma unroll
            for (int j = 0; j < 4; ++j) { s0 += wv[0][g][j] * fmaxf(acc[0][4 * g + j], 0.f); s1 += wv[1][g][j] * fmaxf(acc[1][4 * g + j], 0.f); }
            s0 += __shfl_xor(s0, 32); s1 += __shfl_xor(s1, 32);
            const float v = (hi ? s1 : s0) + 0.f;
            const int tok = 4 * hi + g;
            scores[tok * 4096 + key] = v;
            if (key <= t0 + tok) { mn[g] = fminf(mn[g], v); mx[g] = fmaxf(mx[g], v); }
        }
    }
#pragma unroll
    for (int g = 0; g < 4; ++g) {
#pragma unroll
        for (int o = 1; o < 32; o <<= 1) { mn[g] = fminf(mn[g], __shfl_xor(mn[g], o)); mx[g] = fmaxf(mx[g], __shfl_xor(mx[g], o)); }
    }
    __syncthreads();
    if (r32 == 0) {
#pragma unroll
        for (int g = 0; g < 4; ++g) { if (mx[g] >= mn[g]) { __hip_atomic_fetch_max(&minmax[(4 * hi + g) * 2], f2sort(mx[g]), __ATOMIC_RELAXED, __HIP_MEMORY_SCOPE_WORKGROUP);
                __hip_atomic_fetch_min(&minmax[(4 * hi + g) * 2 + 1], f2sort(mn[g]), __ATOMIC_RELAXED, __HIP_MEMORY_SCOPE_WORKGROUP); } }
    }
    __syncthreads();
    {
        const int t = t0 + wid, n = t + 1;
        unsigned short* selg = (unsigned short*)(F.ws + WS_SEL) + (size_t)(b * SEQ + t) * 256;
        if (n <= 256) {
#pragma unroll
            for (int q = 0; q < 4; ++q) { const int i = lane + 64 * q; selg[i] = (unsigned short)((i < n) ? i : 0xffff); }
        } else {
            const LAS float* sr = scores + wid * 4096;
            LAS unsigned* hist = (LAS unsigned*)(F.lds + XTRA_OFF + 3072 * wid);
            LAS unsigned* cand = hist + 512;
            LAS unsigned short* outl = (LAS unsigned short*)(hist + 640);
            float hif = sort2f(minmax[wid * 2]), lof = sort2f(minmax[wid * 2 + 1]);
            float scale = (hif > lof) ? 1024.f / (hif - lof) : 0.f;
            unsigned above_out = 0;
            int bstar = 0; unsigned cstar = 0, above = 0;
            for (int lvl = 0; lvl < 4; ++lvl) {
#pragma unroll
                for (int q = 0; q < 8; ++q) hist[lane + 64 * q] = 0u;
                LDS_FENCE();
                for (int i0 = 0; i0 < n; i0 += 64) { const int i = i0 + lane;
                    if (i < n) { const float x = sr[i]; if (x >= lof && x <= hif) { int bb = (int)((x - lof) * scale); bb = bb > 1023 ? 1023 : bb;
                        __hip_atomic_fetch_add(&hist[bb >> 1], (bb & 1) ? 65536u : 1u, __ATOMIC_RELAXED, __HIP_MEMORY_SCOPE_WORKGROUP); } } }
                LDS_FENCE();
                const unsigned target = 256u - above_out;
                unsigned hw[8]; unsigned tot = 0;
#pragma unroll
                for (int q = 0; q < 8; ++q) { hw[q] = hist[8 * lane + q]; tot += (hw[q] & 0xffffu) + (hw[q] >> 16); }
                unsigned suf = tot;
#pragma unroll
                for (int o = 1; o < 64; o <<= 1) { const unsigned v = __shfl_down(suf, o); if (lane + o < 64) suf += v; }
                const unsigned long long pm = __ballot(suf >= target);
                const int Ls = 63 - __builtin_clzll(pm | 1ull);
                above = __shfl(suf - tot, Ls);
                bstar = 16 * Ls; cstar = 0; bool found = false;
#pragma unroll
                for (int q = 7; q >= 0; --q) { const unsigned w = __shfl(hw[q], Ls);
                    { const unsigned c = w >> 16; if (!found) { if (above + c >= target) { found = true; bstar = 16 * Ls + 2 * q + 1; cstar = c; } else above += c; } }
                    { const unsigned c = w & 0xffffu; if (!found) { if (above + c >= target) { found = true; bstar = 16 * Ls + 2 * q; cstar = c; } else above += c; } } }
                if (cstar <= 64u || hif <= lof || lvl == 3) break;
                float mn2 = INFINITY, mx2 = -INFINITY;
                for (int i0 = 0; i0 < n; i0 += 64) { const int i = i0 + lane;
                    if (i < n) { const float x = sr[i]; if (x >= lof && x <= hif) { int bb = (int)((x - lof) * scale); bb = bb > 1023 ? 1023 : bb; if (bb == bstar) { mn2 = fminf(mn2, x); mx2 = fmaxf(mx2, x); } } } }
#pragma unroll
                for (int o = 1; o < 64; o <<= 1) { mn2 = fminf(mn2, __shfl_xor(mn2, o)); mx2 = fmaxf(mx2, __shfl_xor(mx2, o)); }
                above_out += above; lof = mn2; hif = mx2; scale = (hif > lof) ? 1024.f / (hif - lof) : 0.f;
            }
            const unsigned need = 256u - above_out - above;
            unsigned pos = 0;
            if (cstar <= 64u) {
                unsigned ncand = 0;
                for (int i0 = 0; i0 < n; i0 += 64) { const int i = i0 + lane; const bool valid = i < n; const float x = valid ? sr[i] : 0.f;
                    int bb = (int)((x - lof) * scale); bb = bb > 1023 ? 1023 : bb; const bool inr = valid && x >= lof && x <= hif;
                    const bool ab = (valid && x > hif) || (inr && bb > bstar); const unsigned long long ma = __ballot(ab);
                    if (ab) { const unsigned sl = pos + mbcnt64(ma); if (sl < 256u) outl[sl] = (unsigned short)i; }
                    pos += (unsigned)__builtin_popcountll(ma);
                    const bool ic = inr && bb == bstar; const unsigned long long mc = __ballot(ic);
                    if (ic) { const unsigned sl = ncand + mbcnt64(mc); if (sl < 64u) { cand[sl] = f2sort(x); cand[64 + sl] = (unsigned)i; } }
                    ncand += (unsigned)__builtin_popcountll(mc); }
                LDS_FENCE();
                const bool v = (unsigned)lane < ncand; const unsigned key = v ? cand[lane] : 0u; const unsigned cidx = cand[64 + lane];
                unsigned prefix = 0u;
                for (int bit = 31; bit >= 0; --bit) { const unsigned trial = prefix | (1u << bit);
                    const unsigned cnt = (unsigned)__builtin_popcountll(__ballot(v && key >= trial)); if (cnt >= need) prefix = trial; }
                const bool gt = v && key > prefix; const unsigned ngt = (unsigned)__builtin_popcountll(__ballot(gt));
                const bool eq = v && key == prefix; const unsigned long long meq = __ballot(eq);
                const bool sc = gt || (eq && mbcnt64(meq) < need - ngt);
                const unsigned long long ms = __ballot(sc);
                if (sc) { const unsigned sl = pos + mbcnt64(ms); if (sl < 256u) outl[sl] = (unsigned short)cidx; }
                pos += (unsigned)__builtin_popcountll(ms);
            } else if (hif <= lof) {
                unsigned eqseen = 0;
                for (int i0 = 0; i0 < n; i0 += 64) { const int i = i0 + lane; const bool valid = i < n; const float x = valid ? sr[i] : 0.f;
                    const bool gt = valid && x > hif, eq = valid && x == hif; const unsigned long long meq = __ballot(eq);
                    const bool sc = gt || (eq && eqseen + mbcnt64(meq) < need); const unsigned long long ms = __ballot(sc);
                    if (sc) { const unsigned sl = pos + mbcnt64(ms); if (sl < 256u) outl[sl] = (unsigned short)i; }
                    pos += (unsigned)__builtin_popcountll(ms); eqseen += (unsigned)__builtin_popcountll(meq); }
            } else {
                unsigned prefix = 0u;
                for (int bit = 31; bit >= 0; --bit) { const unsigned trial = prefix | (1u << bit); unsigned cnt = 0;
                    for (int i0 = 0; i0 < n; i0 += 64) { const int i = i0 + lane; cnt += (unsigned)__builtin_popcountll(__ballot(i < n && f2sort(sr[i < n ? i : 0]) >= trial)); }
                    if (cnt >= 256u) prefix = trial; }
                unsigned ngt = 0;
                for (int i0 = 0; i0 < n; i0 += 64) { const int i = i0 + lane; ngt += (unsigned)__builtin_popcountll(__ballot(i < n && f2sort(sr[i < n ? i : 0]) > prefix)); }
                const unsigned need_eq = 256u - ngt; unsigned eqseen = 0;
                for (int i0 = 0; i0 < n; i0 += 64) { const int i = i0 + lane; const bool valid = i < n; const unsigned k = f2sort(sr[valid ? i : 0]);
                    const bool gt = valid && k > prefix, eq = valid && k == prefix; const unsigned long long meq = __ballot(eq);
                    const bool sc = gt || (eq && eqseen + mbcnt64(meq) < need_eq); const unsigned long long ms = __ballot(sc);
                    if (sc) { const unsigned sl = pos + mbcnt64(ms); if (sl < 256u) outl[sl] = (unsigned short)i; }
                    pos += (unsigned)__builtin_popcountll(ms); eqseen += (unsigned)__builtin_popcountll(meq); }
            }
            LDS_FENCE();
            *(GAS unsigned long long*)(selg + 4 * lane) = *(const LAS unsigned long long*)(outl + 4 * lane);
        }
    }
    __syncthreads();
}
__device__ __forceinline__ void topk_phase(Frame& F) { PHASE_BEGIN(F);
    for (int idx = F.vcu; idx < 2048; idx += F.G) { const int r = idx >> 8, g = idx & 255; const int u = (r & 1) ? (r + 1) * 256 - 1 - g : r * 256 + g;
        topk_unit(F, u >> 9, (u & 511) * 8); }
}
__device__ __forceinline__ void ckv_norm_phase(Frame& F, int e) { PHASE_BEGIN(F);
    const int gw = F.vcu * NWAVES + F.wave, NGW = F.G * NWAVES;
    const bf16* P = (const bf16*)(F.ws + WS_P); bf16* CK = (bf16*)(F.ws + WS_CKV);
    const f32x4 g = *((const GAS f32x4*)(F.inp(I_KVN) + (size_t)e * 256) + F.lane);
    for (int m = gw; m < T; m += NGW) { const u32x2 w = *((const GAS u32x2*)(P + (size_t)m * NE + EC_CKV) + F.lane);
        const float a = bflo(w.x), b = bfhi(w.x), c = bflo(w.y), d = bfhi(w.y);
        const float rstd = 1.f / sqrtf(wave_sum((a * a + b * b) + (c * c + d * d)) * (1.f / 256.f) + RMS_EPS);
        u32x2 o; o.x = pk2(a * rstd * g.x, b * rstd * g.y); o.y = pk2(c * rstd * g.z, d * rstd * g.w);
        *((GAS u32x2*)(CK + (size_t)m * 256) + F.lane) = o; }
}
namespace fa {
__device__ __forceinline__ int crow(int r, int hi) { return (r & 3) + 8 * (r >> 2) + 4 * hi; }
__device__ __forceinline__ void glds16(const void* gsrc, unsigned lds_dst) { unsigned keep;
    asm volatile("s_mov_b32 %0, m0\n\ts_mov_b32 m0, %2\n\ts_nop 0\n\tglobal_load_lds_dwordx4 %1, off\n\ts_mov_b32 m0, %0" : "=&s"(keep) : "v"(gsrc), "s"(lds_dst) : "memory"); }
typedef __bf16 bf16x2_t __attribute__((ext_vector_type(2))); typedef float f32x2_t __attribute__((ext_vector_type(2)));
__device__ __forceinline__ unsigned cvtpk(float lo, float hi) { f32x2_t v = {lo, hi}; bf16x2_t b = __builtin_convertvector(v, bf16x2_t); return __builtin_bit_cast(unsigned, b); }
typedef short v4i16_t __attribute__((ext_vector_type(4)));
__device__ __forceinline__ s16x4 vtr(const LAS char* p) { return __builtin_bit_cast(s16x4, __builtin_amdgcn_ds_read_tr16_b64_v4i16((LAS v4i16_t*)p)); }
constexpr int KSLOT = 8192, THR = 8;
constexpr int L_V = 16384, L_WS = 49152, L_KB = 51200, FA_LDS = 51200 + 16384;

template <int VD, int MODE>
__device__ __forceinline__ void unit(LAS char* lds, const bf16* Qh, const bf16* Kh, const bf16* Vh, int pitch, int q0, bf16* Oh, int opitch, int tid_in) {
    constexpr int NDB = VD / 32, VSLOT = VD * 128;
    const int tid = tid_in, lane = tid & 63, r32 = lane & 31, hi = lane >> 5; const int wid = __builtin_amdgcn_readfirstlane(tid >> 6);
    const unsigned lds0 = (unsigned)(uintptr_t)lds;
    LAS float* wsf = (LAS float*)(lds + L_WS) + wid * 64;
    const LAS float* kbl = (const LAS float*)(lds + L_KB);
    const int NT = (q0 + 256) / 64;
    const int qw0 = q0 + 32 * wid, NTw = (qw0 + 31) / 64 + 1;
    const bf16* ksrc = Kh + (size_t)lane * pitch + wid * 8;
#define FA_DMA(t, s) do { fa::glds16(ksrc + (size_t)(t) * 64 * pitch, (unsigned)__builtin_amdgcn_readfirstlane(lds0 + (s) * fa::KSLOT + wid * 1024)); \
    _Pragma("unroll") for (int i_ = 0; i_ < NDB / 2; ++i_) { const int ci_ = i_ * 8 + wid; \
        fa::glds16(Vh + (size_t)((t) * 64 + 16 * (ci_ & 3) + (lane >> 2)) * pitch + (ci_ >> 2) * 32 + (lane & 3) * 8, (unsigned)__builtin_amdgcn_readfirstlane(lds0 + fa::L_V + (s) * VSLOT + ci_ * 1024)); } } while (0)
    FA_DMA(0, 0);
    bf16x8 qr[4];
#pragma unroll
    for (int d0 = 0; d0 < 4; ++d0) qr[d0] = *(const GAS bf16x8*)(Qh + (size_t)(qw0 + r32) * pitch + d0 * 16 + hi * 8);
    f32x16 o[NDB];
#pragma unroll
    for (int d = 0; d < NDB; ++d) o[d] = (f32x16){};
    float mhat = 0.f, l_reg = 0.f;
    asm volatile("s_waitcnt lgkmcnt(0)\n\ts_barrier" ::: "memory");
    const float farb = (MODE == 0) ? kbl[128] : 0.f;
    for (int j = 0; j < NT; ++j) {
        asm volatile("s_waitcnt vmcnt(0) lgkmcnt(0)\n\ts_barrier" ::: "memory");
        if (j + 1 < NT) FA_DMA(j + 1, (j + 1) & 1);
        if (j < NTw) {
            const int k0 = 64 * j;
            const LAS char* Ks = lds + (j & 1) * KSLOT + hi * 1024 + r32 * 16;
            f32x16 p0, p1;
            if (MODE == 1) {
#pragma unroll
                for (int g = 0; g < 4; ++g) { const f32x4 a = *(const LAS f32x4*)(kbl + k0 + 8 * g + 4 * hi), c = *(const LAS f32x4*)(kbl + k0 + 32 + 8 * g + 4 * hi);
                    p0[4 * g] = a.x - mhat; p0[4 * g + 1] = a.y - mhat; p0[4 * g + 2] = a.z - mhat; p0[4 * g + 3] = a.w - mhat;
                    p1[4 * g] = c.x - mhat; p1[4 * g + 1] = c.y - mhat; p1[4 * g + 2] = c.z - mhat; p1[4 * g + 3] = c.w - mhat; }
            } else { const float c = farb - mhat;
#pragma unroll
                for (int r = 0; r < 16; ++r) { p0[r] = c; p1[r] = c; } }
#pragma unroll
            for (int d0 = 0; d0 < 4; ++d0) { const bf16x8 b0 = *(const LAS bf16x8*)(Ks + d0 * 2048), b1 = *(const LAS bf16x8*)(Ks + d0 * 2048 + 512);
                p0 = __builtin_amdgcn_mfma_f32_32x32x16_bf16(b0, qr[d0], p0, 0, 0, 0); p1 = __builtin_amdgcn_mfma_f32_32x32x16_bf16(b1, qr[d0], p1, 0, 0, 0); }
            const int q = qw0 + r32;
            if (MODE == 0 && (k0 + 63 + 128 > qw0)) {
#pragma unroll
                for (int r = 0; r < 16; ++r) { int d0_ = q - (k0 + crow(r, hi)), d1_ = d0_ - 32; d0_ = d0_ < 0 ? 0 : (d0_ > 128 ? 128 : d0_); d1_ = d1_ < 0 ? 0 : (d1_ > 128 ? 128 : d1_);
                    p0[r] += kbl[d0_] - farb; p1[r] += kbl[d1_] - farb; } }
            if (k0 + 63 > qw0) {
#pragma unroll
                for (int r = 0; r < 16; ++r) { const int kv = k0 + crow(r, hi); if (kv > q) p0[r] = -INFINITY; if (kv + 32 > q) p1[r] = -INFINITY; } }
            float rm = fmaxf(p0[0], p1[0]);
#pragma unroll
            for (int r = 1; r < 16; ++r) rm = fmaxf(rm, fmaxf(p0[r], p1[r]));
            rm = fmaxf(rm, __shfl_xor(rm, 32));
            const bool first = (j == 0);
            if (first || __any(rm > (float)THR)) {
                const float dl = first ? rm : fmaxf(rm, 0.f);
                mhat += dl;
#pragma unroll
                for (int r = 0; r < 16; ++r) { p0[r] -= dl; p1[r] -= dl; }
                if (!first) { const float f = __builtin_amdgcn_exp2f(-dl); l_reg *= f; if (hi == 0) wsf[r32] = f; LDS_FENCE();
#pragma unroll
                    for (int r = 0; r < 16; ++r) { const float ff = wsf[crow(r, hi)];
#pragma unroll
                        for (int d = 0; d < NDB; ++d) o[d][r] *= ff; }
                    LDS_FENCE(); }
            }
            float sacc = 0.f;
#pragma unroll
            for (int r = 0; r < 16; ++r) { p0[r] = __builtin_amdgcn_exp2f(p0[r]); p1[r] = __builtin_amdgcn_exp2f(p1[r]); sacc += p0[r] + p1[r]; }
            l_reg += sacc;
            u32x4 pw[4];
#pragma unroll
            for (int i = 0; i < 4; ++i) { pw[0][i] = cvtpk(p0[2 * i], p0[2 * i + 1]); pw[1][i] = cvtpk(p0[8 + 2 * i], p0[8 + 2 * i + 1]); pw[2][i] = cvtpk(p1[2 * i], p1[2 * i + 1]); pw[3][i] = cvtpk(p1[8 + 2 * i], p1[8 + 2 * i + 1]); }
            const LAS char* vp = lds + L_V + (j & 1) * VSLOT + ((lane >> 4) & 1) * 32 + (lane & 3) * 8 + (4 * hi + ((lane & 15) >> 2)) * 64;
#pragma unroll
            for (int d = 0; d < NDB; ++d) {
#pragma unroll
                for (int ks = 0; ks < 4; ++ks) { const s16x4 lo = vtr(vp + d * 4096 + ks * 1024), hh = vtr(vp + d * 4096 + ks * 1024 + 512);
                    const bf16x8 vf = (bf16x8){lo[0], lo[1], lo[2], lo[3], hh[0], hh[1], hh[2], hh[3]};
                    o[d] = __builtin_amdgcn_mfma_f32_32x32x16_bf16(__builtin_bit_cast(bf16x8, pw[ks]), vf, o[d], 0, 0, 0); } }
        }
    }
#undef FA_DMA
    l_reg += __shfl_xor(l_reg, 32);
    if (hi == 0) wsf[32 + r32] = l_reg;
    LDS_FENCE();
#pragma unroll
    for (int r = 0; r < 16; ++r) { const float rl = 1.f / wsf[32 + crow(r, hi)]; bf16* orow = Oh + (size_t)(qw0 + crow(r, hi)) * opitch + r32;
#pragma unroll
        for (int d = 0; d < NDB; ++d) orow[32 * d] = (bf16)f2bf(o[d][r] * rl); }
    asm volatile("s_waitcnt lgkmcnt(0)\n\ts_barrier" ::: "memory");
}
}
__device__ __forceinline__ void fox_phase(Frame& F) { PHASE_BEGIN(F);
    LAS char* lds = (LAS char*)F.lds;
    const bf16* P = (const bf16*)(F.ws + WS_P); bf16* AO = (bf16*)(F.ws + WS_AO);
    const float* FC = (const float*)(F.ws + WS_FCUM);
    for (int idx = F.vcu; idx < 512; idx += F.G) {
        const int bh = idx >> 3, s = idx & 7, b = bh >> 4, h = bh & 15;
        for (int half = 0; half < 2; ++half) { const int qb = half ? 15 - s : s;
            LAS float* kbl = (LAS float*)(lds + fa::L_KB);
            for (int i = F.tid; i < (qb + 1) * 256; i += NTHR) kbl[i] = FC[((size_t)b * 16 + h) * SEQ + i];
            const size_t rb = (size_t)b * SEQ;
            fa::unit<64, 1>(lds, P + rb * NO + OC_Q + h * 64, P + rb * NO + OC_K + h * 64, P + rb * NO + OC_V + h * 64, NO, qb * 256, AO + rb * DM + h * 64, DM, F.tid); }
    }
}
__device__ __forceinline__ void diff_phase(Frame& F) { PHASE_BEGIN(F);
    LAS char* lds = (LAS char*)F.lds;
    const bf16* P = (const bf16*)(F.ws + WS_P); bf16* DO = (bf16*)(F.ws + WS_H);
    for (int idx = F.vcu; idx < 256; idx += F.G) {
        const int bhm = idx >> 3, s = idx & 7, b = bhm >> 3, h = (bhm >> 1) & 3, mp = bhm & 1;
        for (int half = 0; half < 2; ++half) { const int qb = half ? 15 - s : s;
            LAS float* tab = (LAS float*)(lds + fa::L_KB);
            if (F.tid < 129) tab[F.tid] = F.inp(I_RELB)[t5_bucket(F.tid) * 12 + 8 + h] * LOG2E;
            const size_t rb = (size_t)b * SEQ;
            fa::unit<128, 0>(lds, P + rb * NE + EC_QB + h * 128 + mp * 64, P + rb * NE + EC_KB + h * 128 + mp * 64, P + rb * NE + EC_VB + h * 128, NE, qb * 256, DO + rb * DM + (h * 2 + mp) * 128, DM, F.tid); }
    }
}
__device__ __forceinline__ void fcum_phase(Frame& F, int o) { PHASE_BEGIN(F);
    const bf16* P = (const bf16*)(F.ws + WS_P); float* FC = (float*)(F.ws + WS_FCUM);
    LAS float* wtot = (LAS float*)F.lds;
    for (int it = F.vcu; it < NB * 16; it += F.G) { const int b = it >> 4, h = it & 15; const float bfg = F.inp(I_BF)[o * 16 + h];
        const bf16* src = P + ((size_t)b * SEQ + 8 * F.tid) * NO + OC_F + h;
        float ls[8]; float run = 0.f;
#pragma unroll
        for (int i = 0; i < 8; ++i) { const float x = bf2f(src[(size_t)i * NO]) + bfg; run += fminf(x, 0.f) - log1pf(__expf(-fabsf(x))); ls[i] = run; }
        float inc = run;
#pragma unroll
        for (int of = 1; of < 64; of <<= 1) { const float v = __shfl_up(inc, of); if (F.lane >= of) inc += v; }
        __syncthreads();
        if (F.lane == 63) wtot[F.wave] = inc;
        __syncthreads();
        float base = inc - run;
        for (int w = 0; w < NWAVES; ++w) if (w < F.wave) base += wtot[w];
        float* dst = FC + ((size_t)b * 16 + h) * SEQ + 8 * F.tid;
        f32x4 o0, o1; o0.x = -(base + ls[0]) * LOG2E; o0.y = -(base + ls[1]) * LOG2E; o0.z = -(base + ls[2]) * LOG2E; o0.w = -(base + ls[3]) * LOG2E;
        o1.x = -(base + ls[4]) * LOG2E; o1.y = -(base + ls[5]) * LOG2E; o1.z = -(base + ls[6]) * LOG2E; o1.w = -(base + ls[7]) * LOG2E;
        *(GAS f32x4*)dst = o0; *(GAS f32x4*)(dst + 4) = o1;
    }
    __syncthreads();
}
typedef float f32x4v __attribute__((ext_vector_type(4)));
__device__ __forceinline__ void sparse_phase(Frame& F, int e) { PHASE_BEGIN(F);
    const int lane = F.lane, wid = F.wave, g = lane >> 4, hd = lane & 15, hi = lane >> 5;
    LAS char* lds = (LAS char*)F.lds;
    LAS float* tabA = (LAS float*)(lds + XTRA_OFF);
    LAS int* selw = (LAS int*)(lds + XTRA_OFF + 8192 + wid * 128);
    LAS char* buf = lds + wid * 16384;
    const unsigned buf0 = (unsigned)(uintptr_t)buf;
    for (int i = F.tid; i < 8 * 129; i += NTHR) { const int h = i / 129, d = i % 129; tabA[h * 132 + d] = F.inp(I_RELB)[t5_bucket(d) * 12 + h] * LOG2E; }
    __syncthreads();
    const bf16* P = (const bf16*)(F.ws + WS_P); const bf16* CK = (const bf16*)(F.ws + WS_CKV); bf16* AO = (bf16*)(F.ws + WS_AO);
    const unsigned short* SEL = (const unsigned short*)(F.ws + WS_SEL);
    const int gw = F.vcu * NWAVES + wid, NGW = F.G * NWAVES;
    {
        const float* lv = F.inp(I_LAM) + (size_t)e * 256;
        const float s1 = wave_sum(lv[lane] * lv[64 + lane]), s2 = wave_sum(lv[128 + lane] * lv[192 + lane]);
        const float lam_init = (e == 0) ? 0.2f : 0.47071303836235146f;
        const float lam = __expf(s1) - __expf(s2) + lam_init;
        const bf16* DO = (const bf16*)(F.ws + WS_H);
        const int h = lane >> 4, d0 = (lane & 15) * 8;
        float sg[8];
#pragma unroll
        for (int j = 0; j < 8; ++j) sg[j] = F.inp(I_SUBLN)[(size_t)e * 128 + d0 + j] * (1.f - lam_init);
        for (int t = gw; t < T; t += NGW) {
            const v4u a = *(const GAS v4u*)(DO + (size_t)t * DM + (h * 2) * 128 + d0), b = *(const GAS v4u*)(DO + (size_t)t * DM + (h * 2 + 1) * 128 + d0);
            float o[8];
            o[0] = bflo(a.x) - lam * bflo(b.x); o[1] = bfhi(a.x) - lam * bfhi(b.x); o[2] = bflo(a.y) - lam * bflo(b.y); o[3] = bfhi(a.y) - lam * bfhi(b.y);
            o[4] = bflo(a.z) - lam * bflo(b.z); o[5] = bfhi(a.z) - lam * bfhi(b.z); o[6] = bflo(a.w) - lam * bflo(b.w); o[7] = bfhi(a.w) - lam * bfhi(b.w);
            float ss = 0.f;
#pragma unroll
            for (int j = 0; j < 8; ++j) ss += o[j] * o[j];
            ss += __shfl_xor(ss, 1); ss += __shfl_xor(ss, 2); ss += __shfl_xor(ss, 4); ss += __shfl_xor(ss, 8);
            const float rstd = 1.f / sqrtf(ss * (1.f / 128.f) + RMS_EPS);
            v4u w; w.x = pk2(o[0] * rstd * sg[0], o[1] * rstd * sg[1]); w.y = pk2(o[2] * rstd * sg[2], o[3] * rstd * sg[3]); w.z = pk2(o[4] * rstd * sg[4], o[5] * rstd * sg[5]); w.w = pk2(o[6] * rstd * sg[6], o[7] * rstd * sg[7]);
            *(GAS v4u*)(AO + (size_t)t * KEO + 2048 + h * 128 + d0) = w;
        }
    }
    for (int t = gw; t < T; t += NGW) {
        const int b = t / SEQ, tl = t % SEQ;
        const int cnt = tl + 1 < 256 ? tl + 1 : 256, nch = (cnt + 31) >> 5;
        bf16x8 bq[8];
#pragma unroll
        for (int ks = 0; ks < 8; ++ks) { bq[ks] = (bf16x8){0, 0, 0, 0, 0, 0, 0, 0}; if (hd < 8) bq[ks] = *(const GAS bf16x8*)(P + (size_t)t * NE + EC_QLAT + hd * 256 + 32 * ks + 8 * g); }
        f32x4v oacc[16];
#pragma unroll
        for (int ct = 0; ct < 16; ++ct) oacc[ct] = (f32x4v){0.f, 0.f, 0.f, 0.f};
        float m = 0.f, l = 0.f;
        const float* tb = nullptr; (void)tb;
        for (int ch = 0; ch < nch; ++ch) {
            const int svu = (int)SEL[(size_t)t * 256 + 32 * ch + (lane & 31)];
            const int sv = (svu == 0xffff) ? -1 : svu;
            LDS_FENCE();
            if (lane < 32) selw[lane] = sv;
#pragma unroll
            for (int i = 0; i < 16; ++i) { const int ra = __builtin_amdgcn_readlane(sv, 2 * i), rb = __builtin_amdgcn_readlane(sv, 2 * i + 1);
                int r = hi ? rb : ra; r = r < 0 ? 0 : r; const int row = 2 * i + hi;
                fa::glds16(CK + ((size_t)b * SEQ + r) * 256 + 8 * ((lane & 31) ^ (row & 15)), (unsigned)__builtin_amdgcn_readfirstlane(buf0 + i * 1024)); }
            asm volatile("s_waitcnt vmcnt(0) lgkmcnt(0)" ::: "memory");
            f32x4v s[2];
#pragma unroll
            for (int rt = 0; rt < 2; ++rt) { s[rt] = (f32x4v){0.f, 0.f, 0.f, 0.f}; const int row = 16 * rt + hd; const LAS char* rp = buf + row * 512;
#pragma unroll
                for (int ks = 0; ks < 8; ++ks) { const bf16x8 a = *(const LAS bf16x8*)(rp + (((4 * ks + g) ^ (row & 15)) << 4));
                    s[rt] = __builtin_amdgcn_mfma_f32_16x16x32_bf16(a, bq[ks], s[rt], 0, 0, 0); } }
            float rm = -INFINITY;
#pragma unroll
            for (int rt = 0; rt < 2; ++rt) { const i32x4 kp = *(const LAS i32x4*)(selw + 16 * rt + 4 * g); const int kq[4] = {kp.x, kp.y, kp.z, kp.w};
#pragma unroll
                for (int r = 0; r < 4; ++r) { int d = tl - kq[r]; d = d > 128 ? 128 : (d < 0 ? 0 : d); float v = s[rt][r] + tabA[(hd & 7) * 132 + d]; v = kq[r] < 0 ? -INFINITY : v; s[rt][r] = v; rm = fmaxf(rm, v); } }
            rm = fmaxf(rm, __shfl_xor(rm, 16)); rm = fmaxf(rm, __shfl_xor(rm, 32));
            if (ch == 0) m = rm;
            else if (__any(rm - m > 8.f)) { const float mn = fmaxf(m, rm), f = __builtin_amdgcn_exp2f(m - mn); m = mn; l *= f;
#pragma unroll
                for (int ct = 0; ct < 16; ++ct) oacc[ct] = oacc[ct] * f; }
            float p[2][4]; float ps = 0.f;
#pragma unroll
            for (int rt = 0; rt < 2; ++rt)
#pragma unroll
                for (int r = 0; r < 4; ++r) { p[rt][r] = __builtin_amdgcn_exp2f(s[rt][r] - m); ps += p[rt][r]; }
            l += ps;
            u32x4 pbw; pbw.x = fa::cvtpk(p[0][0], p[0][1]); pbw.y = fa::cvtpk(p[0][2], p[0][3]); pbw.z = fa::cvtpk(p[1][0], p[1][1]); pbw.w = fa::cvtpk(p[1][2], p[1][3]);
            const bf16x8 pb = __builtin_bit_cast(bf16x8, pbw);
            const int q4 = hd >> 2, p4 = hd & 3; const int r0 = 4 * g + q4;
            const LAS char* v0 = buf + r0 * 512 + 8 * (p4 & 1); const LAS char* v1 = v0 + 16 * 512;
#pragma unroll
            for (int ct = 0; ct < 16; ++ct) { const int co = ((2 * ct + (p4 >> 1)) ^ (r0 & 15)) << 4;
                const s16x4 lo = fa::vtr(v0 + co), hh = fa::vtr(v1 + co);
                const bf16x8 a = (bf16x8){lo[0], lo[1], lo[2], lo[3], hh[0], hh[1], hh[2], hh[3]};
                oacc[ct] = __builtin_amdgcn_mfma_f32_16x16x32_bf16(a, pb, oacc[ct], 0, 0, 0); }
        }
        l += __shfl_xor(l, 16); l += __shfl_xor(l, 32);
#ifdef DBG_ZERO_SPARSE
        const float rl = 0.f;
#else
        const float rl = 1.f / l;
#endif
        if (hd < 8) { bf16* orow = AO + (size_t)t * KEO + hd * 256 + 4 * g;
#pragma unroll
            for (int ct = 0; ct < 16; ++ct) { u32x2 w; w.x = pk2(oacc[ct][0] * rl, oacc[ct][1] * rl); w.y = pk2(oacc[ct][2] * rl, oacc[ct][3] * rl); *(GAS u32x2*)(orow + 16 * ct) = w; } }
    }
    LDS_FENCE();
    __syncthreads();
}
template <int N> __device__ __forceinline__ void bitonic_desc(unsigned* v) {
#pragma unroll
    for (int k = 2; k <= N; k <<= 1)
#pragma unroll
        for (int j = k >> 1; j > 0; j >>= 1)
#pragma unroll
            for (int i = 0; i < N; ++i) { const int l = i ^ j; if (l > i) { const bool up = (i & k) != 0; const unsigned a = v[i], b = v[l]; const unsigned mx = a > b ? a : b, mn = a > b ? b : a; v[i] = up ? mn : mx; v[l] = up ? mx : mn; } }
}
__device__ __forceinline__ void merge16_desc(unsigned* a, const unsigned* b) {
#pragma unroll
    for (int i = 0; i < 16; ++i) { const unsigned x = a[i], y = b[15 - i]; a[i] = x > y ? x : y; }
#pragma unroll
    for (int j = 8; j > 0; j >>= 1)
#pragma unroll
        for (int i = 0; i < 16; ++i) { const int l = i ^ j; if (l > i) { const unsigned x = a[i], y = a[l]; a[i] = x > y ? x : y; a[l] = x > y ? y : x; } }
}
__device__ __forceinline__ void top16_of_64(unsigned* v) {
    bitonic_desc<16>(v); bitonic_desc<16>(v + 16); bitonic_desc<16>(v + 32); bitonic_desc<16>(v + 48);
    merge16_desc(v, v + 16); merge16_desc(v + 32, v + 48); merge16_desc(v, v + 32);
}
__device__ __forceinline__ void peer_route_phase(Frame& F, int layer) { PHASE_BEGIN(F);
    const int lane = F.lane, r32 = lane & 31, hi = lane >> 5;
    const bf16* PQ = (const bf16*)(F.ws + WS_P); const bf16* SK = (const bf16*)(F.ws + WS_WSK) + (size_t)layer * 2 * 128 * 128;
    int* PE = (int*)(F.ws + WS_PE); float* PG = (float*)(F.ws + WS_PG);
    const int gw = F.vcu * NWAVES + F.wave, NGW = F.G * NWAVES;
    LAS char* lds = (LAS char*)F.lds;
    for (int i = F.tid; i < 256 * 16; i += NTHR) { const int row = i >> 4, ch = i & 15; *(LAS v4u*)(lds + row * 272 + ch * 16) = *(const GAS v4u*)(SK + (size_t)row * 128 + ch * 8); }
    __syncthreads();
    for (int task = gw; task < T / 4; task += NGW) {
        const int t = 4 * task + (r32 >> 3), h = r32 & 7;
        unsigned top0[16], top1[16];
#pragma unroll
        for (int i = 0; i < 16; ++i) { top0[i] = 0u; top1[i] = 0u; }
#pragma unroll 1
        for (int p = 0; p < 2; ++p) {
            bf16x8 bq[8];
#pragma unroll
            for (int d0 = 0; d0 < 8; ++d0) bq[d0] = *(const GAS bf16x8*)(PQ + (size_t)t * 2048 + h * 256 + p * 128 + 16 * d0 + 8 * hi);
            unsigned v[64];
            const LAS char* ab = lds + (p * 128 + r32) * 272 + hi * 16;
#pragma unroll
            for (int kt = 0; kt < 4; ++kt) { f32x16 acc = (f32x16){};
#pragma unroll
                for (int d0 = 0; d0 < 8; ++d0) { const bf16x8 a = *(const LAS bf16x8*)(ab + kt * 32 * 272 + d0 * 32);
                    acc = __builtin_amdgcn_mfma_f32_32x32x16_bf16(a, bq[d0], acc, 0, 0, 0); }
#pragma unroll
                for (int r = 0; r < 16; ++r) { const int key = 32 * kt + (r & 3) + 8 * (r >> 2) + 4 * hi; v[16 * kt + r] = (f2sort(acc[r]) & ~127u) | (unsigned)(127 - key); } }
            top16_of_64(v);
            unsigned o[16];
#pragma unroll
            for (int i = 0; i < 16; ++i) o[i] = (unsigned)__shfl_xor((int)v[i], 32);
            merge16_desc(v, o);
#pragma unroll
            for (int i = 0; i < 16; ++i) { top0[i] = (p == 0) ? v[i] : top0[i]; top1[i] = (p == 1) ? v[i] : top1[i]; }
        }
        float s0[16], s1[16];
#pragma unroll
        for (int i = 0; i < 16; ++i) { s0[i] = sort2f(top0[i] & ~127u); s1[i] = sort2f(top1[i] & ~127u); }
        unsigned c[64]; int nc = 0;
#pragma unroll
        for (int a = 0; a < 16; ++a)
#pragma unroll
            for (int b = 0; b < 16; ++b) if ((a + 1) * (b + 1) <= 16) { c[nc] = (f2sort(s0[a] + s1[b]) & ~255u) | (unsigned)(255 - (a * 16 + b)); ++nc; }
#pragma unroll
        for (int i = nc; i < 64; ++i) c[i] = 0u;
        top16_of_64(c);
        float gsum = 0.f; float gt[16]; int ex[16];
        const float smax = sort2f(c[0] & ~255u);
#pragma unroll
        for (int j = 0; j < 16; ++j) { const float sj = sort2f(c[j] & ~255u); gt[j] = __expf(sj - smax); gsum += gt[j];
            const int id = 255 - (int)(c[j] & 255u), a = id >> 4, b = id & 15; unsigned ka = top0[0], kb = top1[0];
#pragma unroll
            for (int q = 1; q < 16; ++q) { ka = (a == q) ? top0[q] : ka; kb = (b == q) ? top1[q] : kb; }
            ex[j] = (127 - (int)(ka & 127u)) * 128 + (127 - (int)(kb & 127u)); }
        const float rg = 1.f / gsum;
        if (hi == 0) { int* d = PE + (size_t)t * 128 + h * 16;
#pragma unroll
            for (int q = 0; q < 4; ++q) *(GAS i32x4*)(d + 4 * q) = (i32x4){ex[4 * q], ex[4 * q + 1], ex[4 * q + 2], ex[4 * q + 3]}; }
        else { float* d = PG + (size_t)t * 128 + h * 16;
#pragma unroll
            for (int q = 0; q < 4; ++q) *(GAS f32x4*)(d + 4 * q) = (f32x4){gt[4 * q] * rg, gt[4 * q + 1] * rg, gt[4 * q + 2] * rg, gt[4 * q + 3] * rg}; }
    }
    __syncthreads();
}
__device__ __forceinline__ void dec16(const v4u w, float (&f)[16]) {
#pragma unroll
    for (int q = 0; q < 4; ++q) { const f32x2v a = __builtin_amdgcn_cvt_pk_f32_fp8((int)w[q], false), b = __builtin_amdgcn_cvt_pk_f32_fp8((int)w[q], true); f[4 * q] = a.x; f[4 * q + 1] = a.y; f[4 * q + 2] = b.x; f[4 * q + 3] = b.y; }
}
template <int NB> __device__ __forceinline__ void peer_u_batch(const LAS unsigned* list, int base, int total, const float (&xf)[16], const unsigned char* U8, const float* SU, const float* PGt, float* ACTt, int lane) {
    v4u w[NB];
    const int rem = total - base;
    const unsigned mine = list[base + (lane & (NB - 1))];
    const bool act = lane < NB && lane < rem; const int mye = (int)(mine & 0xffffu), myj = (int)(mine >> 16);
    float su = 0.f, pg = 0.f; if (act) { su = SU[mye]; pg = PGt[myj]; }
#pragma unroll
    for (int q = 0; q < NB; ++q) { w[q] = (v4u){0u, 0u, 0u, 0u};
        if (q < rem) { const unsigned ent = list[base + q]; w[q] = *(const GAS v4u*)(U8 + (size_t)(ent & 0xffffu) * 1024 + 16 * lane); } }
    float d[NB];
#pragma unroll
    for (int q = 0; q < NB; ++q) { d[q] = 0.f; if (q < rem) { float f[16]; dec16(w[q], f); float s = 0.f;
#pragma unroll
        for (int i = 0; i < 16; ++i) s += xf[i] * f[i];
        d[q] = s; } }
#pragma unroll
    for (int lvl = 0, n = NB; n > 1; ++lvl, n >>= 1) { const int bit = 1 << lvl;
#pragma unroll
        for (int q = 0; q < n / 2; ++q) { const float keep = (lane & bit) ? d[2 * q + 1] : d[2 * q], send = (lane & bit) ? d[2 * q] : d[2 * q + 1]; d[q] = keep + __shfl_xor(send, bit); } }
    float e1 = d[0];
#pragma unroll
    for (int o = NB; o < 64; o <<= 1) e1 += __shfl_xor(e1, o);
    if (act) ACTt[myj] = gelu_tanh(e1 * su) * pg;
}
__device__ __forceinline__ void peer_u_phase(Frame& F, int layer) { PHASE_BEGIN(F);
    const int lane = F.lane; const int per = F.G >> 3; const int k = F.vcu / per, wp = (F.vcu % per) * NWAVES + F.wave, nwp = per * NWAVES;
    const bf16* H = (const bf16*)(F.ws + WS_H); const unsigned char* U8 = F.ws + WS_U8; const float* SU = (const float*)(F.ws + WS_SU);
    const int* PE = (const int*)(F.ws + WS_PE); const float* PG = (const float*)(F.ws + WS_PG); float* ACT = (float*)(F.ws + WS_ACT);
    LAS unsigned* list = (LAS unsigned*)(F.lds + F.wave * 1024);
    v4u xa = *(const GAS v4u*)(H + (size_t)wp * DM + 16 * lane), xc = *(const GAS v4u*)(H + (size_t)wp * DM + 16 * lane + 8);
    int ea = PE[(size_t)wp * 128 + lane], eb = PE[(size_t)wp * 128 + 64 + lane];
    for (int t = wp; t < T; t += nwp) {
        float xf[16];
        xf[0] = bflo(xa.x); xf[1] = bfhi(xa.x); xf[2] = bflo(xa.y); xf[3] = bfhi(xa.y); xf[4] = bflo(xa.z); xf[5] = bfhi(xa.z); xf[6] = bflo(xa.w); xf[7] = bfhi(xa.w);
        xf[8] = bflo(xc.x); xf[9] = bfhi(xc.x); xf[10] = bflo(xc.y); xf[11] = bfhi(xc.y); xf[12] = bflo(xc.z); xf[13] = bfhi(xc.z); xf[14] = bflo(xc.w); xf[15] = bfhi(xc.w);
        const bool ia = (ea >> 11) == k, ib = (eb >> 11) == k;
        const unsigned long long ma = __ballot(ia), mb = __ballot(ib);
        const int na = __builtin_popcountll(ma), total = na + __builtin_popcountll(mb);
        LDS_FENCE();
        if (ia) list[mbcnt64(ma)] = (unsigned)ea | ((unsigned)lane << 16);
        if (ib) list[na + mbcnt64(mb)] = (unsigned)eb | ((unsigned)(64 + lane) << 16);
        const int tn = (t + nwp < T) ? t + nwp : t;
        xa = *(const GAS v4u*)(H + (size_t)tn * DM + 16 * lane); xc = *(const GAS v4u*)(H + (size_t)tn * DM + 16 * lane + 8);
        ea = PE[(size_t)tn * 128 + lane]; eb = PE[(size_t)tn * 128 + 64 + lane];
        LDS_FENCE();
        for (int base = 0; base < total; ) {
            if (total - base > 8) { peer_u_batch<16>(list, base, total, xf, U8, SU, PG + (size_t)t * 128, ACT + (size_t)t * 128, lane); base += 16; }
            else { peer_u_batch<8>(list, base, total, xf, U8, SU, PG + (size_t)t * 128, ACT + (size_t)t * 128, lane); base += 8; }
        }
    }
    LDS_FENCE();
}
__device__ __forceinline__ void peer_v_phase(Frame& F, int layer) { PHASE_BEGIN(F);
    const int lane = F.lane; const int per = F.G >> 3; const int k = F.vcu / per, wp = (F.vcu % per) * NWAVES + F.wave, nwp = per * NWAVES;
    const unsigned char* V8 = F.ws + WS_V8 + (size_t)k * (16384 * 128) + (lane & 7) * 16; const float* SV = (const float*)(F.ws + WS_SV);
    const int* PE = (const int*)(F.ws + WS_PE); const float* ACT = (const float*)(F.ws + WS_ACT);
    float* X = (float*)(F.ws + WS_X); const float* mod = (const float*)(F.ws + WS_MOD);
    const int c16 = ((lane >> 3) & 1) * 8 + ((lane >> 4) & 1) * 4 + ((lane >> 5) & 1) * 2;
    const int col = 128 * k + 16 * (lane & 7) + c16;
    int ea = PE[(size_t)wp * 128 + lane], eb = PE[(size_t)wp * 128 + 64 + lane];
    float ca = ACT[(size_t)wp * 128 + lane], cb = ACT[(size_t)wp * 128 + 64 + lane];
    for (int t = wp; t < T; t += nwp) {
        int e[16]; float cf[16]; v4u w[16];
#pragma unroll
        for (int s = 0; s < 16; ++s) { const int sl = (8 * s + (lane >> 3)) & 63;
            e[s] = __shfl(s < 8 ? ea : eb, sl); cf[s] = __shfl(s < 8 ? ca : cb, sl);
            w[s] = *(const GAS v4u*)(V8 + (size_t)e[s] * 128); }
#pragma unroll
        for (int s = 0; s < 16; ++s) cf[s] *= SV[e[s]];
        __builtin_amdgcn_sched_barrier(0);
        const int tn = (t + nwp < T) ? t + nwp : t;
        ea = PE[(size_t)tn * 128 + lane]; eb = PE[(size_t)tn * 128 + 64 + lane]; ca = ACT[(size_t)tn * 128 + lane]; cb = ACT[(size_t)tn * 128 + 64 + lane];
        int ln2 = lane; asm volatile("" : "+v"(ln2));
        const int col2 = 128 * k + 16 * (ln2 & 7) + ((ln2 >> 3) & 1) * 8 + ((ln2 >> 4) & 1) * 4 + ((ln2 >> 5) & 1) * 2;
        const float* g2 = mod + ((size_t)layer * 4 + t / SEQ) * 6144 + 5 * DM + col2;
        GAS f32x2v* xp = (GAS f32x2v*)(X + (size_t)t * DM + col2); f32x2v xv = *xp; const float g2a = g2[0], g2b = g2[1];
        float acc[16];
#pragma unroll
        for (int i = 0; i < 16; ++i) acc[i] = 0.f;
#pragma unroll
        for (int s = 0; s < 16; ++s) { float f[16]; dec16(w[s], f);
#pragma unroll
            for (int i = 0; i < 16; ++i) acc[i] += cf[s] * f[i];
            if ((s & 1) == 1) __builtin_amdgcn_sched_barrier(0); }
        float r8[8], r4[4], r2[2];
#pragma unroll
        for (int i = 0; i < 8; ++i) { const float keep = (lane & 8) ? acc[8 + i] : acc[i], send = (lane & 8) ? acc[i] : acc[8 + i]; r8[i] = keep + __shfl_xor(send, 8); }
#pragma unroll
        for (int i = 0; i < 4; ++i) { const float keep = (lane & 16) ? r8[4 + i] : r8[i], send = (lane & 16) ? r8[i] : r8[4 + i]; r4[i] = keep + __shfl_xor(send, 16); }
#pragma unroll
        for (int i = 0; i < 2; ++i) { const float keep = (lane & 32) ? r4[2 + i] : r4[i], send = (lane & 32) ? r4[i] : r4[2 + i]; r2[i] = keep + __shfl_xor(send, 32); }
        xv.x += g2a * r2[0]; xv.y += g2b * r2[1]; *xp = xv;
    }
}
namespace pg8 {
struct EpiResid {
    static constexpr bool PERM = false, AFTER_DRAIN = false;
    const float* xin; float* xout; const float* gate; float mul;
    __device__ __forceinline__ void operator()(const f32x4 (&acc)[2][2][4][2], const Unit& u, int wr, int wc, int fr, int fq) const {
        const int col0 = u.pn * BM + wc * 32 + 4 * fq; const float* gb = gate + (size_t)((u.pm * BM) / 4096) * 6144 + col0;
        f32x4 gv[2][2];
#pragma unroll
        for (int bj = 0; bj < 2; ++bj)
#pragma unroll
            for (int n = 0; n < 2; ++n) gv[bj][n] = *(const f32x4*)(gb + bj * HALF + n * 16);
#pragma unroll
        for (int ai = 0; ai < 2; ++ai)
#pragma unroll
            for (int m = 0; m < 4; ++m) { const size_t off = (size_t)(u.pm * BM + ai * HALF + wr * 64 + m * 16 + fr) * 1024 + col0;
#pragma unroll
                for (int bj = 0; bj < 2; ++bj)
#pragma unroll
                    for (int n = 0; n < 2; ++n) { const f32x4 xv = *(const f32x4*)(xin + off + bj * HALF + n * 16); *(f32x4*)(xout + off + bj * HALF + n * 16) = xv + gv[bj][n] * acc[ai][bj][m][n] * mul; } }
    }
};
}

struct Args { const float* in[22]; float* out; unsigned char* ws; int stop_after; int pad; };
__global__ void __launch_bounds__(NTHR, 2) fwd_megakernel(Args args) {
    extern __shared__ __attribute__((aligned(16))) unsigned char lds[];
    Frame F;
    F.lds = (LAS unsigned char*)lds;
    F.MISC = (volatile LAS unsigned*)(F.lds + MISC_OFF);
    F.G = gridDim.x; { const int bx = blockIdx.x; F.vcu0 = (F.G % 8 == 0) ? (bx % 8) * (F.G / 8) + bx / 8 : bx; }
    F.ka0 = (const KAS char*)__builtin_amdgcn_kernarg_segment_ptr();
    F.wave0 = __builtin_amdgcn_readfirstlane((int)threadIdx.x >> 6);
    PHASE_BEGIN(F);
    for (int u = F.tid; u < (LDS_BYTES - MISC_OFF) / 4; u += NTHR) ((LAS unsigned*)(F.lds + MISC_OFF))[u] = 0u;
    __syncthreads();
    (void)xcd_barrier_post((unsigned*)(F.ctl + CW_BAR), F.MISC + 8);
#define GRID_BAR() do { XcdBarrier b_; unsigned* p_ = (unsigned*)(F.ws + WS_CTL) + CW_BAR; asm volatile("" : "+s"(p_)); b_.bar = p_; b_.x = xb_xcc_id(); b_.st = F.MISC + 8; xcd_barrier(b_); } while (0)
#ifdef DBG_TIME_MASK
    unsigned long long tacc_ = 0, tst_ = 0;
#define TS_BEGIN(id) do { if ((DBG_TIME_MASK >> (id)) & 1) tst_ = __builtin_amdgcn_s_memrealtime(); } while (0)
#define TS_END(id) do { if ((DBG_TIME_MASK >> (id)) & 1) tacc_ += __builtin_amdgcn_s_memrealtime() - tst_; } while (0)
#else
#define TS_BEGIN(id) do {} while (0)
#define TS_END(id) do {} while (0)
#endif

    TS_BEGIN(1);
    p0_transposes(F);
    p0_fused_weights(F);
    p0_mod(F);
    conv_peer_tables(F, 0);
    GRID_BAR();
    norm_mod_phase(F, 0, 0, 0);
    GRID_BAR();
    TS_END(1);

    for (int layer = 0; layer < DEPTH; ++layer) {
        const int half = layer >> 1; const bool even = (layer & 1) == 0;
        PHASE_BEGIN(F);
        bf16* Hb = (bf16*)(F.ws + WS_H); bf16* Pb = (bf16*)(F.ws + WS_P);
        TS_BEGIN(2);
        if (even) { pg8::Gemm g{Hb, (const bf16*)(F.ws + WS_WEIN) + (size_t)half * NE * DM, T, NE, DM}; pg8::StaticOrder S; S.init(T, NE, F.G, (int)blockIdx.x);
            pg8::EpiBf16<0> E{Pb, NE, nullptr, 0, 0, 1.f}; pg8::gemm_phase<pg8::EpiBf16<0>, pg8::StaticOrder, true, true>(F.lds, g, S, E, F.tid); }
        else { pg8::Gemm g{Hb, (const bf16*)(F.ws + WS_WOIN) + (size_t)half * NO * DM, T, NO, DM}; pg8::StaticOrder S; S.init(T, NO, F.G, (int)blockIdx.x);
            pg8::EpiBf16<0> E{Pb, NO, nullptr, 0, 0, 1.f}; pg8::gemm_phase<pg8::EpiBf16<0>, pg8::StaticOrder, true, true>(F.lds, g, S, E, F.tid); }
        GRID_BAR();
        TS_END(2);
        if (even) {
            TS_BEGIN(3);
            TS_BEGIN(14);
            ckv_norm_phase(F, half);
            topk_phase(F);
            TS_END(14);
            TS_BEGIN(15);
            diff_phase(F);
            TS_END(15);
            TS_BEGIN(16);
#ifdef DBG_REP_DIFF
            diff_phase(F);
#endif
#ifdef DBG_REP_TOPK
            topk_phase(F);
#endif
            GRID_BAR();
            TS_END(16);
            TS_END(3);
            TS_BEGIN(4);
            sparse_phase(F, half);
#ifdef DBG_REP_SPARSE
            sparse_phase(F, half);
#endif
        } else {
            TS_BEGIN(5);
            fcum_phase(F, half);
            GRID_BAR();
            TS_END(5);
            TS_BEGIN(6);
            fox_phase(F);
#ifdef DBG_REP_FOX
            fox_phase(F);
#endif
        }
        GRID_BAR();
        if (even) TS_END(4); else TS_END(6);
        TS_BEGIN(7);
        { PHASE_BEGIN(F); bf16* AOb = (bf16*)(F.ws + WS_AO); float* Xb = (float*)(F.ws + WS_X); const float* mod = (const float*)(F.ws + WS_MOD);
          const float* xin = (layer == 0) ? F.inp(I_X) : Xb; const float* g1 = mod + (size_t)layer * 4 * 6144 + 2 * DM;
          pg8::EpiResid E{xin, Xb, g1, 1.f};
#ifdef DBG_SKIP_EVEN_MIX
          if (even) E.mul = 0.f;
#endif
#ifdef DBG_SKIP_ODD_MIX
          if (!even) E.mul = 0.f;
#endif
          if (even) { pg8::Gemm g{AOb, (const bf16*)(F.ws + WS_WEOUT) + (size_t)half * DM * KEO, T, DM, KEO}; pg8::StaticOrder S; S.init(T, DM, F.G, (int)blockIdx.x);
              pg8::gemm_phase<pg8::EpiResid, pg8::StaticOrder, false, true>(F.lds, g, S, E, F.tid); }
          else { pg8::Gemm g{AOb, (const bf16*)(F.ws + WS_WOOUT) + (size_t)half * DM * DM, T, DM, DM}; pg8::StaticOrder S; S.init(T, DM, F.G, (int)blockIdx.x);
              pg8::gemm_phase<pg8::EpiResid, pg8::StaticOrder, false, true>(F.lds, g, S, E, F.tid); } }
        GRID_BAR();
        TS_END(7);
        TS_BEGIN(8);
        norm_mod_phase(F, 1, layer, 1);
        if (layer > 0) conv_peer_tables(F, layer);
        GRID_BAR();
        TS_END(8);
        TS_BEGIN(9);
        { PHASE_BEGIN(F); bf16* Hb = (bf16*)(F.ws + WS_H); bf16* Pb = (bf16*)(F.ws + WS_P);
          pg8::Gemm g{Hb, (const bf16*)(F.ws + WS_WPQ) + (size_t)layer * 2048 * DM, T, 2048, DM}; pg8::StaticOrder S; S.init(T, 2048, F.G, (int)blockIdx.x);
          pg8::EpiBf16<0> E{Pb, 2048, nullptr, 0, 0, 1.f}; pg8::gemm_phase<pg8::EpiBf16<0>, pg8::StaticOrder, true, true>(F.lds, g, S, E, F.tid); }
        GRID_BAR();
        TS_END(9);
        TS_BEGIN(10);
        peer_route_phase(F, layer);
#ifdef DBG_REP_ROUTE
        peer_route_phase(F, layer);
#endif
        GRID_BAR();
        TS_END(10);
        TS_BEGIN(11);
        peer_u_phase(F, layer);
        GRID_BAR();
        TS_END(11);
        TS_BEGIN(12);
        peer_v_phase(F, layer);
        GRID_BAR();
        TS_END(12);
        TS_BEGIN(13);
        if (layer + 1 < DEPTH) { norm_mod_phase(F, 1, layer + 1, 0); GRID_BAR(); } else final_norm_phase(F);
        TS_END(13);
    }
#ifdef DBG_TIME_MASK
#ifndef DBG_VCU
#define DBG_VCU 0
#endif
#ifdef DBG_MAXMODE
    PHASE_BEGIN(F); if (F.tid == 0) atomicMax((unsigned*)(F.ws + WS_CTL) + 8192, (unsigned)tacc_); GRID_BAR(); { const unsigned mx_ = __hip_atomic_load((unsigned*)(F.ws + WS_CTL) + 8192, __ATOMIC_RELAXED, __HIP_MEMORY_SCOPE_AGENT);
#ifdef DBG_ARGMAX
      if (F.tid == 0 && (unsigned)tacc_ == mx_) __hip_atomic_store((unsigned*)(F.ws + WS_CTL) + 8256, (unsigned)F.vcu0, __ATOMIC_RELAXED, __HIP_MEMORY_SCOPE_AGENT);
      GRID_BAR(); tacc_ = 2500ull * __hip_atomic_load((unsigned*)(F.ws + WS_CTL) + 8256, __ATOMIC_RELAXED, __HIP_MEMORY_SCOPE_AGENT);
#else
      tacc_ = mx_;
#endif
    }
#endif
    if (F.vcu0 == DBG_VCU) { const unsigned long long t0_ = __builtin_amdgcn_s_memrealtime(); while (__builtin_amdgcn_s_memrealtime() - t0_ < 4ull * tacc_) __builtin_amdgcn_s_sleep(8); }
#endif
#undef GRID_BAR
}

extern "C" void kernel_launch(void* const* d_in, const int* in_sizes, int n_in, void* d_out, int out_size, void* d_ws, size_t ws_size, hipStream_t stream) {
    static int grid = 0;
    if (grid == 0) {
        if (n_in != 22 || in_sizes[0] != T * DM || out_size != T * DM || ws_size < WS_END) { fprintf(stderr, "kernel_launch: unexpected problem (n_in %d, in0 %d, out %d, ws %zu)\n", n_in, n_in > 0 ? in_sizes[0] : -1, out_size, ws_size); grid = -1; return; }
        int dev = 0, cus = 0, per_cu = 0;
        if (hipGetDevice(&dev) != hipSuccess || hipDeviceGetAttribute(&cus, hipDeviceAttributeMultiprocessorCount, dev) != hipSuccess) { grid = -1; return; }
        if (hipFuncSetAttribute((const void*)fwd_megakernel, hipFuncAttributeMaxDynamicSharedMemorySize, LDS_BYTES) != hipSuccess) { fprintf(stderr, "kernel_launch: hipFuncSetAttribute failed\n"); grid = -1; return; }
        if (hipOccupancyMaxActiveBlocksPerMultiprocessor(&per_cu, (const void*)fwd_megakernel, NTHR, LDS_BYTES) != hipSuccess || per_cu < 1) fprintf(stderr, "kernel_launch: occupancy query says %d\n", per_cu);
        (void)hipGetLastError();
        grid = cus;
    }
    if (grid < 0) return;
    if (hipMemsetAsync((char*)d_ws + WS_CTL, 0, CTL_ZERO_BYTES, stream) != hipSuccess) return;
    Args a{};
    for (int i = 0; i < 22; ++i) a.in[i] = (const float*)d_in[i];
    a.out = (float*)d_out; a.ws = (unsigned char*)d_ws; a.stop_after = 0; a.pad = 0;
    hipLaunchKernelGGL(fwd_megakernel, dim3(grid), dim3(NTHR), LDS_BYTES, stream, a);
}
```

```cpp
#include <hip/hip_runtime.h>
#include <hip/hip_bf16.h>
#include <cstdio>
#include <cstdint>
#include <cmath>
namespace pg8 {
#define PG8_LAS __attribute__((address_space(3)))
typedef unsigned short bf16_t;
typedef short bf16x8 __attribute__((ext_vector_type(8)));
typedef float f32x4 __attribute__((ext_vector_type(4)));
typedef unsigned u32x4 __attribute__((ext_vector_type(4)));
constexpr int BM = 256, BK = 64, HALF = 128, HTB = HALF * BK * 2  , STAGE_BYTES = 8 * HTB, NXCD = 8, WGM = 8;

__host__ __device__ __forceinline__ int lds_byte(int r, int c) { const int st = (r >> 4) * 2 + (c >> 5), rr = r & 15, cc = c & 31, ob = rr * 64 + cc * 2; return st * 1024 + (ob ^ (((ob >> 9) & 1) << 5)); }
__host__ __device__ __forceinline__ void stage_rc(int b, int& R, int& C) { const int st = b / 1024, sb = b % 1024, swz = sb ^ (((sb >> 9) & 1) << 5); R = (st >> 1) * 16 + swz / 64; C = (st & 1) * 32 + (swz % 64) / 2; }
__host__ __device__ __forceinline__ int perm32(int rho) { const int n = rho >> 4, i = rho & 15; return 8 * (i >> 2) + 4 * n + (i & 3); }

struct Unit { int pm, pn; };
struct Gemm { const bf16_t* A; const bf16_t* Bt; int M, N, K; };

struct StaticOrder {
    int nM, nN, nwg, G, c;
    __host__ __device__ void init(int M, int N, int G_, int c_) { nM = M / BM; nN = N / BM; nwg = nM * nN; G = G_; c = c_; }
    __host__ __device__ bool next(int i, Unit& u) const {
        const long L = (long)i * G + c; if (L >= nwg) return false;
        int wgid = (int)L; { const int q = nwg / NXCD, r = nwg % NXCD, xcd = wgid % NXCD, off = wgid / NXCD; wgid = (xcd < r ? xcd * (q + 1) : r * (q + 1) + (xcd - r) * q) + off; }
        const int nig = WGM * nN, gid = wgid / nig, fm = gid * WGM, gsz = (nM - fm) < WGM ? (nM - fm) : WGM;
        u.pm = fm + ((wgid % nig) % gsz); u.pn = (wgid % nig) / gsz; return true;
    }
    __device__ __forceinline__ void a_ready(const Unit&) const {}
    __device__ __forceinline__ void done(const Unit&) const {}
};

__device__ __forceinline__ unsigned cvt_pk_bf16(float lo, float hi) { unsigned r; asm volatile("v_cvt_pk_bf16_f32 %0, %1, %2" : "=v"(r) : "v"(lo), "v"(hi)); return r; }
typedef float f32x2 __attribute__((ext_vector_type(2)));
__device__ __forceinline__ f32x2 gelu_pk(f32x2 v) {
    const f32x2 av = __builtin_elementwise_abs(v), d = av * 0.2316418882f + 1.0f;
    f32x2 t; t.x = __builtin_amdgcn_rcpf(d.x); t.y = __builtin_amdgcn_rcpf(d.y);
    f32x2 q = t * 0.5307027145f + (-0.7265760135f); q = q * t + 0.7107068705f; q = q * t + (-0.142248368f); q = q * t + 0.127414796f; q = q * t;
    const f32x2 s = (v * v) * (-0.72134752044f);
    f32x2 e; e.x = __builtin_amdgcn_exp2f(s.x); e.y = __builtin_amdgcn_exp2f(s.y);
    const f32x2 m = v * (q * e), r = v - m;
    f32x2 o; o.x = v.x < 0.f ? m.x : r.x; o.y = v.y < 0.f ? m.y : r.y; return o;
}

template <int ACT  > struct EpiBf16 {
    static constexpr bool PERM = true, AFTER_DRAIN = false; static_assert(ACT == 0 || ACT == 1, "EpiBf16: ACT is 0 (none) or 1 (gelu_pk)");
    bf16_t* O; int ldc; const float* bias; int split_cols; size_t split_stride; float scale0;
    __device__ __forceinline__ void operator()(const f32x4 (&acc)[2][2][4][2], const Unit& u, int wr, int wc, int fr, int fq) const {
        const int row0 = u.pm * BM + wr * 64 + fr; int colt = u.pn * BM; bf16_t* base = O;
        float sc = 1.f; if (split_cols) { const int t = colt / split_cols; base += (size_t)t * split_stride; colt -= t * split_cols; if (t == 0) sc = scale0; }
        const int col0 = colt + wc * 32 + 8 * fq, bcol0 = u.pn * BM + wc * 32 + 8 * fq;
        f32x4 bv[2][2];
#pragma unroll
        for (int bj = 0; bj < 2; ++bj)
#pragma unroll
            for (int n = 0; n < 2; ++n) bv[bj][n] = bias ? *(const f32x4*)(bias + bcol0 + bj * HALF + 4 * n) : (f32x4){0.f, 0.f, 0.f, 0.f};
#pragma unroll
        for (int ai = 0; ai < 2; ++ai)
#pragma unroll
            for (int m = 0; m < 4; ++m) { bf16_t* rowp = base + (size_t)(row0 + ai * HALF + m * 16) * ldc + col0;
#pragma unroll
                for (int bj = 0; bj < 2; ++bj) { f32x4 v0 = acc[ai][bj][m][0] + bv[bj][0], v1 = acc[ai][bj][m][1] + bv[bj][1];
                    if (ACT == 1) { f32x2 a = gelu_pk((f32x2){v0[0], v0[1]}), b = gelu_pk((f32x2){v0[2], v0[3]}), c = gelu_pk((f32x2){v1[0], v1[1]}), d = gelu_pk((f32x2){v1[2], v1[3]});
                        v0 = (f32x4){a.x, a.y, b.x, b.y}; v1 = (f32x4){c.x, c.y, d.x, d.y}; }
                    v0 = v0 * sc; v1 = v1 * sc; u32x4 w; w.x = cvt_pk_bf16(v0[0], v0[1]); w.y = cvt_pk_bf16(v0[2], v0[3]); w.z = cvt_pk_bf16(v1[0], v1[1]); w.w = cvt_pk_bf16(v1[2], v1[3]);
                    *(u32x4*)(rowp + bj * HALF) = w; } }
    }
};
template <class Epi, class Sched, bool ALIGN_EPI = false, bool SP2 = false>
__device__ __forceinline__ void gemm_phase(PG8_LAS unsigned char* lds, const Gemm g, const Sched& S, const Epi& E, int tid_in) {
    const int tid = tid_in, wid = __builtin_amdgcn_readfirstlane(tid >> 6), lane = tid & 63, wr = wid >> 2, wc = wid & 3, fr = lane & 15, fq = lane >> 4;
    const int K = g.K, nt = K / BK;
    unsigned voffA[2], voffB[2];
#pragma unroll
    for (int i = 0; i < 2; ++i) { int R, C; stage_rc(tid * 16 + i * 8192, R, C); const int Rb = Epi::PERM ? ((R & ~31) + perm32(R & 31)) : R;
        voffA[i] = (unsigned)(R * K + C) * 2u; voffB[i] = (unsigned)(Rb * K + C) * 2u; }
    const size_t kstep = (size_t)(BK * 2);
    const size_t hstep = (size_t)HALF * K * 2;
    const size_t tstep = 2 * hstep;
    const unsigned ldsw = (unsigned)wid * 1024u;
    const int aoff = lds_byte(wr * 64 + fr, fq * 8), boff = lds_byte(wc * 32 + fr, fq * 8);
#define PG8_SA(b, h) (((b) * 2 + (h)) * HTB)
#define PG8_SB(b, h) ((4 + (b) * 2 + (h)) * HTB)
#define PG8_STAGE(bufoff, gbase, voff) do { _Pragma("unroll") for (int _i = 0; _i < 2; ++_i) \
        __builtin_amdgcn_global_load_lds((const unsigned*)((const char*)(gbase) + (voff)[_i]), (PG8_LAS unsigned*)(lds + (bufoff) + ldsw + _i * 8192), 16, 0, 0); } while (0)
#define PG8_LDA(dst, b, h) do { _Pragma("unroll") for (int m = 0; m < 4; ++m) _Pragma("unroll") for (int k = 0; k < 2; ++k) dst[m][k] = *(const PG8_LAS bf16x8*)(lds + PG8_SA(b, h) + aoff + m * 2048 + k * 1024); } while (0)
#define PG8_LDB(dst, b, h) do { _Pragma("unroll") for (int n = 0; n < 2; ++n) _Pragma("unroll") for (int k = 0; k < 2; ++k) dst[n][k] = *(const PG8_LAS bf16x8*)(lds + PG8_SB(b, h) + boff + n * 2048 + k * 1024); } while (0)
#define PG8_MMA(ai, bj, At, Bt) do { __builtin_amdgcn_s_setprio(1); _Pragma("unroll") for (int m = 0; m < 4; ++m) _Pragma("unroll") for (int n = 0; n < 2; ++n) _Pragma("unroll") for (int k = 0; k < 2; ++k) \
        acc[ai][bj][m][n] = __builtin_amdgcn_mfma_f32_16x16x32_bf16(Bt[n][k], At[m][k], acc[ai][bj][m][n], 0, 0, 0); __builtin_amdgcn_s_setprio(0); } while (0)
#define PG8_WAIT_V(n) asm volatile("s_waitcnt vmcnt(" #n ")" ::: "memory")
#define PG8_WAIT_L(n) asm volatile("s_waitcnt lgkmcnt(" #n ")" ::: "memory")
#define PG8_BAR __builtin_amdgcn_s_barrier()
#define PG8_SCHED __builtin_amdgcn_sched_barrier(0)
    Unit cur, nxt; int ui = 0;
    if (!S.next(0, cur)) return;
    f32x4 acc[2][2][4][2];
#pragma unroll
    for (int a = 0; a < 2; ++a)
#pragma unroll
        for (int b = 0; b < 2; ++b)
#pragma unroll
            for (int m = 0; m < 4; ++m)
#pragma unroll
                for (int n = 0; n < 2; ++n) acc[a][b][m][n] = (f32x4){0.f, 0.f, 0.f, 0.f};
    bf16x8 At[4][2], B0[2][2], B1[2][2];
    const char* cA = (const char*)g.A + (size_t)cur.pm * tstep; const char* cB = (const char*)g.Bt + (size_t)cur.pn * tstep;
    S.a_ready(cur);
    if constexpr (SP2) {
        PG8_STAGE(PG8_SB(0, 0), cB, voffB); PG8_STAGE(PG8_SB(0, 1), cB + hstep, voffB); PG8_STAGE(PG8_SA(0, 0), cA, voffA); PG8_STAGE(PG8_SA(0, 1), cA + hstep, voffA);
        if (wr == 1) PG8_BAR;
        PG8_WAIT_V(2); PG8_BAR;
        PG8_STAGE(PG8_SB(1, 0), cB + kstep, voffB); PG8_STAGE(PG8_SA(1, 0), cA + kstep, voffA); PG8_STAGE(PG8_SB(1, 1), cB + hstep + kstep, voffB);
        PG8_WAIT_V(6); PG8_BAR;
    } else {
        PG8_STAGE(PG8_SB(0, 0), cB, voffB); PG8_STAGE(PG8_SA(0, 0), cA, voffA); PG8_STAGE(PG8_SB(0, 1), cB + hstep, voffB); PG8_STAGE(PG8_SA(0, 1), cA + hstep, voffA);
        if (wr == 1) PG8_BAR;
        PG8_WAIT_V(4); PG8_BAR;
        PG8_STAGE(PG8_SB(1, 0), cB + kstep, voffB); PG8_STAGE(PG8_SA(1, 0), cA + kstep, voffA); PG8_STAGE(PG8_SB(1, 1), cB + hstep + kstep, voffB);
        PG8_WAIT_V(6); PG8_BAR;
    }
    for (;;) {
        const bool has_next = S.next(ui + 1, nxt);
        const char* nA = has_next ? (const char*)g.A + (size_t)nxt.pm * tstep : cA; const char* nB = has_next ? (const char*)g.Bt + (size_t)nxt.pn * tstep : cB;
        for (int t = 0; t < nt; t += 2) {
            const bool last = (t == nt - 2);
            const char* a1 = cA + (size_t)(t + 1) * kstep;
            const char* a2 = last ? nA : cA + (size_t)(t + 2) * kstep; const char* b2 = last ? nB : cB + (size_t)(t + 2) * kstep;
            const char* a3 = a2 + kstep; const char* b3 = b2 + kstep;
            if (last && has_next) S.a_ready(nxt);
            if constexpr (SP2) {
            PG8_LDB(B0, 0, 0); PG8_LDB(B1, 0, 1); PG8_SCHED; PG8_LDA(At, 0, 0); PG8_STAGE(PG8_SA(1, 1), a1 + hstep, voffA);
            PG8_WAIT_V(8); PG8_WAIT_L(0); PG8_BAR; PG8_MMA(0, 0, At, B0); PG8_MMA(0, 1, At, B1); PG8_BAR; PG8_SCHED;
            PG8_LDA(At, 0, 1); PG8_STAGE(PG8_SB(0, 0), b2, voffB); PG8_STAGE(PG8_SB(0, 1), b2 + hstep, voffB); PG8_STAGE(PG8_SA(0, 0), a2, voffA);
            PG8_WAIT_V(8); PG8_WAIT_L(0); PG8_BAR; PG8_MMA(1, 0, At, B0); PG8_MMA(1, 1, At, B1); PG8_BAR; PG8_SCHED;
            PG8_LDB(B0, 1, 0); PG8_LDB(B1, 1, 1); PG8_SCHED; PG8_LDA(At, 1, 0); PG8_STAGE(PG8_SA(0, 1), a2 + hstep, voffA);
            PG8_WAIT_V(8); PG8_WAIT_L(0); PG8_BAR; PG8_MMA(0, 0, At, B0); PG8_MMA(0, 1, At, B1); PG8_BAR; PG8_SCHED;
            PG8_LDA(At, 1, 1); PG8_STAGE(PG8_SB(1, 0), b3, voffB); PG8_STAGE(PG8_SB(1, 1), b3 + hstep, voffB); PG8_STAGE(PG8_SA(1, 0), a3, voffA);
            PG8_WAIT_V(8); PG8_WAIT_L(0); PG8_BAR; PG8_MMA(1, 0, At, B0); PG8_MMA(1, 1, At, B1); PG8_BAR; PG8_SCHED;
            } else {
            PG8_LDB(B0, 0, 0); PG8_SCHED; PG8_LDA(At, 0, 0); PG8_STAGE(PG8_SA(1, 1), a1 + hstep, voffA);
            PG8_WAIT_L(8); PG8_BAR; PG8_WAIT_L(0); PG8_MMA(0, 0, At, B0); PG8_BAR; PG8_SCHED;
            PG8_LDB(B1, 0, 1); PG8_STAGE(PG8_SB(0, 0), b2, voffB);
            PG8_BAR; PG8_WAIT_L(0); PG8_MMA(0, 1, At, B1); PG8_BAR;
            PG8_LDA(At, 0, 1); PG8_STAGE(PG8_SA(0, 0), a2, voffA);
            PG8_BAR; PG8_WAIT_L(0); PG8_MMA(1, 0, At, B0); PG8_BAR; PG8_SCHED;
            PG8_STAGE(PG8_SB(0, 1), b2 + hstep, voffB);
            PG8_WAIT_V(6); PG8_BAR; PG8_MMA(1, 1, At, B1); PG8_BAR;
            PG8_LDB(B0, 1, 0); PG8_SCHED; PG8_LDA(At, 1, 0); PG8_STAGE(PG8_SA(0, 1), a2 + hstep, voffA);
            PG8_WAIT_L(8); PG8_BAR; PG8_WAIT_L(0); PG8_MMA(0, 0, At, B0); PG8_BAR; PG8_SCHED;
            PG8_LDB(B1, 1, 1); PG8_STAGE(PG8_SB(1, 0), b3, voffB);
            PG8_BAR; PG8_WAIT_L(0); PG8_MMA(0, 1, At, B1); PG8_BAR;
            PG8_LDA(At, 1, 1); PG8_STAGE(PG8_SA(1, 0), a3, voffA);
            PG8_BAR; PG8_WAIT_L(0); PG8_MMA(1, 0, At, B0); PG8_BAR; PG8_SCHED;
            PG8_STAGE(PG8_SB(1, 1), b3 + hstep, voffB);
            PG8_WAIT_V(6); PG8_BAR; PG8_MMA(1, 1, At, B1); PG8_BAR;
            }
        }
        if constexpr (ALIGN_EPI) { if (wr == 0) PG8_BAR; }
        if constexpr (!Epi::AFTER_DRAIN) { E(acc, cur, wr, wc, fr, fq); S.done(cur); }
        if (!has_next) break;
#pragma unroll
        for (int a = 0; a < 2; ++a)
#pragma unroll
            for (int b = 0; b < 2; ++b)
#pragma unroll
                for (int m = 0; m < 4; ++m)
#pragma unroll
                    for (int n = 0; n < 2; ++n) acc[a][b][m][n] = (f32x4){0.f, 0.f, 0.f, 0.f};
        cur = nxt; cA = nA; cB = nB; ++ui;
        if constexpr (ALIGN_EPI) { if (wr == 1) PG8_BAR; }
    }
    PG8_WAIT_V(0);
    if constexpr (!ALIGN_EPI) { if (wr == 0) PG8_BAR; }
    PG8_BAR;
    if constexpr (Epi::AFTER_DRAIN) { E.fused(acc, cur, wr, wc, fr, fq, lds, wid, lane); S.done(cur); }
#undef PG8_SA
#undef PG8_SB
#undef PG8_STAGE
#undef PG8_LDA
#undef PG8_LDB
#undef PG8_MMA
#undef PG8_WAIT_V
#undef PG8_WAIT_L
#undef PG8_BAR
#undef PG8_SCHED
}
}
#define GAS __attribute__((address_space(1)))
#define LAS __attribute__((address_space(3)))
typedef unsigned short bf16;
typedef unsigned v4u __attribute__((ext_vector_type(4)));
typedef float f32x4 __attribute__((ext_vector_type(4)));
typedef short bf16x8 __attribute__((ext_vector_type(8)));
typedef GAS unsigned gu32;
typedef GAS unsigned long long gu64;
#define RLX_AGENT __ATOMIC_RELAXED, __HIP_MEMORY_SCOPE_AGENT
#define LDS_WAIT() asm volatile("s_waitcnt lgkmcnt(0)" ::: "memory")
#define VM_WAIT() asm volatile("s_waitcnt vmcnt(0)" ::: "memory")
__device__ __forceinline__ unsigned long long rt() { return __builtin_amdgcn_s_memrealtime(); }
__device__ __forceinline__ unsigned f2bf(float f) { unsigned u = __builtin_bit_cast(unsigned, f); return (u + 0x7fffu + ((u >> 16) & 1u)) >> 16; }
__device__ __forceinline__ unsigned pk2(float lo, float hi) { return f2bf(lo) | (f2bf(hi) << 16); }

#define XB_TMO      128
#define XB_XCNT(j)  (256  + 64 * (j))
#define XB_XSUB(j)  (1280 + 64 * (j))
#define XB_XGEN(j)  (2304 + 64 * (j))
#define XB_TOP      3328
#define XB_TOPGEN   3392
#define XCD_BAR_WORDS 3456
#define XB_SPIN_CAP (1u << 18)

__device__ __forceinline__ unsigned xb_ld(unsigned* p)              { return __hip_atomic_load(p, __ATOMIC_RELAXED, __HIP_MEMORY_SCOPE_AGENT); }
__device__ __forceinline__ unsigned xb_add(unsigned* p, unsigned v) { return __hip_atomic_fetch_add(p, v, __ATOMIC_RELAXED, __HIP_MEMORY_SCOPE_AGENT); }
__device__ __forceinline__ unsigned xb_xcc_id() { return (unsigned)__builtin_amdgcn_s_getreg((3 << 11) | 20) & 0xFu; }
#define XB_SPIN(cond, bar) do { unsigned _sp = 0; while (cond) { __builtin_amdgcn_s_sleep(1); \
    if ((++_sp & 255u) == 0u) { if (xb_ld(&(bar)[XB_TMO])) break; if (_sp > XB_SPIN_CAP) { atomicAdd(&(bar)[XB_TMO], 1u); break; } } } } while (0)

struct XcdBarrier {
    unsigned* bar; unsigned x;
    volatile LAS unsigned* st;
};

__device__ __forceinline__ XcdBarrier xcd_barrier_post(unsigned* bar, volatile LAS unsigned* st) {
    XcdBarrier b; b.bar = bar; b.x = xb_xcc_id(); b.st = st;
    if (threadIdx.x == 0) (void)xb_add(&bar[XB_XCNT(b.x)], 1u);
    return b;
}
__device__ __forceinline__ void xcd_barrier_complete(unsigned* bar, unsigned x, unsigned& nloc, unsigned& nx) {
    const unsigned G = gridDim.x * gridDim.y * gridDim.z;
    unsigned sum, cnt, mine, sp = 0u;
    for (;;) {
        sum = 0u; cnt = 0u; mine = 0u;
#pragma unroll
        for (unsigned j = 0; j < 16; ++j) { const unsigned c = xb_ld(&bar[XB_XCNT(j)]); sum += c; cnt += (c > 0u) ? 1u : 0u; mine = (j == x) ? c : mine; }
        if (sum == G) break;
        __builtin_amdgcn_s_sleep(1);
        if ((++sp & 255u) == 0u) { if (xb_ld(&bar[XB_TMO])) break; if (sp > XB_SPIN_CAP) { atomicAdd(&bar[XB_TMO], 1u); break; } }
    }
    nloc = mine > 0u ? mine : 1u; nx = cnt > 0u ? cnt : 1u;
}

__device__ __forceinline__ void xcd_barrier(const XcdBarrier& b) {
    asm volatile("s_waitcnt vmcnt(0)" ::: "memory");
    __syncthreads();
    if (threadIdx.x == 0) {
        unsigned* bar = b.bar;
        __builtin_amdgcn_s_waitcnt(0);
        unsigned nloc = b.st[0], nx = b.st[1];
        if (nloc == 0u) { xcd_barrier_complete(bar, b.x, nloc, nx); b.st[0] = nloc; b.st[1] = nx; }
        const unsigned old = xb_add(&bar[XB_XSUB(b.x)], 1u);
        const unsigned gen = old / nloc;
        if (old + 1u == (gen + 1u) * nloc) {
            __builtin_amdgcn_fence(__ATOMIC_RELEASE, "agent");
            asm volatile("s_waitcnt vmcnt(0)" ::: "memory");
            const unsigned og = xb_add(&bar[XB_TOP], 1u);
            const unsigned tg = og / nx;
            if (og + 1u == (tg + 1u) * nx) xb_add(&bar[XB_TOPGEN], 1u);
            else XB_SPIN(xb_ld(&bar[XB_TOPGEN]) == tg, bar);
            __builtin_amdgcn_fence(__ATOMIC_ACQUIRE, "agent");
            xb_add(&bar[XB_XGEN(b.x)], 1u);
            asm volatile("s_waitcnt vmcnt(0)" ::: "memory");
        } else {
            XB_SPIN(xb_ld(&bar[XB_XGEN(b.x)]) == gen, bar);
            __builtin_amdgcn_fence(__ATOMIC_ACQUIRE, "agent");
            asm volatile("s_waitcnt vmcnt(0)" ::: "memory");
        }
    }
    __syncthreads();
}
constexpr int NB = 4, SEQ = 4096, T = NB * SEQ, DM = 1024, DEPTH = 4;
constexpr int NE = 4608, NO = 3328;
constexpr int EC_QLAT = 0, EC_CKV = 2048, EC_QI = 2304, EC_KI = 2816, EC_QB = 2880, EC_KB = 3392, EC_VB = 3904, EC_WI = 4416;
constexpr int OC_Q = 0, OC_K = 1024, OC_V = 2048, OC_F = 3072;
constexpr int KEO = 2560;
constexpr int EVEN_IN = 2888, ODD_IN = 3088;
constexpr float RMS_EPS = 1e-6f;
constexpr float LOG2E = 1.4426950408889634f;
constexpr float C2 = 0.125f * LOG2E;
constexpr int NWAVES = 8, NTHR = 512;

constexpr size_t MiB = 1u << 20;
constexpr size_t WS_CTL = 0, CTL_ZERO_BYTES = 1 * MiB;
constexpr size_t WS_MOD = 1 * MiB;
constexpr size_t WS_KN = 2 * MiB;
constexpr size_t WS_FCUM = 3 * MiB;
constexpr size_t WS_WEIN = 4 * MiB;
constexpr size_t WS_WOIN = 22 * MiB;
constexpr size_t WS_WEOUT = 35 * MiB;
constexpr size_t WS_WOOUT = 45 * MiB;
constexpr size_t WS_WPQ = 49 * MiB;
constexpr size_t WS_WSK = 65 * MiB;
constexpr size_t WS_PU = 66 * MiB, WS_PV = 98 * MiB;
constexpr size_t WS_U8 = 66 * MiB;
constexpr size_t WS_V8 = 82 * MiB;
constexpr size_t WS_SU = 98 * MiB, WS_SV = 99 * MiB;
constexpr size_t WS_ACT = 100 * MiB;
constexpr size_t WS_H8 = 108 * MiB;
constexpr size_t WS_SX = 124 * MiB;
constexpr size_t WS_X = 130 * MiB;
constexpr size_t WS_H = 194 * MiB;
constexpr size_t WS_P = 226 * MiB;
constexpr size_t WS_AO = 370 * MiB;
constexpr size_t WS_CKV = 450 * MiB;
constexpr size_t WS_SEL = 458 * MiB;
constexpr size_t WS_PE = 466 * MiB;
constexpr size_t WS_PG = 474 * MiB;
constexpr size_t WS_END = 482 * MiB;
constexpr int CW_BAR = 4096;
constexpr int CW_RANK = 16384;

constexpr int RING_BYTES = 131072;
constexpr int LDS_BYTES = 163840;
constexpr int MISC_OFF = LDS_BYTES - 512;
constexpr int XTRA_OFF = RING_BYTES;

__device__ __constant__ unsigned char T5_BUCKET[128] = {
  0, 1, 2, 3, 4, 5, 6, 7, 8, 9, 10, 11, 12, 13, 14, 15, 16, 16, 16, 17, 17, 18, 18, 18, 19, 19, 19, 20, 20, 20, 20, 21, 21, 21, 21, 22, 22, 22, 22, 22,
  23, 23, 23, 23, 23, 23, 24, 24, 24, 24, 24, 24, 25, 25, 25, 25, 25, 25, 25, 26, 26, 26, 26, 26, 26, 26, 26, 27, 27, 27, 27, 27, 27, 27, 27, 27, 27,
  28, 28, 28, 28, 28, 28, 28, 28, 28, 28, 29, 29, 29, 29, 29, 29, 29, 29, 29, 29, 29, 29, 30, 30, 30, 30, 30, 30, 30, 30, 30, 30, 30, 30, 30, 30,
  31, 31, 31, 31, 31, 31, 31, 31, 31, 31, 31, 31, 31, 31, 31};
__device__ __forceinline__ int t5_bucket(int d) { return d >= 128 ? 31 : (int)T5_BUCKET[d]; }
typedef float f32x16 __attribute__((ext_vector_type(16)));
typedef short s16x4 __attribute__((ext_vector_type(4)));
typedef unsigned u32x2 __attribute__((ext_vector_type(2)));
typedef unsigned u32x4 __attribute__((ext_vector_type(4)));
typedef int i32x4 __attribute__((ext_vector_type(4)));
#define KAS __attribute__((address_space(4)))
struct Frame {
    LAS unsigned char* lds;
    volatile LAS unsigned* MISC;
    gu32* ctl;
    int tid, lane, wave;
    int vcu, G, vcu0, wave0;
    unsigned char* ws;
    const KAS char* ka; const KAS char* ka0;
    float* out;
    __device__ __forceinline__ const float* inp(int i) const { return *(const float* const KAS*)(ka + 8 * i); }
};
#define PHASE_BEGIN(F) do { const KAS char* ka_ = (F).ka0; asm volatile("" : "+s"(ka_)); (F).ka = ka_; (F).out = *(float* const KAS*)(ka_ + 176); (F).ws = *(unsigned char* const KAS*)(ka_ + 184); \
    (F).ctl = (gu32*)((F).ws + WS_CTL); int t_ = threadIdx.x; asm volatile("" : "+v"(t_)); (F).tid = t_; (F).lane = t_ & 63; (F).wave = __builtin_amdgcn_readfirstlane(t_ >> 6); \
    int v_ = (F).vcu0; asm volatile("" : "+s"(v_)); (F).vcu = v_; } while (0)
__device__ __forceinline__ float wave_sum(float v) {
#pragma unroll
    for (int o = 1; o < 64; o <<= 1) v += __shfl_xor(v, o);
    return v;
}
__device__ __forceinline__ float bf2f(unsigned h) { return __uint_as_float(h << 16); }
__device__ __forceinline__ float bflo(unsigned w) { return __uint_as_float(w << 16); }
__device__ __forceinline__ float bfhi(unsigned w) { return __uint_as_float(w & 0xffff0000u); }
__device__ __forceinline__ float siluf(float x) { return x / (1.f + __expf(-x)); }
__device__ __forceinline__ float gelu_tanh(float x) {
    const float u = 0.7978845608028654f * (x + 0.044715f * x * x * x);
    const float e = __expf(2.f * u);
    const float th = 1.f - 2.f / (e + 1.f);
    return 0.5f * x * (1.f + th);
}
enum { I_X = 0, I_C, I_RELB, I_ADAW, I_ADAB, I_NMIX, I_NFFN, I_NFIN, I_EWIN, I_EWOUT, I_KVN, I_WUK, I_WUV, I_LAM, I_SUBLN, I_OWIN, I_BF, I_OWOUT, I_PWQ, I_PSK, I_PU, I_PV };

__device__ __forceinline__ void tr_item(const float* W, int ldw, int sc0, int ncols, bf16* WT, int ldt, int dr0, int dc0, float scale, LAS float* scr, int kb, int nb, int lane) {
    const int k0 = 64 * kb, n0 = 32 * nb;
    const int nn = lane & 31; const bool ok = (n0 + nn) < ncols;
#pragma unroll 8
    for (int i = 0; i < 32; ++i) { const int kk = 2 * i + (lane >> 5); scr[kk * 33 + nn] = ok ? W[(size_t)(k0 + kk) * ldw + sc0 + n0 + nn] * scale : 0.f; }
    LDS_WAIT(); asm volatile("" ::: "memory");
    const int c = lane & 7;
#pragma unroll
    for (int j = 0; j < 4; ++j) { const int n = (lane >> 3) + 8 * j; const LAS float* s = scr + (8 * c) * 33 + n;
        v4u o; o.x = pk2(s[0 * 33], s[1 * 33]); o.y = pk2(s[2 * 33], s[3 * 33]); o.z = pk2(s[4 * 33], s[5 * 33]); o.w = pk2(s[6 * 33], s[7 * 33]);
        if (n0 + n < ncols) *(GAS v4u*)(WT + (size_t)(dr0 + n0 + n) * ldt + dc0 + k0 + 8 * c) = o; }
    LDS_WAIT(); asm volatile("" ::: "memory");
}
struct TrJob { const float* W; int ldw, sc0, ncols, K; bf16* WT; int ldt, dr0, dc0; float scale; };
__device__ __forceinline__ TrJob get_trjob(const Frame& F, int j) {
    TrJob J;
    if (j < 14) { const int e = j / 7, s = j % 7;
        const int sc0[7] = {512, 768, 1280, 1344, 1352, 1864, 2376}; const int nc[7] = {256, 512, 64, 8, 512, 512, 512};
        const int dr[7] = {EC_CKV, EC_QI, EC_KI, EC_WI, EC_QB, EC_KB, EC_VB}; const float sc[7] = {1.f, 0.125f, 1.f, 0.35355339059327373f, C2, 1.f, 1.f};
        int a = 0, b = 0, c = 0; float d = 1.f;
#pragma unroll
        for (int q = 0; q < 7; ++q) if (q == s) { a = sc0[q]; b = nc[q]; c = dr[q]; d = sc[q]; }
        J.W = F.inp(I_EWIN) + (size_t)e * DM * EVEN_IN; J.ldw = EVEN_IN; J.sc0 = a; J.ncols = b; J.K = DM; J.WT = (bf16*)(F.ws + WS_WEIN) + (size_t)e * NE * DM; J.ldt = DM; J.dr0 = c; J.dc0 = 0; J.scale = d;
    } else if (j < 22) { const int o = (j - 14) / 4, s = (j - 14) % 4;
        J.W = F.inp(I_OWIN) + (size_t)o * DM * ODD_IN; J.ldw = ODD_IN; J.sc0 = 1024 * s; J.ncols = (s == 3) ? 16 : 1024; J.K = DM; J.WT = (bf16*)(F.ws + WS_WOIN) + (size_t)o * NO * DM; J.ldt = DM; J.dr0 = 1024 * s; J.dc0 = 0; J.scale = (s == 0) ? C2 : 1.f;
    } else if (j < 24) { const int e = j - 22;
        J.W = F.inp(I_EWOUT) + (size_t)e * DM * DM + (size_t)512 * DM; J.ldw = DM; J.sc0 = 0; J.ncols = DM; J.K = 512; J.WT = (bf16*)(F.ws + WS_WEOUT) + (size_t)e * DM * KEO; J.ldt = KEO; J.dr0 = 0; J.dc0 = 2048; J.scale = 1.f;
    } else if (j < 26) { const int o = j - 24;
        J.W = F.inp(I_OWOUT) + (size_t)o * DM * DM; J.ldw = DM; J.sc0 = 0; J.ncols = DM; J.K = DM; J.WT = (bf16*)(F.ws + WS_WOOUT) + (size_t)o * DM * DM; J.ldt = DM; J.dr0 = 0; J.dc0 = 0; J.scale = 1.f;
    } else { const int l = j - 26;
        J.W = F.inp(I_PWQ) + (size_t)l * DM * 2048; J.ldw = 2048; J.sc0 = 0; J.ncols = 2048; J.K = DM; J.WT = (bf16*)(F.ws + WS_WPQ) + (size_t)l * 2048 * DM; J.ldt = DM; J.dr0 = 0; J.dc0 = 0; J.scale = 1.f;
    }
    return J;
}
constexpr int N_TRJOBS = 30;
__device__ __forceinline__ int trjob_items(int j) {
    if (j < 14) { const int s = j % 7; const int nb[7] = {8, 16, 2, 1, 16, 16, 16}; int r = 0;
#pragma unroll
        for (int q = 0; q < 7; ++q) if (q == s) r = nb[q]; return 16 * r; }
    if (j < 22) return 16 * (((j - 14) % 4 == 3) ? 1 : 32);
    if (j < 24) return 8 * 32;
    if (j < 26) return 16 * 32;
    return 16 * 64;
}
__device__ __forceinline__ void p0_transposes(Frame& F) { PHASE_BEGIN(F);
    LAS float* scr = (LAS float*)(F.lds + F.wave * 16384);
    const int gw = F.vcu * NWAVES + F.wave, NGW = F.G * NWAVES;
    int base = 0;
    for (int j = 0; j < N_TRJOBS; ++j) {
        const int ni = trjob_items(j);
        int it = ((gw - base) % NGW + NGW) % NGW;
        if (it < ni) { const TrJob J = get_trjob(F, j); const int nblk = (J.ncols + 31) / 32;
            for (; it < ni; it += NGW) tr_item(J.W, J.ldw, J.sc0, J.ncols, J.WT, J.ldt, J.dr0, J.dc0, J.scale, scr, it / nblk, it % nblk, F.lane); }
        base += ni;
    }
    const int gt = F.vcu * NTHR + F.tid, NGT = F.G * NTHR;
    for (int e = 0; e < 2; ++e) { GAS v4u* p = (GAS v4u*)((bf16*)(F.ws + WS_WEIN) + (size_t)e * NE * DM + (size_t)4424 * DM); const int n = (NE - 4424) * DM / 8;
        for (int i = gt; i < n; i += NGT) p[i] = (v4u){0u, 0u, 0u, 0u}; }
    for (int o = 0; o < 2; ++o) { GAS v4u* p = (GAS v4u*)((bf16*)(F.ws + WS_WOIN) + (size_t)o * NO * DM + (size_t)ODD_IN * DM); const int n = (NO - ODD_IN) * DM / 8;
        for (int i = gt; i < n; i += NGT) p[i] = (v4u){0u, 0u, 0u, 0u}; }
    { const float* s = F.inp(I_PSK); bf16* d = (bf16*)(F.ws + WS_WSK); const int n = DEPTH * 2 * 128 * 128 / 4;
        for (int i = gt; i < n; i += NGT) { const f32x4 v = *(const GAS f32x4*)(s + (size_t)i * 4); u32x2 w; w.x = pk2(v.x, v.y); w.y = pk2(v.z, v.w); *(GAS u32x2*)(d + (size_t)i * 4) = w; } }
}
template <int kind> __device__ __forceinline__ void p0_fused_weights_k(Frame& F) { PHASE_BEGIN(F);
    LAS float* At = (LAS float*)F.lds;
    for (int it = F.vcu; it < 256; it += F.G) {
        const int e = (it >> 7) & 1, h = (it >> 4) & 7, blk = it & 15;
        __syncthreads();
        if (kind == 0) {
            const float* W = F.inp(I_EWIN) + (size_t)e * DM * EVEN_IN;
            for (int i = F.tid; i < 4096; i += NTHR) { const int kk = i >> 6, d = i & 63; At[kk * 65 + d] = W[(size_t)(64 * blk + kk) * EVEN_IN + 64 * h + d]; }
        } else {
            const float* W = F.inp(I_EWOUT) + (size_t)e * DM * DM;
            for (int i = F.tid; i < 4096; i += NTHR) { const int d = i >> 6, nn = i & 63; At[nn * 65 + d] = W[(size_t)(64 * h + d) * DM + 64 * blk + nn]; }
        }
        __syncthreads();
        const int c = F.tid & 255, half = F.tid >> 8;
        const float* Bsrc = (kind == 0 ? F.inp(I_WUK) : F.inp(I_WUV)) + (((size_t)e * 256 + c) * 8 + h) * 64;
        float br[64];
#pragma unroll
        for (int d4 = 0; d4 < 16; ++d4) { const f32x4 v = *(const GAS f32x4*)(Bsrc + 4 * d4); br[4 * d4] = v.x; br[4 * d4 + 1] = v.y; br[4 * d4 + 2] = v.z; br[4 * d4 + 3] = v.w; }
        if (kind == 0) {
            bf16* dst = (bf16*)(F.ws + WS_WEIN) + (size_t)e * NE * DM + (size_t)(h * 256 + c) * DM + 64 * blk + 32 * half;
#pragma unroll 1
            for (int kq = 0; kq < 16; ++kq) { const LAS float* a0 = At + (32 * half + 2 * kq) * 65; float s0 = 0.f, s1 = 0.f;
#pragma unroll
                for (int d = 0; d < 64; ++d) { s0 += a0[d] * br[d]; s1 += a0[65 + d] * br[d]; }
                *(GAS unsigned*)(dst + 2 * kq) = pk2(s0 * C2, s1 * C2); }
        } else {
            bf16* dst = (bf16*)(F.ws + WS_WEOUT) + (size_t)e * DM * KEO + (size_t)(64 * blk + 32 * half) * KEO + h * 256 + c;
#pragma unroll 1
            for (int q = 0; q < 32; ++q) { const LAS float* a = At + (32 * half + q) * 65; float s = 0.f;
#pragma unroll
                for (int d = 0; d < 64; ++d) s += a[d] * br[d];
                dst[(size_t)q * KEO] = (bf16)f2bf(s); }
        }
    }
    __syncthreads();
}
__device__ __forceinline__ void p0_fused_weights(Frame& F) { p0_fused_weights_k<0>(F); p0_fused_weights_k<1>(F); }
__device__ __forceinline__ void p0_mod(Frame& F) { PHASE_BEGIN(F);
    LAS float* cs = (LAS float*)F.lds;
    LAS float* red = (LAS float*)(F.lds + 16384);
    for (int i = F.tid; i < 4 * DM; i += NTHR) cs[i] = siluf(F.inp(I_C)[i]);
    __syncthreads();
    float* mod = (float*)(F.ws + WS_MOD);
    for (int it = F.vcu; it < DEPTH * 96; it += F.G) {
        const int l = it / 96, j0 = 64 * (it % 96);
        const float* W = F.inp(I_ADAW) + (size_t)l * DM * 6144 + j0 + F.lane;
        float a0 = 0.f, a1 = 0.f, a2 = 0.f, a3 = 0.f;
        const int kb = 128 * F.wave;
#pragma unroll 16
        for (int k = 0; k < 128; ++k) { const float w = W[(size_t)(kb + k) * 6144]; a0 += cs[kb + k] * w; a1 += cs[1024 + kb + k] * w; a2 += cs[2048 + kb + k] * w; a3 += cs[3072 + kb + k] * w; }
        red[(F.wave * 4 + 0) * 64 + F.lane] = a0; red[(F.wave * 4 + 1) * 64 + F.lane] = a1; red[(F.wave * 4 + 2) * 64 + F.lane] = a2; red[(F.wave * 4 + 3) * 64 + F.lane] = a3;
        __syncthreads();
        if (F.tid < 256) { const int b = F.tid >> 6, jj = F.tid & 63; float s = F.inp(I_ADAB)[(size_t)l * 6144 + j0 + jj];
#pragma unroll
            for (int w = 0; w < 8; ++w) s += red[(w * 4 + b) * 64 + jj];
            mod[((size_t)l * 4 + b) * 6144 + j0 + jj] = s; }
        __syncthreads();
    }
}
typedef float f32x2v __attribute__((ext_vector_type(2)));
__device__ __forceinline__ void conv_peer_tables(Frame& F, int layer) { PHASE_BEGIN(F);
    const int gw = F.vcu * NWAVES + F.wave, NGW = F.G * NWAVES, lane = F.lane;
    const float* pu = F.inp(I_PU) + (size_t)layer * 16384 * 1024; const float* pv = F.inp(I_PV) + (size_t)layer * 16384 * 1024;
    unsigned char* U8 = F.ws + WS_U8; unsigned char* V8 = F.ws + WS_V8; float* SU = (float*)(F.ws + WS_SU); float* SV = (float*)(F.ws + WS_SV);
    for (int row = gw; row < 32768; row += NGW) {
        const int isv = row >> 14, e = row & 16383;
        const float* src = (isv ? pv : pu) + (size_t)e * 1024 + 16 * lane;
        f32x4 x[4]; float mx = 0.f;
#pragma unroll
        for (int q = 0; q < 4; ++q) { x[q] = __builtin_nontemporal_load((const GAS f32x4*)(src + 4 * q)); mx = fmaxf(mx, fmaxf(fmaxf(fabsf(x[q].x), fabsf(x[q].y)), fmaxf(fabsf(x[q].z), fabsf(x[q].w)))); }
#pragma unroll
        for (int o = 1; o < 64; o <<= 1) mx = fmaxf(mx, __shfl_xor(mx, o));
        const float sc = mx > 0.f ? mx * (1.f / 400.f) : 1.f, inv = 1.f / sc;
        v4u w;
#pragma unroll
        for (int q = 0; q < 4; ++q) { int t = __builtin_amdgcn_cvt_pk_fp8_f32(x[q].x * inv, x[q].y * inv, 0, false); t = __builtin_amdgcn_cvt_pk_fp8_f32(x[q].z * inv, x[q].w * inv, t, true); w[q] = (unsigned)t; }
        if (isv) { *(GAS v4u*)(V8 + (size_t)(lane >> 3) * (16384 * 128) + (size_t)e * 128 + (lane & 7) * 16) = w; if (lane == 0) SV[e] = sc; }
        else { *(GAS v4u*)(U8 + (size_t)e * 1024 + 16 * lane) = w; if (lane == 0) SU[e] = sc; }
    }
}
__device__ __forceinline__ void norm_mod_row(const float* xrow, const float* g, const float* sc, const float* sh, bf16* orow, unsigned char* o8, float* sx, int lane) {
    const GAS f32x4* xr = (const GAS f32x4*)xrow + lane;
    f32x4 v[4]; float s2 = 0.f;
#pragma unroll
    for (int j = 0; j < 4; ++j) { v[j] = xr[64 * j]; s2 += (v[j].x * v[j].x + v[j].y * v[j].y) + (v[j].z * v[j].z + v[j].w * v[j].w); }
    const float rstd = 1.f / sqrtf(wave_sum(s2) * (1.f / DM) + RMS_EPS);
    GAS unsigned long long* o8b = (GAS unsigned long long*)orow + lane; float mx = 0.f;
#pragma unroll
    for (int j = 0; j < 4; ++j) { const f32x4 gg = *((const GAS f32x4*)g + lane + 64 * j), cc = *((const GAS f32x4*)sc + lane + 64 * j), hh = *((const GAS f32x4*)sh + lane + 64 * j);
        const f32x4 y = v[j] * rstd * gg * (cc + 1.f) + hh; v[j] = y;
        mx = fmaxf(mx, fmaxf(fmaxf(fabsf(y.x), fabsf(y.y)), fmaxf(fabsf(y.z), fabsf(y.w))));
        o8b[64 * j] = (unsigned long long)pk2(y.x, y.y) | ((unsigned long long)pk2(y.z, y.w) << 32); }
    if (o8) {
#pragma unroll
        for (int o = 1; o < 64; o <<= 1) mx = fmaxf(mx, __shfl_xor(mx, o));
        const float scl = mx > 0.f ? mx * (1.f / 400.f) : 1.f, inv = 1.f / scl;
#pragma unroll
        for (int j = 0; j < 4; ++j) { int t = __builtin_amdgcn_cvt_pk_fp8_f32(v[j].x * inv, v[j].y * inv, 0, false); t = __builtin_amdgcn_cvt_pk_fp8_f32(v[j].z * inv, v[j].w * inv, t, true);
            *((GAS unsigned*)o8 + lane + 64 * j) = (unsigned)t; }
        if (lane == 0) *sx = scl;
    }
}
__device__ __forceinline__ void norm_mod_phase(Frame& F, int src_ws, int layer, int which) { PHASE_BEGIN(F);
    const int gw = F.vcu * NWAVES + F.wave, NGW = F.G * NWAVES;
    const float* g = F.inp(which == 0 ? I_NMIX : I_NFFN) + (size_t)layer * DM;
    const float* mod = (const float*)(F.ws + WS_MOD) + (size_t)layer * 4 * 6144;
    bf16* H = (bf16*)(F.ws + WS_H);
    const float* X = src_ws ? (const float*)(F.ws + WS_X) : F.inp(I_X);
    for (int m = gw; m < T; m += NGW) { const float* mb = mod + (size_t)(m / SEQ) * 6144 + (which == 0 ? 0 : 3 * DM);
        norm_mod_row(X + (size_t)m * DM, g, mb + DM, mb, H + (size_t)m * DM, nullptr, nullptr, F.lane); }
}
__device__ __forceinline__ void final_norm_phase(Frame& F) { PHASE_BEGIN(F);
    const int gw = F.vcu * NWAVES + F.wave, NGW = F.G * NWAVES;
    const float* X = (const float*)(F.ws + WS_X); const float* g = F.inp(I_NFIN);
    for (int m = gw; m < T; m += NGW) { const GAS f32x4* xr = (const GAS f32x4*)(X + (size_t)m * DM) + F.lane; f32x4 v[4]; float s2 = 0.f;
#pragma unroll
        for (int j = 0; j < 4; ++j) { v[j] = xr[64 * j]; s2 += (v[j].x * v[j].x + v[j].y * v[j].y) + (v[j].z * v[j].z + v[j].w * v[j].w); }
        const float rstd = 1.f / sqrtf(wave_sum(s2) * (1.f / DM) + RMS_EPS);
        GAS f32x4* o = (GAS f32x4*)(F.out + (size_t)m * DM) + F.lane;
#pragma unroll
        for (int j = 0; j < 4; ++j) o[64 * j] = v[j] * rstd * *((const GAS f32x4*)g + F.lane + 64 * j); }
}
__device__ __forceinline__ unsigned f2sort(float x) { const unsigned u = __float_as_uint(x); return (u & 0x80000000u) ? ~u : (u | 0x80000000u); }
__device__ __forceinline__ float sort2f(unsigned k) { return __uint_as_float((k & 0x80000000u) ? (k & 0x7fffffffu) : ~k); }
__device__ __forceinline__ unsigned mbcnt64(unsigned long long m) { return __builtin_amdgcn_mbcnt_hi((unsigned)(m >> 32), __builtin_amdgcn_mbcnt_lo((unsigned)m, 0u)); }
#define LDS_FENCE() asm volatile("s_waitcnt lgkmcnt(0)" ::: "memory")

__device__ __forceinline__ void topk_unit(Frame& F, int b, int t0) {
    const int lane = F.lane, wid = F.wave, r32 = lane & 31, hi = lane >> 5;
    const bf16* P = (const bf16*)(F.ws + WS_P) + (size_t)b * SEQ * NE;
    LAS float* scores = (LAS float*)F.lds;
    LAS unsigned* minmax = (LAS unsigned*)(F.lds + XTRA_OFF + 24576);
    if (F.tid < 16) minmax[F.tid] = (F.tid & 1) ? 0xffffffffu : 0u;
    bf16x8 qa[2][4];
#pragma unroll
    for (int rt = 0; rt < 2; ++rt)
#pragma unroll
        for (int d0 = 0; d0 < 4; ++d0) qa[rt][d0] = *(const GAS bf16x8*)(P + (size_t)(t0 + 4 * rt + (r32 >> 3)) * NE + EC_QI + (r32 & 7) * 64 + 16 * d0 + 8 * hi);
    float wv[2][4][4];
#pragma unroll
    for (int rt = 0; rt < 2; ++rt)
#pragma unroll
        for (int g = 0; g < 4; ++g) { const u32x2 w = *(const GAS u32x2*)(P + (size_t)(t0 + 4 * rt + g) * NE + EC_WI + 4 * hi);
            wv[rt][g][0] = bflo(w.x); wv[rt][g][1] = bfhi(w.x); wv[rt][g][2] = bflo(w.y); wv[rt][g][3] = bfhi(w.y); }
    float mn[4], mx[4];
#pragma unroll
    for (int g = 0; g < 4; ++g) { mn[g] = INFINITY; mx[g] = -INFINITY; }
    const int nkt = (t0 + 8 + 31) >> 5;
    bf16x8 kn[4];
    { const int key0 = 32 * (wid < nkt ? wid : 0) + r32;
#pragma unroll
      for (int d0 = 0; d0 < 4; ++d0) kn[d0] = *(const GAS bf16x8*)(P + (size_t)key0 * NE + EC_KI + 16 * d0 + 8 * hi); }
    for (int kt = wid; kt < nkt; kt += NWAVES) {
        const int key = 32 * kt + r32;
        bf16x8 kb[4];
#pragma unroll
        for (int d0 = 0; d0 < 4; ++d0) kb[d0] = kn[d0];
        { const int keyn = 32 * (kt + NWAVES < nkt ? kt + NWAVES : kt) + r32;
#pragma unroll
          for (int d0 = 0; d0 < 4; ++d0) kn[d0] = *(const GAS bf16x8*)(P + (size_t)keyn * NE + EC_KI + 16 * d0 + 8 * hi); }
        f32x16 acc[2];
#pragma unroll
        for (int rt = 0; rt < 2; ++rt) { acc[rt] = (f32x16){};
#pragma unroll
            for (int d0 = 0; d0 < 4; ++d0) acc[rt] = __builtin_amdgcn_mfma_f32_32x32x16_bf16(qa[rt][d0], kb[d0], acc[rt], 0, 0, 0); }
#pragma unroll
        for (int g = 0; g < 4; ++g) {
            float s0 = 0.f, s1 = 0.f;
#pragma unroll
            for (int j = 0; j < 4; ++j) { s0 += wv[0][g][j] * fmaxf(acc[0][4 * g + j], 0.f); s1 += wv[1][g][j] * fmaxf(acc[1][4 * g + j], 0.f); }
            s0 += __shfl_xor(s0, 32); s1 += __shfl_xor(s1, 32);
            const float v = (hi ? s1 : s0) + 0.f;
            const int tok = 4 * hi + g;
            scores[tok * 4096 + key] = v;
            if (key <= t0 + tok) { mn[g] = fminf(mn[g], v); mx[g] = fmaxf(mx[g], v); }
        }
    }
#pragma unroll
    for (int g = 0; g < 4; ++g) {
#pragma unroll
        for (int o = 1; o < 32; o <<= 1) { mn[g] = fminf(mn[g], __shfl_xor(mn[g], o)); mx[g] = fmaxf(mx[g], __shfl_xor(mx[g], o)); }
    }
    __syncthreads();
    if (r32 == 0) {
#pragma unroll
        for (int g = 0; g < 4; ++g) { if (mx[g] >= mn[g]) { __hip_atomic_fetch_max(&minmax[(4 * hi + g) * 2], f2sort(mx[g]), __ATOMIC_RELAXED, __HIP_MEMORY_SCOPE_WORKGROUP);
                __hip_atomic_fetch_min(&minmax[(4 * hi + g) * 2 + 1], f2sort(mn[g]), __ATOMIC_RELAXED, __HIP_MEMORY_SCOPE_WORKGROUP); } }
    }
    __syncthreads();
    {
        const int t = t0 + wid, n = t + 1;
        unsigned short* selg = (unsigned short*)(F.ws + WS_SEL) + (size_t)(b * SEQ + t) * 256;
        if (n <= 256) {
#pragma unroll
            for (int q = 0; q < 4; ++q) { const int i = lane + 64 * q; selg[i] = (unsigned short)((i < n) ? i : 0xffff); }
        } else {
            const LAS float* sr = scores + wid * 4096;
            LAS unsigned* hist = (LAS unsigned*)(F.lds + XTRA_OFF + 3072 * wid);
            LAS unsigned* cand = hist + 512;
            LAS unsigned short* outl = (LAS unsigned short*)(hist + 640);
            float hif = sort2f(minmax[wid * 2]), lof = sort2f(minmax[wid * 2 + 1]);
            float scale = (hif > lof) ? 1024.f / (hif - lof) : 0.f;
            unsigned above_out = 0;
            int bstar = 0; unsigned cstar = 0, above = 0;
            for (int lvl = 0; lvl < 4; ++lvl) {
#pragma unroll
                for (int q = 0; q < 8; ++q) hist[lane + 64 * q] = 0u;
                LDS_FENCE();
                for (int i0 = 0; i0 < n; i0 += 64) { const int i = i0 + lane;
                    if (i < n) { const float x = sr[i]; if (x >= lof && x <= hif) { int bb = (int)((x - lof) * scale); bb = bb > 1023 ? 1023 : bb;
                        __hip_atomic_fetch_add(&hist[bb >> 1], (bb & 1) ? 65536u : 1u, __ATOMIC_RELAXED, __HIP_MEMORY_SCOPE_WORKGROUP); } } }
                LDS_FENCE();
                const unsigned target = 256u - above_out;
                unsigned hw[8]; unsigned tot = 0;
#pragma unroll
                for (int q = 0; q < 8; ++q) { hw[q] = hist[8 * lane + q]; tot += (hw[q] & 0xffffu) + (hw[q] >> 16); }
                unsigned suf = tot;
#pragma unroll
                for (int o = 1; o < 64; o <<= 1) { const unsigned v = __shfl_down(suf, o); if (lane + o < 64) suf += v; }
                const unsigned long long pm = __ballot(suf >= target);
                const int Ls = 63 - __builtin_clzll(pm | 1ull);
                above = __shfl(suf - tot, Ls);
                bstar = 16 * Ls; cstar = 0; bool found = false;
#pragma unroll
                for (int q = 7; q >= 0; --q) { const unsigned w = __shfl(hw[q], Ls);
                    { const unsigned c = w >> 16; if (!found) { if (above + c >= target) { found = true; bstar = 16 * Ls + 2 * q + 1; cstar = c; } else above += c; } }
                    { const unsigned c = w & 0xffffu; if (!found) { if (above + c >= target) { found = true; bstar = 16 * Ls + 2 * q; cstar = c; } else above += c; } } }
                if (cstar <= 64u || hif <= lof || lvl == 3) break;
                float mn2 = INFINITY, mx2 = -INFINITY;
                for (int i0 = 0; i0 < n; i0 += 64) { const int i = i0 + lane;
                    if (i < n) { const float x = sr[i]; if (x >= lof && x <= hif) { int bb = (int)((x - lof) * scale); bb = bb > 1023 ? 1023 : bb; if (bb == bstar) { mn2 = fminf(mn2, x); mx2 = fmaxf(mx2, x); } } } }
#pragma unroll
                for (int o = 1; o < 64; o <<= 1) { mn2 = fminf(mn2, __shfl_xor(mn2, o)); mx2 = fmaxf(mx2, __shfl_xor(mx2, o)); }
                above_out += above; lof = mn2; hif = mx2; scale = (hif > lof) ? 1024.f / (hif - lof) : 0.f;
            }
            const unsigned need = 256u - above_out - above;
            unsigned pos = 0;
            if (cstar <= 64u) {
                unsigned ncand = 0;
                for (int i0 = 0; i0 < n; i0 += 64) { const int i = i0 + lane; const bool valid = i < n; const float x = valid ? sr[i] : 0.f;
                    int bb = (int)((x - lof) * scale); bb = bb > 1023 ? 1023 : bb; const bool inr = valid && x >= lof && x <= hif;
                    const bool ab = (valid && x > hif) || (inr && bb > bstar); const unsigned long long ma = __ballot(ab);
                    if (ab) { const unsigned sl = pos + mbcnt64(ma); if (sl < 256u) outl[sl] = (unsigned short)i; }
                    pos += (unsigned)__builtin_popcountll(ma);
                    const bool ic = inr && bb == bstar; const unsigned long long mc = __ballot(ic);
                    if (ic) { const unsigned sl = ncand + mbcnt64(mc); if (sl < 64u) { cand[sl] = f2sort(x); cand[64 + sl] = (unsigned)i; } }
                    ncand += (unsigned)__builtin_popcountll(mc); }
                LDS_FENCE();
                const bool v = (unsigned)lane < ncand; const unsigned key = v ? cand[lane] : 0u; const unsigned cidx = cand[64 + lane];
                unsigned prefix = 0u;
                for (int bit = 31; bit >= 0; --bit) { const unsigned trial = prefix | (1u << bit);
                    const unsigned cnt = (unsigned)__builtin_popcountll(__ballot(v && key >= trial)); if (cnt >= need) prefix = trial; }
                const bool gt = v && key > prefix; const unsigned ngt = (unsigned)__builtin_popcountll(__ballot(gt));
                const bool eq = v && key == prefix; const unsigned long long meq = __ballot(eq);
                const bool sc = gt || (eq && mbcnt64(meq) < need - ngt);
                const unsigned long long ms = __ballot(sc);
                if (sc) { const unsigned sl = pos + mbcnt64(ms); if (sl < 256u) outl[sl] = (unsigned short)cidx; }
                pos += (unsigned)__builtin_popcountll(ms);
            } else if (hif <= lof) {
                unsigned eqseen = 0;
                for (int i0 = 0; i0 < n; i0 += 64) { const int i = i0 + lane; const bool valid = i < n; const float x = valid ? sr[i] : 0.f;
                    const bool gt = valid && x > hif, eq = valid && x == hif; const unsigned long long meq = __ballot(eq);
                    const bool sc = gt || (eq && eqseen + mbcnt64(meq) < need); const unsigned long long ms = __ballot(sc);
                    if (sc) { const unsigned sl = pos + mbcnt64(ms); if (sl < 256u) outl[sl] = (unsigned short)i; }
                    pos += (unsigned)__builtin_popcountll(ms); eqseen += (unsigned)__builtin_popcountll(meq); }
            } else {
                unsigned prefix = 0u;
                for (int bit = 31; bit >= 0; --bit) { const unsigned trial = prefix | (1u << bit); unsigned cnt = 0;
                    for (int i0 = 0; i0 < n; i0 += 64) { const int i = i0 + lane; cnt += (unsigned)__builtin_popcountll(__ballot(i < n && f2sort(sr[i < n ? i : 0]) >= trial)); }
                    if (cnt >= 256u) prefix = trial; }
                unsigned ngt = 0;
                for (int i0 = 0; i0 < n; i0 += 64) { const int i = i0 + lane; ngt += (unsigned)__builtin_popcountll(__ballot(i < n && f2sort(sr[i < n ? i : 0]) > prefix)); }
                const unsigned need_eq = 256u - ngt; unsigned eqseen = 0;
                for (int i0 = 0; i0 < n; i0 += 64) { const int i = i0 + lane; const bool valid = i < n; const unsigned k = f2sort(sr[valid ? i : 0]);
                    const bool gt = valid && k > prefix, eq = valid && k == prefix; const unsigned long long meq = __ballot(eq);
                    const bool sc = gt || (eq && eqseen + mbcnt64(meq) < need_eq); const unsigned long long ms = __ballot(sc);
                    if (sc) { const unsigned sl = pos + mbcnt64(ms); if (sl < 256u) outl[sl] = (unsigned short)i; }
                    pos += (unsigned)__builtin_popcountll(ms); eqseen += (unsigned)__builtin_popcountll(meq); }
            }
            LDS_FENCE();
            *(GAS unsigned long long*)(selg + 4 * lane) = *(const LAS unsigned long long*)(outl + 4 * lane);
        }
    }
    __syncthreads();
}
__device__ __forceinline__ void topk_phase(Frame& F) { PHASE_BEGIN(F);
    for (int idx = F.vcu; idx < 2048; idx += F.G) { const int r = idx >> 8, g = idx & 255; const int u = (r & 1) ? (r + 1) * 256 - 1 - g : r * 256 + g;
        topk_unit(F, u >> 9, (u & 511) * 8); }
}
__device__ __forceinline__ void ckv_norm_phase(Frame& F, int e) { PHASE_BEGIN(F);
    const int gw = F.vcu * NWAVES + F.wave, NGW = F.G * NWAVES;
    const bf16* P = (const bf16*)(F.ws + WS_P); bf16* CK = (bf16*)(F.ws + WS_CKV);
    const f32x4 g = *((const GAS f32x4*)(F.inp(I_KVN) + (size_t)e * 256) + F.lane);
    for (int m = gw; m < T; m += NGW) { const u32x2 w = *((const GAS u32x2*)(P + (size_t)m * NE + EC_CKV) + F.lane);
        const float a = bflo(w.x), b = bfhi(w.x), c = bflo(w.y), d = bfhi(w.y);
        const float rstd = 1.f / sqrtf(wave_sum((a * a + b * b) + (c * c + d * d)) * (1.f / 256.f) + RMS_EPS);
        u32x2 o; o.x = pk2(a * rstd * g.x, b * rstd * g.y); o.y = pk2(c * rstd * g.z, d * rstd * g.w);
        *((GAS u32x2*)(CK + (size_t)m * 256) + F.lane) = o; }
}
namespace fa {
__device__ __forceinline__ int crow(int r, int hi) { return (r & 3) + 8 * (r >> 2) + 4 * hi; }
__device__ __forceinline__ void glds16(const void* gsrc, unsigned lds_dst) { unsigned keep;
    asm volatile("s_mov_b32 %0, m0\n\ts_mov_b32 m0, %2\n\ts_nop 0\n\tglobal_load_lds_dwordx4 %1, off\n\ts_mov_b32 m0, %0" : "=&s"(keep) : "v"(gsrc), "s"(lds_dst) : "memory"); }
typedef __bf16 bf16x2_t __attribute__((ext_vector_type(2))); typedef float f32x2_t __attribute__((ext_vector_type(2)));
__device__ __forceinline__ unsigned cvtpk(float lo, float hi) { f32x2_t v = {lo, hi}; bf16x2_t b = __builtin_convertvector(v, bf16x2_t); return __builtin_bit_cast(unsigned, b); }
typedef short v4i16_t __attribute__((ext_vector_type(4)));
__device__ __forceinline__ s16x4 vtr(const LAS char* p) { return __builtin_bit_cast(s16x4, __builtin_amdgcn_ds_read_tr16_b64_v4i16((LAS v4i16_t*)p)); }
constexpr int KSLOT = 8192, THR = 8;
constexpr int L_V = 16384, L_WS = 49152, L_KB = 51200, L_PKN = 67584, L_DN = 67840, FA_LDS = 67872;

template <int VD, int MODE>
__device__ __forceinline__ void unit(LAS char* lds, const bf16* Qh, const bf16* Kh, const bf16* Vh, int pitch, int q0, bf16* Oh, int opitch, int tid_in) {
    constexpr int NDB = VD / 32, VSLOT = VD * 128;
    const int tid = tid_in, lane = tid & 63, r32 = lane & 31, hi = lane >> 5; const int wid = __builtin_amdgcn_readfirstlane(tid >> 6);
    const unsigned lds0 = (unsigned)(uintptr_t)lds;
    LAS float* wsf = (LAS float*)(lds + L_WS) + wid * 64;
    const LAS float* kbl = (const LAS float*)(lds + L_KB);
    const int NT = (q0 + 256) / 64;
    const int qw0 = q0 + 32 * wid, NTw = (qw0 + 31) / 64 + 1;
    const bf16* ksrc = Kh + (size_t)lane * pitch + wid * 8;
#define FA_DMA(t, s) do { fa::glds16(ksrc + (size_t)(t) * 64 * pitch, (unsigned)__builtin_amdgcn_readfirstlane(lds0 + (s) * fa::KSLOT + wid * 1024)); \
    _Pragma("unroll") for (int i_ = 0; i_ < NDB / 2; ++i_) { const int ci_ = i_ * 8 + wid; \
        fa::glds16(Vh + (size_t)((t) * 64 + 16 * (ci_ & 3) + (lane >> 2)) * pitch + (ci_ >> 2) * 32 + (lane & 3) * 8, (unsigned)__builtin_amdgcn_readfirstlane(lds0 + fa::L_V + (s) * VSLOT + ci_ * 1024)); } } while (0)
    constexpr bool DESC = (MODE == 1);
    LAS unsigned* doneflags = (LAS unsigned*)(lds + L_DN); const LAS float* pkn = (const LAS float*)(lds + L_PKN);
    if (lane == 0) doneflags[wid] = 0u;
    FA_DMA(DESC ? NT - 1 : 0, 0);
    bf16x8 qr[4];
#pragma unroll
    for (int d0 = 0; d0 < 4; ++d0) qr[d0] = *(const GAS bf16x8*)(Qh + (size_t)(qw0 + r32) * pitch + d0 * 16 + hi * 8);
    float qn = 0.f;
    if (MODE == 1) {
#pragma unroll
        for (int d0 = 0; d0 < 4; ++d0)
#pragma unroll
            for (int e = 0; e < 8; ++e) { const float v = bf2f((unsigned short)qr[d0][e]); qn += v * v; }
        qn += __shfl_xor(qn, 32); qn = sqrtf(qn) * 1.002f; }
    f32x16 o[NDB];
#pragma unroll
    for (int d = 0; d < NDB; ++d) o[d] = (f32x16){};
    float mhat = 0.f, l_reg = 0.f;
    asm volatile("s_waitcnt lgkmcnt(0)\n\ts_barrier" ::: "memory");
    const float farb = (MODE == 0) ? kbl[128] : 0.f;
    bool started = false, wdone = false;
    for (int it = 0; it < NT; ++it) {
        asm volatile("s_waitcnt vmcnt(0) lgkmcnt(0)\n\ts_barrier" ::: "memory");
        if (DESC) { const u32x4 f0 = *(const LAS u32x4*)doneflags, f1 = *(const LAS u32x4*)(doneflags + 4);
            if ((f0.x & f0.y & f0.z & f0.w & f1.x & f1.y & f1.z & f1.w) != 0u) break; }
        const int j = DESC ? NT - 1 - it : it;
        if (it + 1 < NT) FA_DMA(DESC ? j - 1 : j + 1, (it + 1) & 1);
        if (j < NTw && !wdone) {
            const int k0 = 64 * j;
            const LAS char* Ks = lds + (it & 1) * KSLOT + hi * 1024 + r32 * 16;
            f32x16 p0, p1;
            if (MODE == 1) {
#pragma unroll
                for (int g = 0; g < 4; ++g) { const f32x4 a = *(const LAS f32x4*)(kbl + k0 + 8 * g + 4 * hi), c = *(const LAS f32x4*)(kbl + k0 + 32 + 8 * g + 4 * hi);
                    p0[4 * g] = a.x - mhat; p0[4 * g + 1] = a.y - mhat; p0[4 * g + 2] = a.z - mhat; p0[4 * g + 3] = a.w - mhat;
                    p1[4 * g] = c.x - mhat; p1[4 * g + 1] = c.y - mhat; p1[4 * g + 2] = c.z - mhat; p1[4 * g + 3] = c.w - mhat; }
            } else { const float c = farb - mhat;
#pragma unroll
                for (int r = 0; r < 16; ++r) { p0[r] = c; p1[r] = c; } }
#pragma unroll
            for (int d0 = 0; d0 < 4; ++d0) { const bf16x8 b0 = *(const LAS bf16x8*)(Ks + d0 * 2048), b1 = *(const LAS bf16x8*)(Ks + d0 * 2048 + 512);
                p0 = __builtin_amdgcn_mfma_f32_32x32x16_bf16(b0, qr[d0], p0, 0, 0, 0); p1 = __builtin_amdgcn_mfma_f32_32x32x16_bf16(b1, qr[d0], p1, 0, 0, 0); }
            const int q = qw0 + r32;
            if (MODE == 0 && (k0 + 63 + 128 > qw0)) {
#pragma unroll
                for (int r = 0; r < 16; ++r) { int d0_ = q - (k0 + crow(r, hi)), d1_ = d0_ - 32; d0_ = d0_ < 0 ? 0 : (d0_ > 128 ? 128 : d0_); d1_ = d1_ < 0 ? 0 : (d1_ > 128 ? 128 : d1_);
                    p0[r] += kbl[d0_] - farb; p1[r] += kbl[d1_] - farb; } }
            if (k0 + 63 > qw0) {
#pragma unroll
                for (int r = 0; r < 16; ++r) { const int kv = k0 + crow(r, hi); if (kv > q) p0[r] = -INFINITY; if (kv + 32 > q) p1[r] = -INFINITY; } }
            float rm = fmaxf(p0[0], p1[0]);
#pragma unroll
            for (int r = 1; r < 16; ++r) rm = fmaxf(rm, fmaxf(p0[r], p1[r]));
            rm = fmaxf(rm, __shfl_xor(rm, 32));
            const bool first = !started; started = true;
            if (first || __any(rm > (float)THR)) {
                const float dl = first ? rm : fmaxf(rm, 0.f);
                mhat += dl;
#pragma unroll
                for (int r = 0; r < 16; ++r) { p0[r] -= dl; p1[r] -= dl; }
                if (!first) { const float f = __builtin_amdgcn_exp2f(-dl); l_reg *= f; if (hi == 0) wsf[r32] = f; LDS_FENCE();
#pragma unroll
                    for (int r = 0; r < 16; ++r) { const float ff = wsf[crow(r, hi)];
#pragma unroll
                        for (int d = 0; d < NDB; ++d) o[d][r] *= ff; }
                    LDS_FENCE(); }
            }
            float sacc = 0.f;
#pragma unroll
            for (int r = 0; r < 16; ++r) { p0[r] = __builtin_amdgcn_exp2f(p0[r]); p1[r] = __builtin_amdgcn_exp2f(p1[r]); sacc += p0[r] + p1[r]; }
            l_reg += sacc;
            u32x4 pw[4];
#pragma unroll
            for (int i = 0; i < 4; ++i) { pw[0][i] = cvtpk(p0[2 * i], p0[2 * i + 1]); pw[1][i] = cvtpk(p0[8 + 2 * i], p0[8 + 2 * i + 1]); pw[2][i] = cvtpk(p1[2 * i], p1[2 * i + 1]); pw[3][i] = cvtpk(p1[8 + 2 * i], p1[8 + 2 * i + 1]); }
            const LAS char* vp = lds + L_V + (it & 1) * VSLOT + ((lane >> 4) & 1) * 32 + (lane & 3) * 8 + (4 * hi + ((lane & 15) >> 2)) * 64;
#pragma unroll
            for (int d = 0; d < NDB; ++d) {
#pragma unroll
                for (int ks = 0; ks < 4; ++ks) { const s16x4 lo = vtr(vp + d * 4096 + ks * 1024), hh = vtr(vp + d * 4096 + ks * 1024 + 512);
                    const bf16x8 vf = (bf16x8){lo[0], lo[1], lo[2], lo[3], hh[0], hh[1], hh[2], hh[3]};
                    o[d] = __builtin_amdgcn_mfma_f32_32x32x16_bf16(__builtin_bit_cast(bf16x8, pw[ks]), vf, o[d], 0, 0, 0); } }
            if (DESC) {
                if (j == 0) wdone = true;
                else { const float bnd = qn * pkn[j - 1] + kbl[64 * j - 1] - mhat; wdone = __all(bnd < -52.f); }
                if (wdone && lane == 0) doneflags[wid] = 1u; }
        }
    }
#undef FA_DMA
    l_reg += __shfl_xor(l_reg, 32);
    if (hi == 0) wsf[32 + r32] = l_reg;
    LDS_FENCE();
#pragma unroll
    for (int r = 0; r < 16; ++r) { const float rl = 1.f / wsf[32 + crow(r, hi)]; bf16* orow = Oh + (size_t)(qw0 + crow(r, hi)) * opitch + r32;
#pragma unroll
        for (int d = 0; d < NDB; ++d) orow[32 * d] = (bf16)f2bf(o[d][r] * rl); }
    asm volatile("s_waitcnt vmcnt(0) lgkmcnt(0)\n\ts_barrier" ::: "memory");
}
}
__device__ __forceinline__ void fox_phase(Frame& F) { PHASE_BEGIN(F);
    LAS char* lds = (LAS char*)F.lds;
    const bf16* P = (const bf16*)(F.ws + WS_P); bf16* AO = (bf16*)(F.ws + WS_AO);
    const float* FC = (const float*)(F.ws + WS_FCUM);
    for (int idx = F.vcu; idx < 512; idx += F.G) {
        const int bh = idx >> 3, s = idx & 7, b = bh >> 4, h = bh & 15;
        for (int half = 0; half < 2; ++half) { const int qb = half ? 15 - s : s;
            LAS float* kbl = (LAS float*)(lds + fa::L_KB);
            for (int i = F.tid; i < (qb + 1) * 256; i += NTHR) kbl[i] = FC[((size_t)b * 16 + h) * SEQ + i];
            if (F.tid < 64) { float v = ((const float*)(F.ws + WS_KN))[((size_t)b * 16 + h) * 64 + F.tid];
#pragma unroll
                for (int of = 1; of < 64; of <<= 1) { const float u = __shfl_up(v, of); if (F.tid >= of) v = fmaxf(v, u); }
                ((LAS float*)(lds + fa::L_PKN))[F.tid] = v * 1.002f; }
            const size_t rb = (size_t)b * SEQ;
            fa::unit<64, 1>(lds, P + rb * NO + OC_Q + h * 64, P + rb * NO + OC_K + h * 64, P + rb * NO + OC_V + h * 64, NO, qb * 256, AO + rb * DM + h * 64, DM, F.tid); }
    }
}
__device__ __forceinline__ void diff_phase(Frame& F) { PHASE_BEGIN(F);
    LAS char* lds = (LAS char*)F.lds;
    const bf16* P = (const bf16*)(F.ws + WS_P); bf16* DO = (bf16*)(F.ws + WS_H);
    for (int idx = F.vcu; idx < 256; idx += F.G) {
        const int bhm = idx >> 3, s = idx & 7, b = bhm >> 3, h = (bhm >> 1) & 3, mp = bhm & 1;
        for (int half = 0; half < 2; ++half) { const int qb = half ? 15 - s : s;
            LAS float* tab = (LAS float*)(lds + fa::L_KB);
            if (F.tid < 129) tab[F.tid] = F.inp(I_RELB)[t5_bucket(F.tid) * 12 + 8 + h] * LOG2E;
            const size_t rb = (size_t)b * SEQ;
            fa::unit<128, 0>(lds, P + rb * NE + EC_QB + h * 128 + mp * 64, P + rb * NE + EC_KB + h * 128 + mp * 64, P + rb * NE + EC_VB + h * 128, NE, qb * 256, DO + rb * DM + (h * 2 + mp) * 128, DM, F.tid); }
    }
}
__device__ __forceinline__ void fcum_phase(Frame& F, int o) { PHASE_BEGIN(F);
    const bf16* P = (const bf16*)(F.ws + WS_P); float* FC = (float*)(F.ws + WS_FCUM);
    LAS float* wtot = (LAS float*)F.lds;
    for (int it = F.vcu; it < NB * 16; it += F.G) { const int b = it >> 4, h = it & 15; const float bfg = F.inp(I_BF)[o * 16 + h];
        const bf16* src = P + ((size_t)b * SEQ + 8 * F.tid) * NO + OC_F + h;
        float ls[8]; float run = 0.f;
#pragma unroll
        for (int i = 0; i < 8; ++i) { const float x = bf2f(src[(size_t)i * NO]) + bfg; run += fminf(x, 0.f) - log1pf(__expf(-fabsf(x))); ls[i] = run; }
        float inc = run;
#pragma unroll
        for (int of = 1; of < 64; of <<= 1) { const float v = __shfl_up(inc, of); if (F.lane >= of) inc += v; }
        __syncthreads();
        if (F.lane == 63) wtot[F.wave] = inc;
        __syncthreads();
        float base = inc - run;
        for (int w = 0; w < NWAVES; ++w) if (w < F.wave) base += wtot[w];
        float* dst = FC + ((size_t)b * 16 + h) * SEQ + 8 * F.tid;
        f32x4 o0, o1; o0.x = -(base + ls[0]) * LOG2E; o0.y = -(base + ls[1]) * LOG2E; o0.z = -(base + ls[2]) * LOG2E; o0.w = -(base + ls[3]) * LOG2E;
        o1.x = -(base + ls[4]) * LOG2E; o1.y = -(base + ls[5]) * LOG2E; o1.z = -(base + ls[6]) * LOG2E; o1.w = -(base + ls[7]) * LOG2E;
        *(GAS f32x4*)dst = o0; *(GAS f32x4*)(dst + 4) = o1;
    }
    __syncthreads();
    { const int gw = F.vcu * NWAVES + F.wave, NGW = F.G * NWAVES; float* KN = (float*)(F.ws + WS_KN);
      for (int it = gw; it < NB * 16 * 64; it += NGW) { const int bh = it >> 6, tl = it & 63, b = bh >> 4, h = bh & 15;
          const bf16* kr = P + ((size_t)b * SEQ + 64 * tl + F.lane) * NO + OC_K + h * 64; float ss = 0.f;
#pragma unroll
          for (int c = 0; c < 8; ++c) { const v4u w = *(const GAS v4u*)(kr + 8 * c);
              ss += bflo(w.x) * bflo(w.x) + bfhi(w.x) * bfhi(w.x) + bflo(w.y) * bflo(w.y) + bfhi(w.y) * bfhi(w.y) + bflo(w.z) * bflo(w.z) + bfhi(w.z) * bfhi(w.z) + bflo(w.w) * bflo(w.w) + bfhi(w.w) * bfhi(w.w); }
#pragma unroll
          for (int of = 1; of < 64; of <<= 1) ss = fmaxf(ss, __shfl_xor(ss, of));
          if (F.lane == 0) KN[it] = sqrtf(ss); } }
}
typedef float f32x4v __attribute__((ext_vector_type(4)));
__device__ __forceinline__ void sparse_phase(Frame& F, int e) { PHASE_BEGIN(F);
    const int lane = F.lane, wid = F.wave, g = lane >> 4, hd = lane & 15, hi = lane >> 5;
    LAS char* lds = (LAS char*)F.lds;
    LAS float* tabA = (LAS float*)(lds + XTRA_OFF);
    LAS int* selw = (LAS int*)(lds + XTRA_OFF + 8192 + wid * 128);
    LAS char* buf = lds + wid * 16384;
    const unsigned buf0 = (unsigned)(uintptr_t)buf;
    for (int i = F.tid; i < 8 * 129; i += NTHR) { const int h = i / 129, d = i % 129; tabA[h * 132 + d] = F.inp(I_RELB)[t5_bucket(d) * 12 + h] * LOG2E; }
    __syncthreads();
    const bf16* P = (const bf16*)(F.ws + WS_P); const bf16* CK = (const bf16*)(F.ws + WS_CKV); bf16* AO = (bf16*)(F.ws + WS_AO);
    const unsigned short* SEL = (const unsigned short*)(F.ws + WS_SEL);
    const int gw = F.vcu * NWAVES + wid, NGW = F.G * NWAVES;
    {
        const float* lv = F.inp(I_LAM) + (size_t)e * 256;
        const float s1 = wave_sum(lv[lane] * lv[64 + lane]), s2 = wave_sum(lv[128 + lane] * lv[192 + lane]);
        const float lam_init = (e == 0) ? 0.2f : 0.47071303836235146f;
        const float lam = __expf(s1) - __expf(s2) + lam_init;
        const bf16* DO = (const bf16*)(F.ws + WS_H);
        const int h = lane >> 4, d0 = (lane & 15) * 8;
        float sg[8];
#pragma unroll
        for (int j = 0; j < 8; ++j) sg[j] = F.inp(I_SUBLN)[(size_t)e * 128 + d0 + j] * (1.f - lam_init);
        for (int t = gw; t < T; t += NGW) {
            const v4u a = *(const GAS v4u*)(DO + (size_t)t * DM + (h * 2) * 128 + d0), b = *(const GAS v4u*)(DO + (size_t)t * DM + (h * 2 + 1) * 128 + d0);
            float o[8];
            o[0] = bflo(a.x) - lam * bflo(b.x); o[1] = bfhi(a.x) - lam * bfhi(b.x); o[2] = bflo(a.y) - lam * bflo(b.y); o[3] = bfhi(a.y) - lam * bfhi(b.y);
            o[4] = bflo(a.z) - lam * bflo(b.z); o[5] = bfhi(a.z) - lam * bfhi(b.z); o[6] = bflo(a.w) - lam * bflo(b.w); o[7] = bfhi(a.w) - lam * bfhi(b.w);
            float ss = 0.f;
#pragma unroll
            for (int j = 0; j < 8; ++j) ss += o[j] * o[j];
            ss += __shfl_xor(ss, 1); ss += __shfl_xor(ss, 2); ss += __shfl_xor(ss, 4); ss += __shfl_xor(ss, 8);
            const float rstd = 1.f / sqrtf(ss * (1.f / 128.f) + RMS_EPS);
            v4u w; w.x = pk2(o[0] * rstd * sg[0], o[1] * rstd * sg[1]); w.y = pk2(o[2] * rstd * sg[2], o[3] * rstd * sg[3]); w.z = pk2(o[4] * rstd * sg[4], o[5] * rstd * sg[5]); w.w = pk2(o[6] * rstd * sg[6], o[7] * rstd * sg[7]);
            *(GAS v4u*)(AO + (size_t)t * KEO + 2048 + h * 128 + d0) = w;
        }
    }
    for (int t = gw; t < T; t += NGW) {
        const int b = t / SEQ, tl = t % SEQ;
        const int cnt = tl + 1 < 256 ? tl + 1 : 256, nch = (cnt + 31) >> 5;
        bf16x8 bq[8];
#pragma unroll
        for (int ks = 0; ks < 8; ++ks) { bq[ks] = (bf16x8){0, 0, 0, 0, 0, 0, 0, 0}; if (hd < 8) bq[ks] = *(const GAS bf16x8*)(P + (size_t)t * NE + EC_QLAT + hd * 256 + 32 * ks + 8 * g); }
        f32x4v oacc[16];
#pragma unroll
        for (int ct = 0; ct < 16; ++ct) oacc[ct] = (f32x4v){0.f, 0.f, 0.f, 0.f};
        float m = 0.f, l = 0.f;
        const float* tb = nullptr; (void)tb;
        for (int ch = 0; ch < nch; ++ch) {
            const int svu = (int)SEL[(size_t)t * 256 + 32 * ch + (lane & 31)];
            const int sv = (svu == 0xffff) ? -1 : svu;
            LDS_FENCE();
            if (lane < 32) selw[lane] = sv;
#pragma unroll
            for (int i = 0; i < 16; ++i) { const int ra = __builtin_amdgcn_readlane(sv, 2 * i), rb = __builtin_amdgcn_readlane(sv, 2 * i + 1);
                int r = hi ? rb : ra; r = r < 0 ? 0 : r; const int row = 2 * i + hi;
                fa::glds16(CK + ((size_t)b * SEQ + r) * 256 + 8 * ((lane & 31) ^ (row & 15)), (unsigned)__builtin_amdgcn_readfirstlane(buf0 + i * 1024)); }
            asm volatile("s_waitcnt vmcnt(0) lgkmcnt(0)" ::: "memory");
            f32x4v s[2];
#pragma unroll
            for (int rt = 0; rt < 2; ++rt) { s[rt] = (f32x4v){0.f, 0.f, 0.f, 0.f}; const int row = 16 * rt + hd; const LAS char* rp = buf + row * 512;
#pragma unroll
                for (int ks = 0; ks < 8; ++ks) { const bf16x8 a = *(const LAS bf16x8*)(rp + (((4 * ks + g) ^ (row & 15)) << 4));
                    s[rt] = __builtin_amdgcn_mfma_f32_16x16x32_bf16(a, bq[ks], s[rt], 0, 0, 0); } }
            float rm = -INFINITY;
#pragma unroll
            for (int rt = 0; rt < 2; ++rt) { const i32x4 kp = *(const LAS i32x4*)(selw + 16 * rt + 4 * g); const int kq[4] = {kp.x, kp.y, kp.z, kp.w};
#pragma unroll
                for (int r = 0; r < 4; ++r) { int d = tl - kq[r]; d = d > 128 ? 128 : (d < 0 ? 0 : d); float v = s[rt][r] + tabA[(hd & 7) * 132 + d]; v = kq[r] < 0 ? -INFINITY : v; s[rt][r] = v; rm = fmaxf(rm, v); } }
            rm = fmaxf(rm, __shfl_xor(rm, 16)); rm = fmaxf(rm, __shfl_xor(rm, 32));
            if (ch == 0) m = rm;
            else if (__any(rm - m > 8.f)) { const float mn = fmaxf(m, rm), f = __builtin_amdgcn_exp2f(m - mn); m = mn; l *= f;
#pragma unroll
                for (int ct = 0; ct < 16; ++ct) oacc[ct] = oacc[ct] * f; }
            float p[2][4]; float ps = 0.f;
#pragma unroll
            for (int rt = 0; rt < 2; ++rt)
#pragma unroll
                for (int r = 0; r < 4; ++r) { p[rt][r] = __builtin_amdgcn_exp2f(s[rt][r] - m); ps += p[rt][r]; }
            l += ps;
            u32x4 pbw; pbw.x = fa::cvtpk(p[0][0], p[0][1]); pbw.y = fa::cvtpk(p[0][2], p[0][3]); pbw.z = fa::cvtpk(p[1][0], p[1][1]); pbw.w = fa::cvtpk(p[1][2], p[1][3]);
            const bf16x8 pb = __builtin_bit_cast(bf16x8, pbw);
            const int q4 = hd >> 2, p4 = hd & 3; const int r0 = 4 * g + q4;
            const LAS char* v0 = buf + r0 * 512 + 8 * (p4 & 1); const LAS char* v1 = v0 + 16 * 512;
#pragma unroll
            for (int ct = 0; ct < 16; ++ct) { const int co = ((2 * ct + (p4 >> 1)) ^ (r0 & 15)) << 4;
                const s16x4 lo = fa::vtr(v0 + co), hh = fa::vtr(v1 + co);
                const bf16x8 a = (bf16x8){lo[0], lo[1], lo[2], lo[3], hh[0], hh[1], hh[2], hh[3]};
                oacc[ct] = __builtin_amdgcn_mfma_f32_16x16x32_bf16(a, pb, oacc[ct], 0, 0, 0); }
        }
        l += __shfl_xor(l, 16); l += __shfl_xor(l, 32);
#ifdef DBG_ZERO_SPARSE
        const float rl = 0.f;
#else
        const float rl = 1.f / l;
#endif
        if (hd < 8) { bf16* orow = AO + (size_t)t * KEO + hd * 256 + 4 * g;
#pragma unroll
            for (int ct = 0; ct < 16; ++ct) { u32x2 w; w.x = pk2(oacc[ct][0] * rl, oacc[ct][1] * rl); w.y = pk2(oacc[ct][2] * rl, oacc[ct][3] * rl); *(GAS u32x2*)(orow + 16 * ct) = w; } }
    }
    LDS_FENCE();
    __syncthreads();
}
template <int N> __device__ __forceinline__ void bitonic_desc(unsigned* v) {
#pragma unroll
    for (int k = 2; k <= N; k <<= 1)
#pragma unroll
        for (int j = k >> 1; j > 0; j >>= 1)
#pragma unroll
            for (int i = 0; i < N; ++i) { const int l = i ^ j; if (l > i) { const bool up = (i & k) != 0; const unsigned a = v[i], b = v[l]; const unsigned mx = a > b ? a : b, mn = a > b ? b : a; v[i] = up ? mn : mx; v[l] = up ? mx : mn; } }
}
__device__ __forceinline__ void merge16_desc(unsigned* a, const unsigned* b) {
#pragma unroll
    for (int i = 0; i < 16; ++i) { const unsigned x = a[i], y = b[15 - i]; a[i] = x > y ? x : y; }
#pragma unroll
    for (int j = 8; j > 0; j >>= 1)
#pragma unroll
        for (int i = 0; i < 16; ++i) { const int l = i ^ j; if (l > i) { const unsigned x = a[i], y = a[l]; a[i] = x > y ? x : y; a[l] = x > y ? y : x; } }
}
__device__ __forceinline__ void top16_of_64(unsigned* v) {
    bitonic_desc<16>(v); bitonic_desc<16>(v + 16); bitonic_desc<16>(v + 32); bitonic_desc<16>(v + 48);
    merge16_desc(v, v + 16); merge16_desc(v + 32, v + 48); merge16_desc(v, v + 32);
}
__device__ __forceinline__ void peer_route_phase(Frame& F, int layer) { PHASE_BEGIN(F);
    const int lane = F.lane, r32 = lane & 31, hi = lane >> 5;
    const bf16* PQ = (const bf16*)(F.ws + WS_P); const bf16* SK = (const bf16*)(F.ws + WS_WSK) + (size_t)layer * 2 * 128 * 128;
    int* PE = (int*)(F.ws + WS_PE); float* PG = (float*)(F.ws + WS_PG);
    const int gw = F.vcu * NWAVES + F.wave, NGW = F.G * NWAVES;
    LAS char* lds = (LAS char*)F.lds;
    for (int i = F.tid; i < 256 * 16; i += NTHR) { const int row = i >> 4, ch = i & 15; *(LAS v4u*)(lds + row * 272 + ch * 16) = *(const GAS v4u*)(SK + (size_t)row * 128 + ch * 8); }
    __syncthreads();
    for (int task = gw; task < T / 4; task += NGW) {
        const int t = 4 * task + (r32 >> 3), h = r32 & 7;
        unsigned top0[16], top1[16];
#pragma unroll
        for (int i = 0; i < 16; ++i) { top0[i] = 0u; top1[i] = 0u; }
#pragma unroll 1
        for (int p = 0; p < 2; ++p) {
            bf16x8 bq[8];
#pragma unroll
            for (int d0 = 0; d0 < 8; ++d0) bq[d0] = *(const GAS bf16x8*)(PQ + (size_t)t * 2048 + h * 256 + p * 128 + 16 * d0 + 8 * hi);
            unsigned v[64];
            const LAS char* ab = lds + (p * 128 + r32) * 272 + hi * 16;
#pragma unroll
            for (int kt = 0; kt < 4; ++kt) { f32x16 acc = (f32x16){};
#pragma unroll
                for (int d0 = 0; d0 < 8; ++d0) { const bf16x8 a = *(const LAS bf16x8*)(ab + kt * 32 * 272 + d0 * 32);
                    acc = __builtin_amdgcn_mfma_f32_32x32x16_bf16(a, bq[d0], acc, 0, 0, 0); }
#pragma unroll
                for (int r = 0; r < 16; ++r) { const int key = 32 * kt + (r & 3) + 8 * (r >> 2) + 4 * hi; v[16 * kt + r] = (f2sort(acc[r]) & ~127u) | (unsigned)(127 - key); } }
            top16_of_64(v);
            unsigned o[16];
#pragma unroll
            for (int i = 0; i < 16; ++i) o[i] = (unsigned)__shfl_xor((int)v[i], 32);
            merge16_desc(v, o);
#pragma unroll
            for (int i = 0; i < 16; ++i) { top0[i] = (p == 0) ? v[i] : top0[i]; top1[i] = (p == 1) ? v[i] : top1[i]; }
        }
        float s0[16], s1[16];
#pragma unroll
        for (int i = 0; i < 16; ++i) { s0[i] = sort2f(top0[i] & ~127u); s1[i] = sort2f(top1[i] & ~127u); }
        unsigned c[64]; int nc = 0;
#pragma unroll
        for (int a = 0; a < 16; ++a)
#pragma unroll
            for (int b = 0; b < 16; ++b) if ((a + 1) * (b + 1) <= 16) { c[nc] = (f2sort(s0[a] + s1[b]) & ~255u) | (unsigned)(255 - (a * 16 + b)); ++nc; }
#pragma unroll
        for (int i = nc; i < 64; ++i) c[i] = 0u;
        top16_of_64(c);
        float gsum = 0.f; float gt[16]; int ex[16];
        const float smax = sort2f(c[0] & ~255u);
#pragma unroll
        for (int j = 0; j < 16; ++j) { const float sj = sort2f(c[j] & ~255u); gt[j] = __expf(sj - smax); gsum += gt[j];
            const int id = 255 - (int)(c[j] & 255u), a = id >> 4, b = id & 15; unsigned ka = top0[0], kb = top1[0];
#pragma unroll
            for (int q = 1; q < 16; ++q) { ka = (a == q) ? top0[q] : ka; kb = (b == q) ? top1[q] : kb; }
            ex[j] = (127 - (int)(ka & 127u)) * 128 + (127 - (int)(kb & 127u)); }
        const float rg = 1.f / gsum;
        if (hi == 0) { int* d = PE + (size_t)t * 128 + h * 16;
#pragma unroll
            for (int q = 0; q < 4; ++q) *(GAS i32x4*)(d + 4 * q) = (i32x4){ex[4 * q], ex[4 * q + 1], ex[4 * q + 2], ex[4 * q + 3]}; }
        else { float* d = PG + (size_t)t * 128 + h * 16;
#pragma unroll
            for (int q = 0; q < 4; ++q) *(GAS f32x4*)(d + 4 * q) = (f32x4){gt[4 * q] * rg, gt[4 * q + 1] * rg, gt[4 * q + 2] * rg, gt[4 * q + 3] * rg}; }
    }
    __syncthreads();
}
__device__ __forceinline__ void dec16(const v4u w, float (&f)[16]) {
#pragma unroll
    for (int q = 0; q < 4; ++q) { const f32x2v a = __builtin_amdgcn_cvt_pk_f32_fp8((int)w[q], false), b = __builtin_amdgcn_cvt_pk_f32_fp8((int)w[q], true); f[4 * q] = a.x; f[4 * q + 1] = a.y; f[4 * q + 2] = b.x; f[4 * q + 3] = b.y; }
}
template <int NB> __device__ __forceinline__ void peer_u_batch(const LAS unsigned* list, int base, int total, const float (&xf)[16], const unsigned char* U8, const float* SU, const float* PGt, float* ACTt, int lane) {
    v4u w[NB];
    const int rem = total - base;
    const unsigned mine = list[base + (lane & (NB - 1))];
    const bool act = lane < NB && lane < rem; const int mye = (int)(mine & 0xffffu), myj = (int)(mine >> 16);
    float su = 0.f, pg = 0.f; if (act) { su = SU[mye]; pg = PGt[myj]; }
#pragma unroll
    for (int q = 0; q < NB; ++q) { w[q] = (v4u){0u, 0u, 0u, 0u};
        if (q < rem) { const unsigned ent = (unsigned)__builtin_amdgcn_readlane((int)mine, q); w[q] = *(const GAS v4u*)(U8 + (size_t)(ent & 0xffffu) * 1024 + 16 * lane); } }
    float d[NB];
#pragma unroll
    for (int q = 0; q < NB; ++q) { d[q] = 0.f; if (q < rem) { float f[16]; dec16(w[q], f); float s = 0.f;
#pragma unroll
        for (int i = 0; i < 16; ++i) s += xf[i] * f[i];
        d[q] = s; } }
#pragma unroll
    for (int lvl = 0, n = NB; n > 1; ++lvl, n >>= 1) { const int bit = 1 << lvl;
#pragma unroll
        for (int q = 0; q < n / 2; ++q) { const float keep = (lane & bit) ? d[2 * q + 1] : d[2 * q], send = (lane & bit) ? d[2 * q] : d[2 * q + 1]; d[q] = keep + __shfl_xor(send, bit); } }
    float e1 = d[0];
#pragma unroll
    for (int o = NB; o < 64; o <<= 1) e1 += __shfl_xor(e1, o);
    if (act) ACTt[myj] = gelu_tanh(e1 * su) * pg;
}
__device__ __forceinline__ void peer_u_phase(Frame& F, int layer) { PHASE_BEGIN(F);
    const int lane = F.lane; const int per = F.G >> 3; const int k = F.vcu / per, wp = (F.vcu % per) * NWAVES + F.wave, nwp = per * NWAVES;
    const bf16* H = (const bf16*)(F.ws + WS_H); const unsigned char* U8 = F.ws + WS_U8; const float* SU = (const float*)(F.ws + WS_SU);
    const int* PE = (const int*)(F.ws + WS_PE); const float* PG = (const float*)(F.ws + WS_PG); float* ACT = (float*)(F.ws + WS_ACT);
    LAS unsigned* list = (LAS unsigned*)(F.lds + F.wave * 1024);
    v4u xa = *(const GAS v4u*)(H + (size_t)wp * DM + 16 * lane), xc = *(const GAS v4u*)(H + (size_t)wp * DM + 16 * lane + 8);
    int ea = PE[(size_t)wp * 128 + lane], eb = PE[(size_t)wp * 128 + 64 + lane];
    for (int t = wp; t < T; t += nwp) {
        float xf[16];
        xf[0] = bflo(xa.x); xf[1] = bfhi(xa.x); xf[2] = bflo(xa.y); xf[3] = bfhi(xa.y); xf[4] = bflo(xa.z); xf[5] = bfhi(xa.z); xf[6] = bflo(xa.w); xf[7] = bfhi(xa.w);
        xf[8] = bflo(xc.x); xf[9] = bfhi(xc.x); xf[10] = bflo(xc.y); xf[11] = bfhi(xc.y); xf[12] = bflo(xc.z); xf[13] = bfhi(xc.z); xf[14] = bflo(xc.w); xf[15] = bfhi(xc.w);
        const bool ia = (ea >> 11) == k, ib = (eb >> 11) == k;
        const unsigned long long ma = __ballot(ia), mb = __ballot(ib);
        const int na = __builtin_popcountll(ma), total = na + __builtin_popcountll(mb);
        LDS_FENCE();
        if (ia) list[mbcnt64(ma)] = (unsigned)ea | ((unsigned)lane << 16);
        if (ib) list[na + mbcnt64(mb)] = (unsigned)eb | ((unsigned)(64 + lane) << 16);
        const int tn = (t + nwp < T) ? t + nwp : t;
        xa = *(const GAS v4u*)(H + (size_t)tn * DM + 16 * lane); xc = *(const GAS v4u*)(H + (size_t)tn * DM + 16 * lane + 8);
        ea = PE[(size_t)tn * 128 + lane]; eb = PE[(size_t)tn * 128 + 64 + lane];
        LDS_FENCE();
        for (int base = 0; base < total; ) {
            if (total - base > 8) { peer_u_batch<16>(list, base, total, xf, U8, SU, PG + (size_t)t * 128, ACT + (size_t)t * 128, lane); base += 16; }
            else { peer_u_batch<8>(list, base, total, xf, U8, SU, PG + (size_t)t * 128, ACT + (size_t)t * 128, lane); base += 8; }
        }
    }
    LDS_FENCE();
}
__device__ __forceinline__ void peer_v_phase(Frame& F, int layer) { PHASE_BEGIN(F);
    const int lane = F.lane; const int per = F.G >> 3; const int k = F.vcu / per, wp = (F.vcu % per) * NWAVES + F.wave, nwp = per * NWAVES;
    const unsigned char* V8 = F.ws + WS_V8 + (size_t)k * (16384 * 128) + (lane & 7) * 16; const float* SV = (const float*)(F.ws + WS_SV);
    const int* PE = (const int*)(F.ws + WS_PE); const float* ACT = (const float*)(F.ws + WS_ACT);
    float* X = (float*)(F.ws + WS_X); const float* mod = (const float*)(F.ws + WS_MOD);
    const int c16 = ((lane >> 3) & 1) * 8 + ((lane >> 4) & 1) * 4 + ((lane >> 5) & 1) * 2;
    const int col = 128 * k + 16 * (lane & 7) + c16;
    int ea = PE[(size_t)wp * 128 + lane], eb = PE[(size_t)wp * 128 + 64 + lane];
    float ca = ACT[(size_t)wp * 128 + lane], cb = ACT[(size_t)wp * 128 + 64 + lane];
    for (int t = wp; t < T; t += nwp) {
        int e[16]; float cf[16]; v4u w[16];
#pragma unroll
        for (int s = 0; s < 16; ++s) { const int sl = (8 * s + (lane >> 3)) & 63;
            e[s] = __shfl(s < 8 ? ea : eb, sl); cf[s] = __shfl(s < 8 ? ca : cb, sl);
            w[s] = *(const GAS v4u*)(V8 + (size_t)e[s] * 128); }
#pragma unroll
        for (int s = 0; s < 16; ++s) cf[s] *= SV[e[s]];
        __builtin_amdgcn_sched_barrier(0);
        const int tn = (t + nwp < T) ? t + nwp : t;
        ea = PE[(size_t)tn * 128 + lane]; eb = PE[(size_t)tn * 128 + 64 + lane]; ca = ACT[(size_t)tn * 128 + lane]; cb = ACT[(size_t)tn * 128 + 64 + lane];
        int ln2 = lane; asm volatile("" : "+v"(ln2));
        const int col2 = 128 * k + 16 * (ln2 & 7) + ((ln2 >> 3) & 1) * 8 + ((ln2 >> 4) & 1) * 4 + ((ln2 >> 5) & 1) * 2;
        const float* g2 = mod + ((size_t)layer * 4 + t / SEQ) * 6144 + 5 * DM + col2;
        GAS f32x2v* xp = (GAS f32x2v*)(X + (size_t)t * DM + col2); f32x2v xv = *xp; const float g2a = g2[0], g2b = g2[1];
        float acc[16];
#pragma unroll
        for (int i = 0; i < 16; ++i) acc[i] = 0.f;
#pragma unroll
        for (int s = 0; s < 16; ++s) { float f[16]; dec16(w[s], f);
#pragma unroll
            for (int i = 0; i < 16; ++i) acc[i] += cf[s] * f[i];
            if ((s & 1) == 1) __builtin_amdgcn_sched_barrier(0); }
        float r8[8], r4[4], r2[2];
#pragma unroll
        for (int i = 0; i < 8; ++i) { const float keep = (lane & 8) ? acc[8 + i] : acc[i], send = (lane & 8) ? acc[i] : acc[8 + i]; r8[i] = keep + __shfl_xor(send, 8); }
#pragma unroll
        for (int i = 0; i < 4; ++i) { const float keep = (lane & 16) ? r8[4 + i] : r8[i], send = (lane & 16) ? r8[i] : r8[4 + i]; r4[i] = keep + __shfl_xor(send, 16); }
#pragma unroll
        for (int i = 0; i < 2; ++i) { const float keep = (lane & 32) ? r4[2 + i] : r4[i], send = (lane & 32) ? r4[i] : r4[2 + i]; r2[i] = keep + __shfl_xor(send, 32); }
        xv.x += g2a * r2[0]; xv.y += g2b * r2[1]; *xp = xv;
    }
}
namespace pg8 {
struct EpiResid {
    static constexpr bool PERM = false, AFTER_DRAIN = false;
    const float* xin; float* xout; const float* gate; float mul;
    __device__ __forceinline__ void operator()(const f32x4 (&acc)[2][2][4][2], const Unit& u, int wr, int wc, int fr, int fq) const {
        const int col0 = u.pn * BM + wc * 32 + 4 * fq; const float* gb = gate + (size_t)((u.pm * BM) / 4096) * 6144 + col0;
        f32x4 gv[2][2];
#pragma unroll
        for (int bj = 0; bj < 2; ++bj)
#pragma unroll
            for (int n = 0; n < 2; ++n) gv[bj][n] = *(const f32x4*)(gb + bj * HALF + n * 16);
#pragma unroll
        for (int ai = 0; ai < 2; ++ai)
#pragma unroll
            for (int m = 0; m < 4; ++m) { const size_t off = (size_t)(u.pm * BM + ai * HALF + wr * 64 + m * 16 + fr) * 1024 + col0;
#pragma unroll
                for (int bj = 0; bj < 2; ++bj)
#pragma unroll
                    for (int n = 0; n < 2; ++n) { const f32x4 xv = *(const f32x4*)(xin + off + bj * HALF + n * 16); *(f32x4*)(xout + off + bj * HALF + n * 16) = xv + gv[bj][n] * acc[ai][bj][m][n] * mul; } }
    }
};
}

struct Args { const float* in[22]; float* out; unsigned char* ws; int stop_after; int pad; };
__global__ void __launch_bounds__(NTHR, 2) fwd_megakernel(Args args) {
    extern __shared__ __attribute__((aligned(16))) unsigned char lds[];
    Frame F;
    F.lds = (LAS unsigned char*)lds;
    F.MISC = (volatile LAS unsigned*)(F.lds + MISC_OFF);
    F.G = gridDim.x; { const int bx = blockIdx.x; F.vcu0 = (F.G % 8 == 0) ? (bx % 8) * (F.G / 8) + bx / 8 : bx; }
    F.ka0 = (const KAS char*)__builtin_amdgcn_kernarg_segment_ptr();
    F.wave0 = __builtin_amdgcn_readfirstlane((int)threadIdx.x >> 6);
    PHASE_BEGIN(F);
    for (int u = F.tid; u < (LDS_BYTES - MISC_OFF) / 4; u += NTHR) ((LAS unsigned*)(F.lds + MISC_OFF))[u] = 0u;
    __syncthreads();
    (void)xcd_barrier_post((unsigned*)(F.ctl + CW_BAR), F.MISC + 8);
    if (F.tid == 0) { const unsigned x_ = xb_xcc_id(); F.MISC[20] = x_; F.MISC[21] = atomicAdd((unsigned*)(F.ws + WS_CTL) + CW_RANK + 64 * x_, 1u); }
#define GRID_BAR() do { XcdBarrier b_; unsigned* p_ = (unsigned*)(F.ws + WS_CTL) + CW_BAR; asm volatile("" : "+s"(p_)); b_.bar = p_; b_.x = xb_xcc_id(); b_.st = F.MISC + 8; xcd_barrier(b_); } while (0)
#ifdef DBG_TIME_MASK
    unsigned long long tacc_ = 0, tst_ = 0;
#define TS_BEGIN(id) do { if ((DBG_TIME_MASK >> (id)) & 1) tst_ = __builtin_amdgcn_s_memrealtime(); } while (0)
#define TS_END(id) do { if ((DBG_TIME_MASK >> (id)) & 1) tacc_ += __builtin_amdgcn_s_memrealtime() - tst_; } while (0)
#else
#define TS_BEGIN(id) do {} while (0)
#define TS_END(id) do {} while (0)
#endif

    TS_BEGIN(1);
    p0_transposes(F);
    p0_fused_weights(F);
    p0_mod(F);
    conv_peer_tables(F, 0);
    GRID_BAR();
    if (F.tid == 0) { unsigned off_ = 0; const unsigned x_ = F.MISC[20];
        for (unsigned j = 0; j < 16; ++j) { const unsigned c_ = __hip_atomic_load((unsigned*)(F.ws + WS_CTL) + CW_RANK + 64 * j, __ATOMIC_RELAXED, __HIP_MEMORY_SCOPE_AGENT); if (j < x_) off_ += c_; }
        F.MISC[22] = off_ + F.MISC[21]; }
    __syncthreads();
    F.vcu0 = __builtin_amdgcn_readfirstlane((int)F.MISC[22]);
    norm_mod_phase(F, 0, 0, 0);
    GRID_BAR();
    TS_END(1);

    for (int layer = 0; layer < DEPTH; ++layer) {
        const int half = layer >> 1; const bool even = (layer & 1) == 0;
        PHASE_BEGIN(F);
        bf16* Hb = (bf16*)(F.ws + WS_H); bf16* Pb = (bf16*)(F.ws + WS_P);
        TS_BEGIN(2);
        if (even) { pg8::Gemm g{Hb, (const bf16*)(F.ws + WS_WEIN) + (size_t)half * NE * DM, T, NE, DM}; pg8::StaticOrder S; S.init(T, NE, F.G, (int)blockIdx.x);
            pg8::EpiBf16<0> E{Pb, NE, nullptr, 0, 0, 1.f}; pg8::gemm_phase<pg8::EpiBf16<0>, pg8::StaticOrder, true, true>(F.lds, g, S, E, F.tid); }
        else { pg8::Gemm g{Hb, (const bf16*)(F.ws + WS_WOIN) + (size_t)half * NO * DM, T, NO, DM}; pg8::StaticOrder S; S.init(T, NO, F.G, (int)blockIdx.x);
            pg8::EpiBf16<0> E{Pb, NO, nullptr, 0, 0, 1.f}; pg8::gemm_phase<pg8::EpiBf16<0>, pg8::StaticOrder, true, true>(F.lds, g, S, E, F.tid); }
        GRID_BAR();
        TS_END(2);
        if (even) {
            TS_BEGIN(3);
            TS_BEGIN(14);
            ckv_norm_phase(F, half);
            topk_phase(F);
            TS_END(14);
            TS_BEGIN(15);
            diff_phase(F);
            TS_END(15);
            TS_BEGIN(16);
#ifdef DBG_REP_DIFF
            diff_phase(F);
#endif
#ifdef DBG_REP_TOPK
            topk_phase(F);
#endif
            GRID_BAR();
            TS_END(16);
            TS_END(3);
            TS_BEGIN(4);
            sparse_phase(F, half);
#ifdef DBG_REP_SPARSE
            sparse_phase(F, half);
#endif
        } else {
            TS_BEGIN(5);
            fcum_phase(F, half);
            GRID_BAR();
            TS_END(5);
            TS_BEGIN(6);
            fox_phase(F);
#ifdef DBG_REP_FOX
            fox_phase(F);
#endif
        }
        GRID_BAR();
        if (even) TS_END(4); else TS_END(6);
        TS_BEGIN(7);
        { PHASE_BEGIN(F); bf16* AOb = (bf16*)(F.ws + WS_AO); float* Xb = (float*)(F.ws + WS_X); const float* mod = (const float*)(F.ws + WS_MOD);
          const float* xin = (layer == 0) ? F.inp(I_X) : Xb; const float* g1 = mod + (size_t)layer * 4 * 6144 + 2 * DM;
          pg8::EpiResid E{xin, Xb, g1, 1.f};
#ifdef DBG_SKIP_EVEN_MIX
          if (even) E.mul = 0.f;
#endif
#ifdef DBG_SKIP_ODD_MIX
          if (!even) E.mul = 0.f;
#endif
          if (even) { pg8::Gemm g{AOb, (const bf16*)(F.ws + WS_WEOUT) + (size_t)half * DM * KEO, T, DM, KEO}; pg8::StaticOrder S; S.init(T, DM, F.G, (int)blockIdx.x);
              pg8::gemm_phase<pg8::EpiResid, pg8::StaticOrder, false, true>(F.lds, g, S, E, F.tid); }
          else { pg8::Gemm g{AOb, (const bf16*)(F.ws + WS_WOOUT) + (size_t)half * DM * DM, T, DM, DM}; pg8::StaticOrder S; S.init(T, DM, F.G, (int)blockIdx.x);
              pg8::gemm_phase<pg8::EpiResid, pg8::StaticOrder, false, true>(F.lds, g, S, E, F.tid); } }
        GRID_BAR();
        TS_END(7);
        TS_BEGIN(8);
        norm_mod_phase(F, 1, layer, 1);
        if (layer > 0) conv_peer_tables(F, layer);
        GRID_BAR();
        TS_END(8);
        TS_BEGIN(9);
        { PHASE_BEGIN(F); bf16* Hb = (bf16*)(F.ws + WS_H); bf16* Pb = (bf16*)(F.ws + WS_P);
          pg8::Gemm g{Hb, (const bf16*)(F.ws + WS_WPQ) + (size_t)layer * 2048 * DM, T, 2048, DM}; pg8::StaticOrder S; S.init(T, 2048, F.G, (int)blockIdx.x);
          pg8::EpiBf16<0> E{Pb, 2048, nullptr, 0, 0, 1.f}; pg8::gemm_phase<pg8::EpiBf16<0>, pg8::StaticOrder, true, true>(F.lds, g, S, E, F.tid); }
        GRID_BAR();
        TS_END(9);
        TS_BEGIN(10);
        peer_route_phase(F, layer);
#ifdef DBG_REP_ROUTE
        peer_route_phase(F, layer);
#endif
        GRID_BAR();
        TS_END(10);
        TS_BEGIN(11);
        peer_u_phase(F, layer);
        GRID_BAR();
        TS_END(11);
        TS_BEGIN(12);
        peer_v_phase(F, layer);
        GRID_BAR();
        TS_END(12);
        TS_BEGIN(13);
        if (layer + 1 < DEPTH) { norm_mod_phase(F, 1, layer + 1, 0); GRID_BAR(); } else final_norm_phase(F);
        TS_END(13);
    }
#ifdef DBG_TIME_MASK
#ifndef DBG_VCU
#define DBG_VCU 0
#endif
#ifdef DBG_MAXMODE
    PHASE_BEGIN(F); if (F.tid == 0) atomicMax((unsigned*)(F.ws + WS_CTL) + 8192, (unsigned)tacc_); GRID_BAR(); { const unsigned mx_ = __hip_atomic_load((unsigned*)(F.ws + WS_CTL) + 8192, __ATOMIC_RELAXED, __HIP_MEMORY_SCOPE_AGENT);
#ifdef DBG_ARGMAX
      if (F.tid == 0 && (unsigned)tacc_ == mx_) __hip_atomic_store((unsigned*)(F.ws + WS_CTL) + 8256, (unsigned)F.vcu0, __ATOMIC_RELAXED, __HIP_MEMORY_SCOPE_AGENT);
      GRID_BAR(); tacc_ = 2500ull * __hip_atomic_load((unsigned*)(F.ws + WS_CTL) + 8256, __ATOMIC_RELAXED, __HIP_MEMORY_SCOPE_AGENT);
#else
      tacc_ = mx_;
#endif
    }
#endif
    if (F.vcu0 == DBG_VCU) { const unsigned long long t0_ = __builtin_amdgcn_s_memrealtime(); while (__builtin_amdgcn_s_memrealtime() - t0_ < 4ull * tacc_) __builtin_amdgcn_s_sleep(8); }
#endif
#undef GRID_BAR
}

extern "C" void kernel_launch(void* const* d_in, const int* in_sizes, int n_in, void* d_out, int out_size, void* d_ws, size_t ws_size, hipStream_t stream) {
    static int grid = 0;
    if (grid == 0) {
        if (n_in != 22 || in_sizes[0] != T * DM || out_size != T * DM || ws_size < WS_END) { fprintf(stderr, "kernel_launch: unexpected problem (n_in %d, in0 %d, out %d, ws %zu)\n", n_in, n_in > 0 ? in_sizes[0] : -1, out_size, ws_size); grid = -1; return; }
        int dev = 0, cus = 0, per_cu = 0;
        if (hipGetDevice(&dev) != hipSuccess || hipDeviceGetAttribute(&cus, hipDeviceAttributeMultiprocessorCount, dev) != hipSuccess) { grid = -1; return; }
        if (hipFuncSetAttribute((const void*)fwd_megakernel, hipFuncAttributeMaxDynamicSharedMemorySize, LDS_BYTES) != hipSuccess) { fprintf(stderr, "kernel_launch: hipFuncSetAttribute failed\n"); grid = -1; return; }
        if (hipOccupancyMaxActiveBlocksPerMultiprocessor(&per_cu, (const void*)fwd_megakernel, NTHR, LDS_BYTES) != hipSuccess || per_cu < 1) fprintf(stderr, "kernel_launch: occupancy query says %d\n", per_cu);
        (void)hipGetLastError();
        grid = cus;
    }
    if (grid < 0) return;
    if (hipMemsetAsync((char*)d_ws + WS_CTL, 0, CTL_ZERO_BYTES, stream) != hipSuccess) return;
    Args a{};
    for (int i = 0; i < 22; ++i) a.in[i] = (const float*)d_in[i];
    a.out = (float*)d_out; a.ws = (unsigned char*)d_ws; a.stop_after = 0; a.pad = 0;
    hipLaunchKernelGGL(fwd_megakernel, dim3(grid), dim3(NTHR), LDS_BYTES, stream, a);
}
```

```cpp
#include <hip/hip_runtime.h>
#include <hip/hip_bf16.h>
#include <cstdio>
#include <cstdint>
#include <cmath>
namespace pg8 {
#define PG8_LAS __attribute__((address_space(3)))
typedef unsigned short bf16_t;
typedef short bf16x8 __attribute__((ext_vector_type(8)));
typedef float f32x4 __attribute__((ext_vector_type(4)));
typedef unsigned u32x4 __attribute__((ext_vector_type(4)));
constexpr int BM = 256, BK = 64, HALF = 128, HTB = HALF * BK * 2  , STAGE_BYTES = 8 * HTB, NXCD = 8, WGM = 8;

__host__ __device__ __forceinline__ int lds_byte(int r, int c) { const int st = (r >> 4) * 2 + (c >> 5), rr = r & 15, cc = c & 31, ob = rr * 64 + cc * 2; return st * 1024 + (ob ^ (((ob >> 9) & 1) << 5)); }
__host__ __device__ __forceinline__ void stage_rc(int b, int& R, int& C) { const int st = b / 1024, sb = b % 1024, swz = sb ^ (((sb >> 9) & 1) << 5); R = (st >> 1) * 16 + swz / 64; C = (st & 1) * 32 + (swz % 64) / 2; }
__host__ __device__ __forceinline__ int perm32(int rho) { const int n = rho >> 4, i = rho & 15; return 8 * (i >> 2) + 4 * n + (i & 3); }

struct Unit { int pm, pn; };
struct Gemm { const bf16_t* A; const bf16_t* Bt; int M, N, K; int lda, koff_shift, koff_mul; };

struct StaticOrder {
    int nM, nN, nwg, G, c;
    __host__ __device__ void init(int M, int N, int G_, int c_) { nM = M / BM; nN = N / BM; nwg = nM * nN; G = G_; c = c_; }
    __host__ __device__ bool next(int i, Unit& u) const {
        const long L = (long)i * G + c; if (L >= nwg) return false;
        int wgid = (int)L; { const int q = nwg / NXCD, r = nwg % NXCD, xcd = wgid % NXCD, off = wgid / NXCD; wgid = (xcd < r ? xcd * (q + 1) : r * (q + 1) + (xcd - r) * q) + off; }
        const int nig = WGM * nN, gid = wgid / nig, fm = gid * WGM, gsz = (nM - fm) < WGM ? (nM - fm) : WGM;
        u.pm = fm + ((wgid % nig) % gsz); u.pn = (wgid % nig) / gsz; return true;
    }
    __device__ __forceinline__ void a_ready(const Unit&) const {}
    __device__ __forceinline__ void done(const Unit&) const {}
};

__device__ __forceinline__ unsigned cvt_pk_bf16(float lo, float hi) { unsigned r; asm volatile("v_cvt_pk_bf16_f32 %0, %1, %2" : "=v"(r) : "v"(lo), "v"(hi)); return r; }
typedef float f32x2 __attribute__((ext_vector_type(2)));
__device__ __forceinline__ f32x2 gelu_pk(f32x2 v) {
    const f32x2 av = __builtin_elementwise_abs(v), d = av * 0.2316418882f + 1.0f;
    f32x2 t; t.x = __builtin_amdgcn_rcpf(d.x); t.y = __builtin_amdgcn_rcpf(d.y);
    f32x2 q = t * 0.5307027145f + (-0.7265760135f); q = q * t + 0.7107068705f; q = q * t + (-0.142248368f); q = q * t + 0.127414796f; q = q * t;
    const f32x2 s = (v * v) * (-0.72134752044f);
    f32x2 e; e.x = __builtin_amdgcn_exp2f(s.x); e.y = __builtin_amdgcn_exp2f(s.y);
    const f32x2 m = v * (q * e), r = v - m;
    f32x2 o; o.x = v.x < 0.f ? m.x : r.x; o.y = v.y < 0.f ? m.y : r.y; return o;
}

template <int ACT  > struct EpiBf16 {
    static constexpr bool PERM = true, AFTER_DRAIN = false; static_assert(ACT == 0 || ACT == 1, "EpiBf16: ACT is 0 (none) or 1 (gelu_pk)");
    bf16_t* O; int ldc; const float* bias; int split_cols; size_t split_stride; float scale0;
    __device__ __forceinline__ void operator()(const f32x4 (&acc)[2][2][4][2], const Unit& u, int wr, int wc, int fr, int fq) const {
        const int row0 = u.pm * BM + wr * 64 + fr; int colt = u.pn * BM; bf16_t* base = O;
        float sc = 1.f; if (split_cols) { const int t = colt / split_cols; base += (size_t)t * split_stride; colt -= t * split_cols; if (t == 0) sc = scale0; }
        const int col0 = colt + wc * 32 + 8 * fq, bcol0 = u.pn * BM + wc * 32 + 8 * fq;
        f32x4 bv[2][2];
#pragma unroll
        for (int bj = 0; bj < 2; ++bj)
#pragma unroll
            for (int n = 0; n < 2; ++n) bv[bj][n] = bias ? *(const f32x4*)(bias + bcol0 + bj * HALF + 4 * n) : (f32x4){0.f, 0.f, 0.f, 0.f};
#pragma unroll
        for (int ai = 0; ai < 2; ++ai)
#pragma unroll
            for (int m = 0; m < 4; ++m) { bf16_t* rowp = base + (size_t)(row0 + ai * HALF + m * 16) * ldc + col0;
#pragma unroll
                for (int bj = 0; bj < 2; ++bj) { f32x4 v0 = acc[ai][bj][m][0] + bv[bj][0], v1 = acc[ai][bj][m][1] + bv[bj][1];
                    if (ACT == 1) { f32x2 a = gelu_pk((f32x2){v0[0], v0[1]}), b = gelu_pk((f32x2){v0[2], v0[3]}), c = gelu_pk((f32x2){v1[0], v1[1]}), d = gelu_pk((f32x2){v1[2], v1[3]});
                        v0 = (f32x4){a.x, a.y, b.x, b.y}; v1 = (f32x4){c.x, c.y, d.x, d.y}; }
                    v0 = v0 * sc; v1 = v1 * sc; u32x4 w; w.x = cvt_pk_bf16(v0[0], v0[1]); w.y = cvt_pk_bf16(v0[2], v0[3]); w.z = cvt_pk_bf16(v1[0], v1[1]); w.w = cvt_pk_bf16(v1[2], v1[3]);
                    *(u32x4*)(rowp + bj * HALF) = w; } }
    }
};
template <class Epi, class Sched, bool ALIGN_EPI = false, bool SP2 = false>
__device__ __forceinline__ void gemm_phase(PG8_LAS unsigned char* lds, const Gemm g, const Sched& S, const Epi& E, int tid_in) {
    const int tid = tid_in, wid = __builtin_amdgcn_readfirstlane(tid >> 6), lane = tid & 63, wr = wid >> 2, wc = wid & 3, fr = lane & 15, fq = lane >> 4;
    const int K = g.K, nt = K / BK;
    unsigned voffA[2], voffB[2];
#pragma unroll
    for (int i = 0; i < 2; ++i) { int R, C; stage_rc(tid * 16 + i * 8192, R, C); const int Rb = Epi::PERM ? ((R & ~31) + perm32(R & 31)) : R;
        voffA[i] = (unsigned)(R * g.lda + C) * 2u; voffB[i] = (unsigned)(Rb * K + C) * 2u; }
    const size_t kstep = (size_t)(BK * 2);
    const size_t hstepB = (size_t)HALF * K * 2, hstepA = (size_t)HALF * g.lda * 2;
    const size_t tstepB = 2 * hstepB, tstepA = 2 * hstepA;
#define PG8_ABASE(u) ((const char*)g.A + (size_t)(u).pm * tstepA + (size_t)(((u).pn >> g.koff_shift) * g.koff_mul) * 2)
    const unsigned ldsw = (unsigned)wid * 1024u;
    const int aoff = lds_byte(wr * 64 + fr, fq * 8), boff = lds_byte(wc * 32 + fr, fq * 8);
#define PG8_SA(b, h) (((b) * 2 + (h)) * HTB)
#define PG8_SB(b, h) ((4 + (b) * 2 + (h)) * HTB)
#define PG8_STAGE(bufoff, gbase, voff) do { _Pragma("unroll") for (int _i = 0; _i < 2; ++_i) \
        __builtin_amdgcn_global_load_lds((const unsigned*)((const char*)(gbase) + (voff)[_i]), (PG8_LAS unsigned*)(lds + (bufoff) + ldsw + _i * 8192), 16, 0, 0); } while (0)
#define PG8_LDA(dst, b, h) do { _Pragma("unroll") for (int m = 0; m < 4; ++m) _Pragma("unroll") for (int k = 0; k < 2; ++k) dst[m][k] = *(const PG8_LAS bf16x8*)(lds + PG8_SA(b, h) + aoff + m * 2048 + k * 1024); } while (0)
#define PG8_LDB(dst, b, h) do { _Pragma("unroll") for (int n = 0; n < 2; ++n) _Pragma("unroll") for (int k = 0; k < 2; ++k) dst[n][k] = *(const PG8_LAS bf16x8*)(lds + PG8_SB(b, h) + boff + n * 2048 + k * 1024); } while (0)
#define PG8_MMA(ai, bj, At, Bt) do { __builtin_amdgcn_s_setprio(1); _Pragma("unroll") for (int m = 0; m < 4; ++m) _Pragma("unroll") for (int n = 0; n < 2; ++n) _Pragma("unroll") for (int k = 0; k < 2; ++k) \
        acc[ai][bj][m][n] = __builtin_amdgcn_mfma_f32_16x16x32_bf16(Bt[n][k], At[m][k], acc[ai][bj][m][n], 0, 0, 0); __builtin_amdgcn_s_setprio(0); } while (0)
#define PG8_WAIT_V(n) asm volatile("s_waitcnt vmcnt(" #n ")" ::: "memory")
#define PG8_WAIT_L(n) asm volatile("s_waitcnt lgkmcnt(" #n ")" ::: "memory")
#define PG8_BAR __builtin_amdgcn_s_barrier()
#define PG8_SCHED __builtin_amdgcn_sched_barrier(0)
    Unit cur, nxt; int ui = 0;
    if (!S.next(0, cur)) return;
    f32x4 acc[2][2][4][2];
#pragma unroll
    for (int a = 0; a < 2; ++a)
#pragma unroll
        for (int b = 0; b < 2; ++b)
#pragma unroll
            for (int m = 0; m < 4; ++m)
#pragma unroll
                for (int n = 0; n < 2; ++n) acc[a][b][m][n] = (f32x4){0.f, 0.f, 0.f, 0.f};
    bf16x8 At[4][2], B0[2][2], B1[2][2];
    const char* cA = PG8_ABASE(cur); const char* cB = (const char*)g.Bt + (size_t)cur.pn * tstepB;
    S.a_ready(cur);
    if constexpr (SP2) {
        PG8_STAGE(PG8_SB(0, 0), cB, voffB); PG8_STAGE(PG8_SB(0, 1), cB + hstepB, voffB); PG8_STAGE(PG8_SA(0, 0), cA, voffA); PG8_STAGE(PG8_SA(0, 1), cA + hstepA, voffA);
        if (wr == 1) PG8_BAR;
        PG8_WAIT_V(2); PG8_BAR;
        PG8_STAGE(PG8_SB(1, 0), cB + kstep, voffB); PG8_STAGE(PG8_SA(1, 0), cA + kstep, voffA); PG8_STAGE(PG8_SB(1, 1), cB + hstepB + kstep, voffB);
        PG8_WAIT_V(6); PG8_BAR;
    } else {
        PG8_STAGE(PG8_SB(0, 0), cB, voffB); PG8_STAGE(PG8_SA(0, 0), cA, voffA); PG8_STAGE(PG8_SB(0, 1), cB + hstepB, voffB); PG8_STAGE(PG8_SA(0, 1), cA + hstepA, voffA);
        if (wr == 1) PG8_BAR;
        PG8_WAIT_V(4); PG8_BAR;
        PG8_STAGE(PG8_SB(1, 0), cB + kstep, voffB); PG8_STAGE(PG8_SA(1, 0), cA + kstep, voffA); PG8_STAGE(PG8_SB(1, 1), cB + hstepB + kstep, voffB);
        PG8_WAIT_V(6); PG8_BAR;
    }
    for (;;) {
        const bool has_next = S.next(ui + 1, nxt);
        const char* nA = has_next ? PG8_ABASE(nxt) : cA; const char* nB = has_next ? (const char*)g.Bt + (size_t)nxt.pn * tstepB : cB;
        for (int t = 0; t < nt; t += 2) {
            const bool last = (t == nt - 2);
            const char* a1 = cA + (size_t)(t + 1) * kstep;
            const char* a2 = last ? nA : cA + (size_t)(t + 2) * kstep; const char* b2 = last ? nB : cB + (size_t)(t + 2) * kstep;
            const char* a3 = a2 + kstep; const char* b3 = b2 + kstep;
            if (last && has_next) S.a_ready(nxt);
            if constexpr (SP2) {
            PG8_LDB(B0, 0, 0); PG8_LDB(B1, 0, 1); PG8_SCHED; PG8_LDA(At, 0, 0); PG8_STAGE(PG8_SA(1, 1), a1 + hstepA, voffA);
            PG8_WAIT_V(8); PG8_WAIT_L(0); PG8_BAR; PG8_MMA(0, 0, At, B0); PG8_MMA(0, 1, At, B1); PG8_BAR; PG8_SCHED;
            PG8_LDA(At, 0, 1); PG8_STAGE(PG8_SB(0, 0), b2, voffB); PG8_STAGE(PG8_SB(0, 1), b2 + hstepB, voffB); PG8_STAGE(PG8_SA(0, 0), a2, voffA);
            PG8_WAIT_V(8); PG8_WAIT_L(0); PG8_BAR; PG8_MMA(1, 0, At, B0); PG8_MMA(1, 1, At, B1); PG8_BAR; PG8_SCHED;
            PG8_LDB(B0, 1, 0); PG8_LDB(B1, 1, 1); PG8_SCHED; PG8_LDA(At, 1, 0); PG8_STAGE(PG8_SA(0, 1), a2 + hstepA, voffA);
            PG8_WAIT_V(8); PG8_WAIT_L(0); PG8_BAR; PG8_MMA(0, 0, At, B0); PG8_MMA(0, 1, At, B1); PG8_BAR; PG8_SCHED;
            PG8_LDA(At, 1, 1); PG8_STAGE(PG8_SB(1, 0), b3, voffB); PG8_STAGE(PG8_SB(1, 1), b3 + hstepB, voffB); PG8_STAGE(PG8_SA(1, 0), a3, voffA);
            PG8_WAIT_V(8); PG8_WAIT_L(0); PG8_BAR; PG8_MMA(1, 0, At, B0); PG8_MMA(1, 1, At, B1); PG8_BAR; PG8_SCHED;
            } else {
            PG8_LDB(B0, 0, 0); PG8_SCHED; PG8_LDA(At, 0, 0); PG8_STAGE(PG8_SA(1, 1), a1 + hstepA, voffA);
            PG8_WAIT_L(8); PG8_BAR; PG8_WAIT_L(0); PG8_MMA(0, 0, At, B0); PG8_BAR; PG8_SCHED;
            PG8_LDB(B1, 0, 1); PG8_STAGE(PG8_SB(0, 0), b2, voffB);
            PG8_BAR; PG8_WAIT_L(0); PG8_MMA(0, 1, At, B1); PG8_BAR;
            PG8_LDA(At, 0, 1); PG8_STAGE(PG8_SA(0, 0), a2, voffA);
            PG8_BAR; PG8_WAIT_L(0); PG8_MMA(1, 0, At, B0); PG8_BAR; PG8_SCHED;
            PG8_STAGE(PG8_SB(0, 1), b2 + hstepB, voffB);
            PG8_WAIT_V(6); PG8_BAR; PG8_MMA(1, 1, At, B1); PG8_BAR;
            PG8_LDB(B0, 1, 0); PG8_SCHED; PG8_LDA(At, 1, 0); PG8_STAGE(PG8_SA(0, 1), a2 + hstepA, voffA);
            PG8_WAIT_L(8); PG8_BAR; PG8_WAIT_L(0); PG8_MMA(0, 0, At, B0); PG8_BAR; PG8_SCHED;
            PG8_LDB(B1, 1, 1); PG8_STAGE(PG8_SB(1, 0), b3, voffB);
            PG8_BAR; PG8_WAIT_L(0); PG8_MMA(0, 1, At, B1); PG8_BAR;
            PG8_LDA(At, 1, 1); PG8_STAGE(PG8_SA(1, 0), a3, voffA);
            PG8_BAR; PG8_WAIT_L(0); PG8_MMA(1, 0, At, B0); PG8_BAR; PG8_SCHED;
            PG8_STAGE(PG8_SB(1, 1), b3 + hstepB, voffB);
            PG8_WAIT_V(6); PG8_BAR; PG8_MMA(1, 1, At, B1); PG8_BAR;
            }
        }
        if constexpr (ALIGN_EPI) { if (wr == 0) PG8_BAR; }
        if constexpr (!Epi::AFTER_DRAIN) { E(acc, cur, wr, wc, fr, fq); S.done(cur); }
        if (!has_next) break;
#pragma unroll
        for (int a = 0; a < 2; ++a)
#pragma unroll
            for (int b = 0; b < 2; ++b)
#pragma unroll
                for (int m = 0; m < 4; ++m)
#pragma unroll
                    for (int n = 0; n < 2; ++n) acc[a][b][m][n] = (f32x4){0.f, 0.f, 0.f, 0.f};
        cur = nxt; cA = nA; cB = nB; ++ui;
        if constexpr (ALIGN_EPI) { if (wr == 1) PG8_BAR; }
    }
    PG8_WAIT_V(0);
    if constexpr (!ALIGN_EPI) { if (wr == 0) PG8_BAR; }
    PG8_BAR;
    if constexpr (Epi::AFTER_DRAIN) { E.fused(acc, cur, wr, wc, fr, fq, lds, wid, lane); S.done(cur); }
#undef PG8_ABASE
#undef PG8_SA
#undef PG8_SB
#undef PG8_STAGE
#undef PG8_LDA
#undef PG8_LDB
#undef PG8_MMA
#undef PG8_WAIT_V
#undef PG8_WAIT_L
#undef PG8_BAR
#undef PG8_SCHED
}
}
#define GAS __attribute__((address_space(1)))
#define LAS __attribute__((address_space(3)))
typedef unsigned short bf16;
typedef unsigned v4u __attribute__((ext_vector_type(4)));
typedef float f32x4 __attribute__((ext_vector_type(4)));
typedef short bf16x8 __attribute__((ext_vector_type(8)));
typedef GAS unsigned gu32;
typedef GAS unsigned long long gu64;
#define RLX_AGENT __ATOMIC_RELAXED, __HIP_MEMORY_SCOPE_AGENT
#define LDS_WAIT() asm volatile("s_waitcnt lgkmcnt(0)" ::: "memory")
#define VM_WAIT() asm volatile("s_waitcnt vmcnt(0)" ::: "memory")
__device__ __forceinline__ unsigned long long rt() { return __builtin_amdgcn_s_memrealtime(); }
__device__ __forceinline__ unsigned f2bf(float f) { unsigned u = __builtin_bit_cast(unsigned, f); return (u + 0x7fffu + ((u >> 16) & 1u)) >> 16; }
__device__ __forceinline__ unsigned pk2(float lo, float hi) { return f2bf(lo) | (f2bf(hi) << 16); }

#define XB_TMO      128
#define XB_XCNT(j)  (256  + 64 * (j))
#define XB_XSUB(j)  (1280 + 64 * (j))
#define XB_XGEN(j)  (2304 + 64 * (j))
#define XB_TOP      3328
#define XB_TOPGEN   3392
#define XCD_BAR_WORDS 3456
#define XB_SPIN_CAP (1u << 18)

__device__ __forceinline__ unsigned xb_ld(unsigned* p)              { return __hip_atomic_load(p, __ATOMIC_RELAXED, __HIP_MEMORY_SCOPE_AGENT); }
__device__ __forceinline__ unsigned xb_add(unsigned* p, unsigned v) { return __hip_atomic_fetch_add(p, v, __ATOMIC_RELAXED, __HIP_MEMORY_SCOPE_AGENT); }
__device__ __forceinline__ unsigned xb_xcc_id() { return (unsigned)__builtin_amdgcn_s_getreg((3 << 11) | 20) & 0xFu; }
#define XB_SPIN(cond, bar) do { unsigned _sp = 0; while (cond) { __builtin_amdgcn_s_sleep(1); \
    if ((++_sp & 255u) == 0u) { if (xb_ld(&(bar)[XB_TMO])) break; if (_sp > XB_SPIN_CAP) { atomicAdd(&(bar)[XB_TMO], 1u); break; } } } } while (0)

struct XcdBarrier {
    unsigned* bar; unsigned x;
    volatile LAS unsigned* st;
};

__device__ __forceinline__ XcdBarrier xcd_barrier_post(unsigned* bar, volatile LAS unsigned* st) {
    XcdBarrier b; b.bar = bar; b.x = xb_xcc_id(); b.st = st;
    if (threadIdx.x == 0) (void)xb_add(&bar[XB_XCNT(b.x)], 1u);
    return b;
}
__device__ __forceinline__ void xcd_barrier_complete(unsigned* bar, unsigned x, unsigned& nloc, unsigned& nx) {
    const unsigned G = gridDim.x * gridDim.y * gridDim.z;
    unsigned sum, cnt, mine, sp = 0u;
    for (;;) {
        sum = 0u; cnt = 0u; mine = 0u;
#pragma unroll
        for (unsigned j = 0; j < 16; ++j) { const unsigned c = xb_ld(&bar[XB_XCNT(j)]); sum += c; cnt += (c > 0u) ? 1u : 0u; mine = (j == x) ? c : mine; }
        if (sum == G) break;
        __builtin_amdgcn_s_sleep(1);
        if ((++sp & 255u) == 0u) { if (xb_ld(&bar[XB_TMO])) break; if (sp > XB_SPIN_CAP) { atomicAdd(&bar[XB_TMO], 1u); break; } }
    }
    nloc = mine > 0u ? mine : 1u; nx = cnt > 0u ? cnt : 1u;
}

__device__ __forceinline__ void xcd_barrier(const XcdBarrier& b) {
    asm volatile("s_waitcnt vmcnt(0)" ::: "memory");
    __syncthreads();
    if (threadIdx.x == 0) {
        unsigned* bar = b.bar;
        __builtin_amdgcn_s_waitcnt(0);
        unsigned nloc = b.st[0], nx = b.st[1];
        if (nloc == 0u) { xcd_barrier_complete(bar, b.x, nloc, nx); b.st[0] = nloc; b.st[1] = nx; }
        const unsigned old = xb_add(&bar[XB_XSUB(b.x)], 1u);
        const unsigned gen = old / nloc;
        if (old + 1u == (gen + 1u) * nloc) {
            __builtin_amdgcn_fence(__ATOMIC_RELEASE, "agent");
            asm volatile("s_waitcnt vmcnt(0)" ::: "memory");
            const unsigned og = xb_add(&bar[XB_TOP], 1u);
            const unsigned tg = og / nx;
            if (og + 1u == (tg + 1u) * nx) xb_add(&bar[XB_TOPGEN], 1u);
            else XB_SPIN(xb_ld(&bar[XB_TOPGEN]) == tg, bar);
            __builtin_amdgcn_fence(__ATOMIC_ACQUIRE, "agent");
            xb_add(&bar[XB_XGEN(b.x)], 1u);
            asm volatile("s_waitcnt vmcnt(0)" ::: "memory");
        } else {
            XB_SPIN(xb_ld(&bar[XB_XGEN(b.x)]) == gen, bar);
            __builtin_amdgcn_fence(__ATOMIC_ACQUIRE, "agent");
            asm volatile("s_waitcnt vmcnt(0)" ::: "memory");
        }
    }
    __syncthreads();
}
constexpr int NB = 4, SEQ = 4096, T = NB * SEQ, DM = 1024, DEPTH = 4;
constexpr int NE = 3072, NO = 3072;
constexpr int EC_QA = 0, EC_CKV = 512, EC_QI = 768, EC_KI = 1280, EC_QB = 1344, EC_KB = 1856, EC_VB = 2368, EC_WI = 2880;
constexpr int OC_Q = 0, OC_K = 1024, OC_V = 2048;
constexpr int EVEN_IN = 2888, ODD_IN = 3088;
constexpr float RMS_EPS = 1e-6f;
constexpr float LOG2E = 1.4426950408889634f;
constexpr float C2 = 0.125f * LOG2E;
constexpr int NWAVES = 8, NTHR = 512;

constexpr size_t MiB = 1u << 20;
constexpr size_t WS_CTL = 0, CTL_ZERO_BYTES = 1 * MiB;
constexpr size_t WS_MOD = 1 * MiB;
constexpr size_t WS_KN = 2 * MiB;
constexpr size_t WS_FCUM = 3 * MiB;
constexpr size_t WS_WEIN = 4 * MiB;
constexpr size_t WS_WOIN = 22 * MiB;
constexpr size_t WS_WEOUT = 35 * MiB;
constexpr size_t WS_WOOUT = 45 * MiB;
constexpr size_t WS_WPQ = 49 * MiB;
constexpr size_t WS_WSK = 65 * MiB;
constexpr size_t WS_PU = 66 * MiB, WS_PV = 98 * MiB;
constexpr size_t WS_U8 = 66 * MiB;
constexpr size_t WS_V8 = 82 * MiB;
constexpr size_t WS_SU = 98 * MiB, WS_SV = 99 * MiB;
constexpr size_t WS_ACT = 100 * MiB;
constexpr size_t WS_H8 = 108 * MiB;
constexpr size_t WS_SX = 124 * MiB;
constexpr size_t WS_X = 130 * MiB;
constexpr size_t WS_H = 194 * MiB;
constexpr size_t WS_P = 226 * MiB;
constexpr size_t WS_AO = 370 * MiB;
constexpr size_t WS_CKV = 450 * MiB;
constexpr size_t WS_SEL = 458 * MiB;
constexpr size_t WS_PE = 466 * MiB;
constexpr size_t WS_PG = 474 * MiB;
constexpr size_t WS_QL = 482 * MiB;
constexpr size_t WS_AO2 = 546 * MiB;
constexpr size_t WS_WUKB = 578 * MiB;
constexpr size_t WS_WUVB = 579 * MiB;
constexpr size_t WS_WFT = 580 * MiB;
constexpr size_t WS_FG = 581 * MiB;
constexpr size_t WS_END = 582 * MiB;
constexpr int CW_BAR = 4096;
constexpr int CW_RANK = 16384;

constexpr int RING_BYTES = 131072;
constexpr int LDS_BYTES = 163840;
constexpr int MISC_OFF = LDS_BYTES - 512;
constexpr int XTRA_OFF = RING_BYTES;

__device__ __constant__ unsigned char T5_BUCKET[128] = {
  0, 1, 2, 3, 4, 5, 6, 7, 8, 9, 10, 11, 12, 13, 14, 15, 16, 16, 16, 17, 17, 18, 18, 18, 19, 19, 19, 20, 20, 20, 20, 21, 21, 21, 21, 22, 22, 22, 22, 22,
  23, 23, 23, 23, 23, 23, 24, 24, 24, 24, 24, 24, 25, 25, 25, 25, 25, 25, 25, 26, 26, 26, 26, 26, 26, 26, 26, 27, 27, 27, 27, 27, 27, 27, 27, 27, 27,
  28, 28, 28, 28, 28, 28, 28, 28, 28, 28, 29, 29, 29, 29, 29, 29, 29, 29, 29, 29, 29, 29, 30, 30, 30, 30, 30, 30, 30, 30, 30, 30, 30, 30, 30, 30,
  31, 31, 31, 31, 31, 31, 31, 31, 31, 31, 31, 31, 31, 31, 31};
__device__ __forceinline__ int t5_bucket(int d) { return d >= 128 ? 31 : (int)T5_BUCKET[d]; }
typedef float f32x16 __attribute__((ext_vector_type(16)));
typedef short s16x4 __attribute__((ext_vector_type(4)));
typedef unsigned u32x2 __attribute__((ext_vector_type(2)));
typedef unsigned u32x4 __attribute__((ext_vector_type(4)));
typedef int i32x4 __attribute__((ext_vector_type(4)));
#define KAS __attribute__((address_space(4)))
struct Frame {
    LAS unsigned char* lds;
    volatile LAS unsigned* MISC;
    gu32* ctl;
    int tid, lane, wave;
    int vcu, G, vcu0, wave0;
    unsigned char* ws;
    const KAS char* ka; const KAS char* ka0;
    float* out;
    __device__ __forceinline__ const float* inp(int i) const { return *(const float* const KAS*)(ka + 8 * i); }
};
#define PHASE_BEGIN(F) do { const KAS char* ka_ = (F).ka0; asm volatile("" : "+s"(ka_)); (F).ka = ka_; (F).out = *(float* const KAS*)(ka_ + 176); (F).ws = *(unsigned char* const KAS*)(ka_ + 184); \
    (F).ctl = (gu32*)((F).ws + WS_CTL); int t_ = threadIdx.x; asm volatile("" : "+v"(t_)); (F).tid = t_; (F).lane = t_ & 63; (F).wave = __builtin_amdgcn_readfirstlane(t_ >> 6); \
    int v_ = (F).vcu0; asm volatile("" : "+s"(v_)); (F).vcu = v_; } while (0)
__device__ __forceinline__ float wave_sum(float v) {
#pragma unroll
    for (int o = 1; o < 64; o <<= 1) v += __shfl_xor(v, o);
    return v;
}
__device__ __forceinline__ float bf2f(unsigned h) { return __uint_as_float(h << 16); }
__device__ __forceinline__ float bflo(unsigned w) { return __uint_as_float(w << 16); }
__device__ __forceinline__ float bfhi(unsigned w) { return __uint_as_float(w & 0xffff0000u); }
__device__ __forceinline__ float siluf(float x) { return x / (1.f + __expf(-x)); }
__device__ __forceinline__ float gelu_tanh(float x) {
    const float u = 0.7978845608028654f * (x + 0.044715f * x * x * x);
    const float e = __expf(2.f * u);
    const float th = 1.f - 2.f / (e + 1.f);
    return 0.5f * x * (1.f + th);
}
enum { I_X = 0, I_C, I_RELB, I_ADAW, I_ADAB, I_NMIX, I_NFFN, I_NFIN, I_EWIN, I_EWOUT, I_KVN, I_WUK, I_WUV, I_LAM, I_SUBLN, I_OWIN, I_BF, I_OWOUT, I_PWQ, I_PSK, I_PU, I_PV };

__device__ __forceinline__ void tr_item(const float* W, int ldw, int sc0, int ncols, bf16* WT, int ldt, int dr0, int dc0, float scale, LAS float* scr, int kb, int nb, int lane) {
    const int k0 = 64 * kb, n0 = 32 * nb;
    const int nn = lane & 31; const bool ok = (n0 + nn) < ncols;
#pragma unroll 32
    for (int i = 0; i < 32; ++i) { const int kk = 2 * i + (lane >> 5); scr[kk * 33 + nn] = ok ? W[(size_t)(k0 + kk) * ldw + sc0 + n0 + nn] * scale : 0.f; }
    LDS_WAIT(); asm volatile("" ::: "memory");
    const int c = lane & 7;
#pragma unroll
    for (int j = 0; j < 4; ++j) { const int n = (lane >> 3) + 8 * j; const LAS float* s = scr + (8 * c) * 33 + n;
        v4u o; o.x = pk2(s[0 * 33], s[1 * 33]); o.y = pk2(s[2 * 33], s[3 * 33]); o.z = pk2(s[4 * 33], s[5 * 33]); o.w = pk2(s[6 * 33], s[7 * 33]);
        if (n0 + n < ncols) *(GAS v4u*)(WT + (size_t)(dr0 + n0 + n) * ldt + dc0 + k0 + 8 * c) = o; }
    LDS_WAIT(); asm volatile("" ::: "memory");
}
struct TrJob { const float* W; int ldw, sc0, ncols, K; bf16* WT; int ldt, dr0, dc0; float scale; };
__device__ __forceinline__ TrJob get_trjob(const Frame& F, int j) {
    TrJob J;
    if (j < 16) { const int e = j / 8, s = j % 8;
        const int sc0[8] = {0, 512, 768, 1280, 1344, 1352, 1864, 2376}; const int nc[8] = {512, 256, 512, 64, 8, 512, 512, 512};
        const int dr[8] = {EC_QA, EC_CKV, EC_QI, EC_KI, EC_WI, EC_QB, EC_KB, EC_VB}; const float sc[8] = {1.f, 1.f, 0.125f, 1.f, 0.35355339059327373f, C2, 1.f, 1.f};
        int a = 0, b = 0, c = 0; float d = 1.f;
#pragma unroll
        for (int q = 0; q < 8; ++q) if (q == s) { a = sc0[q]; b = nc[q]; c = dr[q]; d = sc[q]; }
        J.W = F.inp(I_EWIN) + (size_t)e * DM * EVEN_IN; J.ldw = EVEN_IN; J.sc0 = a; J.ncols = b; J.K = DM; J.WT = (bf16*)(F.ws + WS_WEIN) + (size_t)e * NE * DM; J.ldt = DM; J.dr0 = c; J.dc0 = 0; J.scale = d;
    } else if (j < 22) { const int o = (j - 16) / 3, s = (j - 16) % 3;
        J.W = F.inp(I_OWIN) + (size_t)o * DM * ODD_IN; J.ldw = ODD_IN; J.sc0 = 1024 * s; J.ncols = 1024; J.K = DM; J.WT = (bf16*)(F.ws + WS_WOIN) + (size_t)o * NO * DM; J.ldt = DM; J.dr0 = 1024 * s; J.dc0 = 0; J.scale = (s == 0) ? C2 : 1.f;
    } else if (j < 24) { const int e = j - 22;
        J.W = F.inp(I_EWOUT) + (size_t)e * DM * DM; J.ldw = DM; J.sc0 = 0; J.ncols = DM; J.K = DM; J.WT = (bf16*)(F.ws + WS_WEOUT) + (size_t)e * DM * DM; J.ldt = DM; J.dr0 = 0; J.dc0 = 0; J.scale = 1.f;
    } else if (j < 26) { const int o = j - 24;
        J.W = F.inp(I_OWOUT) + (size_t)o * DM * DM; J.ldw = DM; J.sc0 = 0; J.ncols = DM; J.K = DM; J.WT = (bf16*)(F.ws + WS_WOOUT) + (size_t)o * DM * DM; J.ldt = DM; J.dr0 = 0; J.dc0 = 0; J.scale = 1.f;
    } else { const int l = j - 26;
        J.W = F.inp(I_PWQ) + (size_t)l * DM * 2048; J.ldw = 2048; J.sc0 = 0; J.ncols = 2048; J.K = DM; J.WT = (bf16*)(F.ws + WS_WPQ) + (size_t)l * 2048 * DM; J.ldt = DM; J.dr0 = 0; J.dc0 = 0; J.scale = 1.f;
    }
    return J;
}
constexpr int N_TRJOBS = 30;
__device__ __forceinline__ int trjob_items(int j) {
    if (j < 16) { const int s = j % 8; const int nb[8] = {16, 8, 16, 2, 1, 16, 16, 16}; int r = 0;
#pragma unroll
        for (int q = 0; q < 8; ++q) if (q == s) r = nb[q]; return 16 * r; }
    if (j < 22) return 16 * 32;
    if (j < 26) return 16 * 32;
    return 16 * 64;
}
__device__ __forceinline__ void p0_transposes(Frame& F) { PHASE_BEGIN(F);
    LAS float* scr = (LAS float*)(F.lds + F.wave * 16384);
    const int gw = F.vcu * NWAVES + F.wave, NGW = F.G * NWAVES;
    int base = 0;
    for (int j = 0; j < N_TRJOBS; ++j) {
        const int ni = trjob_items(j);
        int it = ((gw - base) % NGW + NGW) % NGW;
        if (it < ni) { const TrJob J = get_trjob(F, j); const int nblk = (J.ncols + 31) / 32;
            for (; it < ni; it += NGW) tr_item(J.W, J.ldw, J.sc0, J.ncols, J.WT, J.ldt, J.dr0, J.dc0, J.scale, scr, it / nblk, it % nblk, F.lane); }
        base += ni;
    }
    const int gt = F.vcu * NTHR + F.tid, NGT = F.G * NTHR;
    for (int e = 0; e < 2; ++e) { GAS v4u* p = (GAS v4u*)((bf16*)(F.ws + WS_WEIN) + (size_t)e * NE * DM + (size_t)EVEN_IN * DM); const int n = (NE - EVEN_IN) * DM / 8;
        for (int i = gt; i < n; i += NGT) p[i] = (v4u){0u, 0u, 0u, 0u}; }
    { const float* s = F.inp(I_PSK); bf16* d = (bf16*)(F.ws + WS_WSK); const int n = DEPTH * 2 * 128 * 128 / 4;
        for (int i = gt; i < n; i += NGT) { const f32x4 v = *(const GAS f32x4*)(s + (size_t)i * 4); u32x2 w; w.x = pk2(v.x, v.y); w.y = pk2(v.z, v.w); *(GAS u32x2*)(d + (size_t)i * 4) = w; } }
}
__device__ __forceinline__ void p0_fused_weights(Frame& F) { PHASE_BEGIN(F);
    const int gt = F.vcu * NTHR + F.tid, NGT = F.G * NTHR;
    bf16* ukt = (bf16*)(F.ws + WS_WUKB); bf16* uvt = (bf16*)(F.ws + WS_WUVB);
    for (int i = gt; i < 2 * 8 * 256 * 64; i += NGT) { const int d = i & 63, c = (i >> 6) & 255, h = (i >> 14) & 7, e = i >> 17;
        ukt[i] = (bf16)f2bf(C2 * F.inp(I_WUK)[(((size_t)e * 256 + c) * 8 + h) * 64 + d]); }
    for (int i = gt; i < 2 * 8 * 64 * 256; i += NGT) { const int c = i & 255, d = (i >> 8) & 63, h = (i >> 14) & 7, e = i >> 17;
        uvt[i] = (bf16)f2bf(F.inp(I_WUV)[(((size_t)e * 256 + c) * 8 + h) * 64 + d]); }
    bf16* wft = (bf16*)(F.ws + WS_WFT);
    for (int i = gt; i < 2 * 16 * 1024; i += NGT) { const int k = i & 1023, h = (i >> 10) & 15, o = i >> 14;
        wft[i] = (bf16)f2bf(F.inp(I_OWIN)[(size_t)o * DM * ODD_IN + (size_t)k * ODD_IN + 3072 + h]); }
}
__device__ __forceinline__ void p0_mod(Frame& F) { PHASE_BEGIN(F);
    __syncthreads();
    LAS float* cs = (LAS float*)F.lds;
    LAS float* red = (LAS float*)(F.lds + 16384);
    for (int i = F.tid; i < 4 * DM; i += NTHR) cs[i] = siluf(F.inp(I_C)[i]);
    __syncthreads();
    float* mod = (float*)(F.ws + WS_MOD);
    for (int it = F.vcu; it < DEPTH * 96; it += F.G) {
        const int l = it / 96, j0 = 64 * (it % 96);
        const float* W = F.inp(I_ADAW) + (size_t)l * DM * 6144 + j0 + F.lane;
        float a0 = 0.f, a1 = 0.f, a2 = 0.f, a3 = 0.f;
        const int kb = 128 * F.wave;
#pragma unroll 32
        for (int k = 0; k < 128; ++k) { const float w = W[(size_t)(kb + k) * 6144]; a0 += cs[kb + k] * w; a1 += cs[1024 + kb + k] * w; a2 += cs[2048 + kb + k] * w; a3 += cs[3072 + kb + k] * w; }
        red[(F.wave * 4 + 0) * 64 + F.lane] = a0; red[(F.wave * 4 + 1) * 64 + F.lane] = a1; red[(F.wave * 4 + 2) * 64 + F.lane] = a2; red[(F.wave * 4 + 3) * 64 + F.lane] = a3;
        __syncthreads();
        if (F.tid < 256) { const int b = F.tid >> 6, jj = F.tid & 63; float s = F.inp(I_ADAB)[(size_t)l * 6144 + j0 + jj];
#pragma unroll
            for (int w = 0; w < 8; ++w) s += red[(w * 4 + b) * 64 + jj];
            mod[((size_t)l * 4 + b) * 6144 + j0 + jj] = s; }
        __syncthreads();
    }
}
typedef float f32x2v __attribute__((ext_vector_type(2)));
__device__ __forceinline__ void conv_peer_tables(Frame& F, int layer) { PHASE_BEGIN(F);
    const int gw = F.vcu * NWAVES + F.wave, NGW = F.G * NWAVES, lane = F.lane;
    const float* pu = F.inp(I_PU) + (size_t)layer * 16384 * 1024; const float* pv = F.inp(I_PV) + (size_t)layer * 16384 * 1024;
    unsigned char* U8 = F.ws + WS_U8; unsigned char* V8 = F.ws + WS_V8; float* SU = (float*)(F.ws + WS_SU); float* SV = (float*)(F.ws + WS_SV);
    for (int row0 = 4 * gw; row0 < 32768; row0 += 4 * NGW) {
        f32x4 x[4][4];
#pragma unroll
        for (int rr = 0; rr < 4; ++rr) { const int row = row0 + rr; const float* src = ((row >> 14) ? pv : pu) + (size_t)(row & 16383) * 1024 + 16 * lane;
#pragma unroll
            for (int q = 0; q < 4; ++q) x[rr][q] = __builtin_nontemporal_load((const GAS f32x4*)(src + 4 * q)); }
#pragma unroll
        for (int rr = 0; rr < 4; ++rr) { const int row = row0 + rr; const int isv = row >> 14, e = row & 16383; float mx = 0.f;
#pragma unroll
            for (int q = 0; q < 4; ++q) mx = fmaxf(mx, fmaxf(fmaxf(fabsf(x[rr][q].x), fabsf(x[rr][q].y)), fmaxf(fabsf(x[rr][q].z), fabsf(x[rr][q].w))));
#pragma unroll
            for (int o = 1; o < 64; o <<= 1) mx = fmaxf(mx, __shfl_xor(mx, o));
            const float sc = mx > 0.f ? mx * (1.f / 400.f) : 1.f, inv = 1.f / sc;
            v4u w;
#pragma unroll
            for (int q = 0; q < 4; ++q) { int t = __builtin_amdgcn_cvt_pk_fp8_f32(x[rr][q].x * inv, x[rr][q].y * inv, 0, false); t = __builtin_amdgcn_cvt_pk_fp8_f32(x[rr][q].z * inv, x[rr][q].w * inv, t, true); w[q] = (unsigned)t; }
            if (isv) { *(GAS v4u*)(V8 + (size_t)(lane >> 3) * (16384 * 128) + (size_t)e * 128 + (lane & 7) * 16) = w; if (lane == 0) SV[e] = sc; }
            else { *(GAS v4u*)(U8 + (size_t)e * 1024 + 16 * lane) = w; if (lane == 0) SU[e] = sc; } }
    }
}
__device__ __forceinline__ void norm_mod_row(const float* xrow, const float* g, const float* sc, const float* sh, bf16* orow, unsigned char* o8, float* sx, const float* wf, float* fg, int lane) {
    const GAS f32x4* xr = (const GAS f32x4*)xrow + lane;
    f32x4 v[4]; float s2 = 0.f;
#pragma unroll
    for (int j = 0; j < 4; ++j) { v[j] = xr[64 * j]; s2 += (v[j].x * v[j].x + v[j].y * v[j].y) + (v[j].z * v[j].z + v[j].w * v[j].w); }
    const float rstd = 1.f / sqrtf(wave_sum(s2) * (1.f / DM) + RMS_EPS);
    GAS unsigned long long* o8b = (GAS unsigned long long*)orow + lane; float mx = 0.f;
#pragma unroll
    for (int j = 0; j < 4; ++j) { const f32x4 gg = *((const GAS f32x4*)g + lane + 64 * j), cc = *((const GAS f32x4*)sc + lane + 64 * j), hh = *((const GAS f32x4*)sh + lane + 64 * j);
        const f32x4 y = v[j] * rstd * gg * (cc + 1.f) + hh; v[j] = y;
        mx = fmaxf(mx, fmaxf(fmaxf(fabsf(y.x), fabsf(y.y)), fmaxf(fabsf(y.z), fabsf(y.w))));
        o8b[64 * j] = (unsigned long long)pk2(y.x, y.y) | ((unsigned long long)pk2(y.z, y.w) << 32); }
    if (o8) {
#pragma unroll
        for (int o = 1; o < 64; o <<= 1) mx = fmaxf(mx, __shfl_xor(mx, o));
        const float scl = mx > 0.f ? mx * (1.f / 400.f) : 1.f, inv = 1.f / scl;
#pragma unroll
        for (int j = 0; j < 4; ++j) { int t = __builtin_amdgcn_cvt_pk_fp8_f32(v[j].x * inv, v[j].y * inv, 0, false); t = __builtin_amdgcn_cvt_pk_fp8_f32(v[j].z * inv, v[j].w * inv, t, true);
            *((GAS unsigned*)o8 + lane + 64 * j) = (unsigned)t; }
        if (lane == 0) *sx = scl;
    }
    if (wf) {
        float d[16];
#pragma unroll
        for (int h = 0; h < 16; ++h) d[h] = 0.f;
#pragma unroll
        for (int j = 0; j < 4; ++j)
#pragma unroll
            for (int c = 0; c < 4; ++c) { const float y = v[j][c]; const float* wr = wf + (size_t)(256 * j + 4 * lane + c) * ODD_IN;
#pragma unroll
                for (int q = 0; q < 4; ++q) { const f32x4 w = *(const GAS f32x4*)(wr + 4 * q); d[4 * q] += y * w.x; d[4 * q + 1] += y * w.y; d[4 * q + 2] += y * w.z; d[4 * q + 3] += y * w.w; } }
#pragma unroll
        for (int lvl = 0, n = 16; n > 1; ++lvl, n >>= 1) { const int bit = 1 << lvl;
#pragma unroll
            for (int q = 0; q < n / 2; ++q) { const float keep = (lane & bit) ? d[2 * q + 1] : d[2 * q], send = (lane & bit) ? d[2 * q] : d[2 * q + 1]; d[q] = keep + __shfl_xor(send, bit); } }
        float e1 = d[0]; e1 += __shfl_xor(e1, 16); e1 += __shfl_xor(e1, 32);
        if (lane < 16) fg[lane] = e1;
    }
}
__device__ __forceinline__ void norm_mod_phase(Frame& F, int src_ws, int layer, int which) { PHASE_BEGIN(F);
    const int gw = F.vcu * NWAVES + F.wave, NGW = F.G * NWAVES;
    const float* g = F.inp(which == 0 ? I_NMIX : I_NFFN) + (size_t)layer * DM;
    const float* mod = (const float*)(F.ws + WS_MOD) + (size_t)layer * 4 * 6144;
    bf16* H = (bf16*)(F.ws + WS_H);
    const float* X = src_ws ? (const float*)(F.ws + WS_X) : F.inp(I_X);
    const float* wf = nullptr;
    for (int m = gw; m < T; m += NGW) { const float* mb = mod + (size_t)(m / SEQ) * 6144 + (which == 0 ? 0 : 3 * DM);
        norm_mod_row(X + (size_t)m * DM, g, mb + DM, mb, H + (size_t)m * DM, which ? F.ws + WS_H8 + (size_t)m * DM : nullptr, (float*)(F.ws + WS_SX) + m, wf, (float*)(F.ws + WS_FG) + (size_t)m * 16, F.lane); }
}
__device__ __forceinline__ void final_norm_phase(Frame& F) { PHASE_BEGIN(F);
    const int gw = F.vcu * NWAVES + F.wave, NGW = F.G * NWAVES;
    const float* X = (const float*)(F.ws + WS_X); const float* g = F.inp(I_NFIN);
    for (int m = gw; m < T; m += NGW) { const GAS f32x4* xr = (const GAS f32x4*)(X + (size_t)m * DM) + F.lane; f32x4 v[4]; float s2 = 0.f;
#pragma unroll
        for (int j = 0; j < 4; ++j) { v[j] = xr[64 * j]; s2 += (v[j].x * v[j].x + v[j].y * v[j].y) + (v[j].z * v[j].z + v[j].w * v[j].w); }
        const float rstd = 1.f / sqrtf(wave_sum(s2) * (1.f / DM) + RMS_EPS);
        GAS f32x4* o = (GAS f32x4*)(F.out + (size_t)m * DM) + F.lane;
#pragma unroll
        for (int j = 0; j < 4; ++j) o[64 * j] = v[j] * rstd * *((const GAS f32x4*)g + F.lane + 64 * j); }
}
__device__ __forceinline__ unsigned f2sort(float x) { const unsigned u = __float_as_uint(x); return (u & 0x80000000u) ? ~u : (u | 0x80000000u); }
__device__ __forceinline__ float sort2f(unsigned k) { return __uint_as_float((k & 0x80000000u) ? (k & 0x7fffffffu) : ~k); }
__device__ __forceinline__ unsigned mbcnt64(unsigned long long m) { return __builtin_amdgcn_mbcnt_hi((unsigned)(m >> 32), __builtin_amdgcn_mbcnt_lo((unsigned)m, 0u)); }
#define LDS_FENCE() asm volatile("s_waitcnt lgkmcnt(0)" ::: "memory")

__device__ __forceinline__ void topk_unit(Frame& F, int b, int t0) {
    const int lane = F.lane, wid = F.wave, r32 = lane & 31, hi = lane >> 5;
    const bf16* P = (const bf16*)(F.ws + WS_P) + (size_t)b * SEQ * NE;
    LAS float* scores = (LAS float*)F.lds;
    LAS unsigned* minmax = (LAS unsigned*)(F.lds + XTRA_OFF + 24576);
    if (F.tid < 16) minmax[F.tid] = (F.tid & 1) ? 0xffffffffu : 0u;
    bf16x8 qa[2][4];
#pragma unroll
    for (int rt = 0; rt < 2; ++rt)
#pragma unroll
        for (int d0 = 0; d0 < 4; ++d0) qa[rt][d0] = *(const GAS bf16x8*)(P + (size_t)(t0 + 4 * rt + (r32 >> 3)) * NE + EC_QI + (r32 & 7) * 64 + 16 * d0 + 8 * hi);
    float wv[2][4][4];
#pragma unroll
    for (int rt = 0; rt < 2; ++rt)
#pragma unroll
        for (int g = 0; g < 4; ++g) { const u32x2 w = *(const GAS u32x2*)(P + (size_t)(t0 + 4 * rt + g) * NE + EC_WI + 4 * hi);
            wv[rt][g][0] = bflo(w.x); wv[rt][g][1] = bfhi(w.x); wv[rt][g][2] = bflo(w.y); wv[rt][g][3] = bfhi(w.y); }
    float mn[4], mx[4];
#pragma unroll
    for (int g = 0; g < 4; ++g) { mn[g] = INFINITY; mx[g] = -INFINITY; }
    const int nkt = (t0 + 8 + 31) >> 5;
    bf16x8 kn[4];
    { const int key0 = 32 * (wid < nkt ? wid : 0) + r32;
#pragma unroll
      for (int d0 = 0; d0 < 4; ++d0) kn[d0] = *(const GAS bf16x8*)(P + (size_t)key0 * NE + EC_KI + 16 * d0 + 8 * hi); }
    for (int kt = wid; kt < nkt; kt += NWAVES) {
        const int key = 32 * kt + r32;
        bf16x8 kb[4];
#pragma unroll
        for (int d0 = 0; d0 < 4; ++d0) kb[d0] = kn[d0];
        { const int keyn = 32 * (kt + NWAVES < nkt ? kt + NWAVES : kt) + r32;
#pragma unroll
          for (int d0 = 0; d0 < 4; ++d0) kn[d0] = *(const GAS bf16x8*)(P + (size_t)keyn * NE + EC_KI + 16 * d0 + 8 * hi); }
        f32x16 acc[2];
#pragma unroll
        for (int rt = 0; rt < 2; ++rt) { acc[rt] = (f32x16){};
#pragma unroll
            for (int d0 = 0; d0 < 4; ++d0) acc[rt] = __builtin_amdgcn_mfma_f32_32x32x16_bf16(qa[rt][d0], kb[d0], acc[rt], 0, 0, 0); }
#pragma unroll
        for (int g = 0; g < 4; ++g) {
            float s0 = 0.f, s1 = 0.f;
#pragma unroll
            for (int j = 0; j < 4; ++j) { s0 += wv[0][g][j] * fmaxf(acc[0][4 * g + j], 0.f); s1 += wv[1][g][j] * fmaxf(acc[1][4 * g + j], 0.f); }
            s0 += __shfl_xor(s0, 32); s1 += __shfl_xor(s1, 32);
            const float v = (hi ? s1 : s0) + 0.f;
            const int tok = 4 * hi + g;
            scores[tok * 4096 + key] = v;
            if (key <= t0 + tok) { mn[g] = fminf(mn[g], v); mx[g] = fmaxf(mx[g], v); }
        }
    }
#pragma unroll
    for (int g = 0; g < 4; ++g) {
#pragma unroll
        for (int o = 1; o < 32; o <<= 1) { mn[g] = fminf(mn[g], __shfl_xor(mn[g], o)); mx[g] = fmaxf(mx[g], __shfl_xor(mx[g], o)); }
    }
    __syncthreads();
    if (r32 == 0) {
#pragma unroll
        for (int g = 0; g < 4; ++g) { if (mx[g] >= mn[g]) { __hip_atomic_fetch_max(&minmax[(4 * hi + g) * 2], f2sort(mx[g]), __ATOMIC_RELAXED, __HIP_MEMORY_SCOPE_WORKGROUP);
                __hip_atomic_fetch_min(&minmax[(4 * hi + g) * 2 + 1], f2sort(mn[g]), __ATOMIC_RELAXED, __HIP_MEMORY_SCOPE_WORKGROUP); } }
    }
    __syncthreads();
    {
        const int t = t0 + wid, n = t + 1;
        unsigned short* selg = (unsigned short*)(F.ws + WS_SEL) + (size_t)(b * SEQ + t) * 256;
        if (n <= 256) {
#pragma unroll
            for (int q = 0; q < 4; ++q) { const int i = lane + 64 * q; selg[i] = (unsigned short)((i < n) ? i : 0xffff); }
        } else {
            const LAS float* sr = scores + wid * 4096;
            LAS unsigned* hist = (LAS unsigned*)(F.lds + XTRA_OFF + 3072 * wid);
            LAS unsigned* cand = hist + 512;
            LAS unsigned short* outl = (LAS unsigned short*)(hist + 640);
            float hif = sort2f(minmax[wid * 2]), lof = sort2f(minmax[wid * 2 + 1]);
            float scale = (hif > lof) ? 1024.f / (hif - lof) : 0.f;
            unsigned above_out = 0;
            int bstar = 0; unsigned cstar = 0, above = 0;
            for (int lvl = 0; lvl < 4; ++lvl) {
#pragma unroll
                for (int q = 0; q < 8; ++q) hist[lane + 64 * q] = 0u;
                LDS_FENCE();
                for (int i0 = 0; i0 < n; i0 += 64) { const int i = i0 + lane;
                    if (i < n) { const float x = sr[i]; if (x >= lof && x <= hif) { int bb = (int)((x - lof) * scale); bb = bb > 1023 ? 1023 : bb;
                        __hip_atomic_fetch_add(&hist[bb >> 1], (bb & 1) ? 65536u : 1u, __ATOMIC_RELAXED, __HIP_MEMORY_SCOPE_WORKGROUP); } } }
                LDS_FENCE();
                const unsigned target = 256u - above_out;
                unsigned hw[8]; unsigned tot = 0;
#pragma unroll
                for (int q = 0; q < 8; ++q) { hw[q] = hist[8 * lane + q]; tot += (hw[q] & 0xffffu) + (hw[q] >> 16); }
                unsigned suf = tot;
#pragma unroll
                for (int o = 1; o < 64; o <<= 1) { const unsigned v = __shfl_down(suf, o); if (lane + o < 64) suf += v; }
                const unsigned long long pm = __ballot(suf >= target);
                const int Ls = 63 - __builtin_clzll(pm | 1ull);
                above = __shfl(suf - tot, Ls);
                bstar = 16 * Ls; cstar = 0; bool found = false;
#pragma unroll
                for (int q = 7; q >= 0; --q) { const unsigned w = __shfl(hw[q], Ls);
                    { const unsigned c = w >> 16; if (!found) { if (above + c >= target) { found = true; bstar = 16 * Ls + 2 * q + 1; cstar = c; } else above += c; } }
                    { const unsigned c = w & 0xffffu; if (!found) { if (above + c >= target) { found = true; bstar = 16 * Ls + 2 * q; cstar = c; } else above += c; } } }
                if (cstar <= 64u || hif <= lof || lvl == 3) break;
                float mn2 = INFINITY, mx2 = -INFINITY;
                for (int i0 = 0; i0 < n; i0 += 64) { const int i = i0 + lane;
                    if (i < n) { const float x = sr[i]; if (x >= lof && x <= hif) { int bb = (int)((x - lof) * scale); bb = bb > 1023 ? 1023 : bb; if (bb == bstar) { mn2 = fminf(mn2, x); mx2 = fmaxf(mx2, x); } } } }
#pragma unroll
                for (int o = 1; o < 64; o <<= 1) { mn2 = fminf(mn2, __shfl_xor(mn2, o)); mx2 = fmaxf(mx2, __shfl_xor(mx2, o)); }
                above_out += above; lof = mn2; hif = mx2; scale = (hif > lof) ? 1024.f / (hif - lof) : 0.f;
            }
            const unsigned need = 256u - above_out - above;
            unsigned pos = 0;
            if (cstar <= 64u) {
                unsigned ncand = 0;
                for (int i0 = 0; i0 < n; i0 += 64) { const int i = i0 + lane; const bool valid = i < n; const float x = valid ? sr[i] : 0.f;
                    int bb = (int)((x - lof) * scale); bb = bb > 1023 ? 1023 : bb; const bool inr = valid && x >= lof && x <= hif;
                    const bool ab = (valid && x > hif) || (inr && bb > bstar); const unsigned long long ma = __ballot(ab);
                    if (ab) { const unsigned sl = pos + mbcnt64(ma); if (sl < 256u) outl[sl] = (unsigned short)i; }
                    pos += (unsigned)__builtin_popcountll(ma);
                    const bool ic = inr && bb == bstar; const unsigned long long mc = __ballot(ic);
                    if (ic) { const unsigned sl = ncand + mbcnt64(mc); if (sl < 64u) { cand[sl] = f2sort(x); cand[64 + sl] = (unsigned)i; } }
                    ncand += (unsigned)__builtin_popcountll(mc); }
                LDS_FENCE();
                const bool v = (unsigned)lane < ncand; const unsigned key = v ? cand[lane] : 0u; const unsigned cidx = cand[64 + lane];
                unsigned prefix = 0u;
                for (int bit = 31; bit >= 0; --bit) { const unsigned trial = prefix | (1u << bit);
                    const unsigned cnt = (unsigned)__builtin_popcountll(__ballot(v && key >= trial)); if (cnt >= need) prefix = trial; }
                const bool gt = v && key > prefix; const unsigned ngt = (unsigned)__builtin_popcountll(__ballot(gt));
                const bool eq = v && key == prefix; const unsigned long long meq = __ballot(eq);
                const bool sc = gt || (eq && mbcnt64(meq) < need - ngt);
                const unsigned long long ms = __ballot(sc);
                if (sc) { const unsigned sl = pos + mbcnt64(ms); if (sl < 256u) outl[sl] = (unsigned short)cidx; }
                pos += (unsigned)__builtin_popcountll(ms);
            } else if (hif <= lof) {
                unsigned eqseen = 0;
                for (int i0 = 0; i0 < n; i0 += 64) { const int i = i0 + lane; const bool valid = i < n; const float x = valid ? sr[i] : 0.f;
                    const bool gt = valid && x > hif, eq = valid && x == hif; const unsigned long long meq = __ballot(eq);
                    const bool sc = gt || (eq && eqseen + mbcnt64(meq) < need); const unsigned long long ms = __ballot(sc);
                    if (sc) { const unsigned sl = pos + mbcnt64(ms); if (sl < 256u) outl[sl] = (unsigned short)i; }
                    pos += (unsigned)__builtin_popcountll(ms); eqseen += (unsigned)__builtin_popcountll(meq); }
            } else {
                unsigned prefix = 0u;
                for (int bit = 31; bit >= 0; --bit) { const unsigned trial = prefix | (1u << bit); unsigned cnt = 0;
                    for (int i0 = 0; i0 < n; i0 += 64) { const int i = i0 + lane; cnt += (unsigned)__builtin_popcountll(__ballot(i < n && f2sort(sr[i < n ? i : 0]) >= trial)); }
                    if (cnt >= 256u) prefix = trial; }
                unsigned ngt = 0;
                for (int i0 = 0; i0 < n; i0 += 64) { const int i = i0 + lane; ngt += (unsigned)__builtin_popcountll(__ballot(i < n && f2sort(sr[i < n ? i : 0]) > prefix)); }
                const unsigned need_eq = 256u - ngt; unsigned eqseen = 0;
                for (int i0 = 0; i0 < n; i0 += 64) { const int i = i0 + lane; const bool valid = i < n; const unsigned k = f2sort(sr[valid ? i : 0]);
                    const bool gt = valid && k > prefix, eq = valid && k == prefix; const unsigned long long meq = __ballot(eq);
                    const bool sc = gt || (eq && eqseen + mbcnt64(meq) < need_eq); const unsigned long long ms = __ballot(sc);
                    if (sc) { const unsigned sl = pos + mbcnt64(ms); if (sl < 256u) outl[sl] = (unsigned short)i; }
                    pos += (unsigned)__builtin_popcountll(ms); eqseen += (unsigned)__builtin_popcountll(meq); }
            }
            LDS_FENCE();
            *(GAS unsigned long long*)(selg + 4 * lane) = *(const LAS unsigned long long*)(outl + 4 * lane);
        }
    }
    __syncthreads();
}
__device__ __forceinline__ void topk_phase(Frame& F) { PHASE_BEGIN(F);
    for (int idx = F.vcu; idx < 2048; idx += F.G) { const int r = idx >> 8, g = idx & 255; const int u = (r & 1) ? (r + 1) * 256 - 1 - g : r * 256 + g;
        topk_unit(F, u >> 9, (u & 511) * 8); }
}
__device__ __forceinline__ void ckv_norm_phase(Frame& F, int e) { PHASE_BEGIN(F);
    const int gw = F.vcu * NWAVES + F.wave, NGW = F.G * NWAVES;
    const bf16* P = (const bf16*)(F.ws + WS_P); bf16* CK = (bf16*)(F.ws + WS_CKV);
    const f32x4 g = *((const GAS f32x4*)(F.inp(I_KVN) + (size_t)e * 256) + F.lane);
    for (int m = gw; m < T; m += NGW) { const u32x2 w = *((const GAS u32x2*)(P + (size_t)m * NE + EC_CKV) + F.lane);
        const float a = bflo(w.x), b = bfhi(w.x), c = bflo(w.y), d = bfhi(w.y);
        const float rstd = 1.f / sqrtf(wave_sum((a * a + b * b) + (c * c + d * d)) * (1.f / 256.f) + RMS_EPS);
        u32x2 o; o.x = pk2(a * rstd * g.x, b * rstd * g.y); o.y = pk2(c * rstd * g.z, d * rstd * g.w);
        *((GAS u32x2*)(CK + (size_t)m * 256) + F.lane) = o; }
}
namespace fa {
__device__ __forceinline__ int crow(int r, int hi) { return (r & 3) + 8 * (r >> 2) + 4 * hi; }
__device__ __forceinline__ void glds16(const void* gsrc, unsigned lds_dst) { unsigned keep;
    asm volatile("s_mov_b32 %0, m0\n\ts_mov_b32 m0, %2\n\ts_nop 0\n\tglobal_load_lds_dwordx4 %1, off\n\ts_mov_b32 m0, %0" : "=&s"(keep) : "v"(gsrc), "s"(lds_dst) : "memory"); }
typedef __bf16 bf16x2_t __attribute__((ext_vector_type(2))); typedef float f32x2_t __attribute__((ext_vector_type(2)));
__device__ __forceinline__ unsigned cvtpk(float lo, float hi) { f32x2_t v = {lo, hi}; bf16x2_t b = __builtin_convertvector(v, bf16x2_t); return __builtin_bit_cast(unsigned, b); }
typedef short v4i16_t __attribute__((ext_vector_type(4)));
__device__ __forceinline__ s16x4 vtr(const LAS char* p) { return __builtin_bit_cast(s16x4, __builtin_amdgcn_ds_read_tr16_b64_v4i16((LAS v4i16_t*)p)); }
constexpr int KSLOT = 8192, THR = 8;
constexpr int L_V = 16384, L_WS = 49152, L_KB = 51200, L_PKN = 67584, L_DN = 67840, FA_LDS = 67872;

template <int VD, int MODE>
__device__ __forceinline__ void unit(LAS char* lds, const bf16* Qh, const bf16* Kh, const bf16* Vh, int pitch, int q0, bf16* Oh, int opitch, int tid_in) {
    constexpr int NDB = VD / 32, VSLOT = VD * 128;
    const int tid = tid_in, lane = tid & 63, r32 = lane & 31, hi = lane >> 5; const int wid = __builtin_amdgcn_readfirstlane(tid >> 6);
    const unsigned lds0 = (unsigned)(uintptr_t)lds;
    LAS float* wsf = (LAS float*)(lds + L_WS) + wid * 64;
    const LAS float* kbl = (const LAS float*)(lds + L_KB);
    const int NT = (q0 + 256) / 64;
    const int qw0 = q0 + 32 * wid, NTw = (qw0 + 31) / 64 + 1;
    const bf16* ksrc = Kh + (size_t)lane * pitch + wid * 8;
#define FA_DMA(t, s) do { fa::glds16(ksrc + (size_t)(t) * 64 * pitch, (unsigned)__builtin_amdgcn_readfirstlane(lds0 + (s) * fa::KSLOT + wid * 1024)); \
    _Pragma("unroll") for (int i_ = 0; i_ < NDB / 2; ++i_) { const int ci_ = i_ * 8 + wid; \
        fa::glds16(Vh + (size_t)((t) * 64 + 16 * (ci_ & 3) + (lane >> 2)) * pitch + (ci_ >> 2) * 32 + (lane & 3) * 8, (unsigned)__builtin_amdgcn_readfirstlane(lds0 + fa::L_V + (s) * VSLOT + ci_ * 1024)); } } while (0)
    constexpr bool DESC = (MODE == 1);
    LAS unsigned* doneflags = (LAS unsigned*)(lds + L_DN); const LAS float* pkn = (const LAS float*)(lds + L_PKN);
    if (lane == 0) doneflags[wid] = 0u;
    FA_DMA(DESC ? NT - 1 : 0, 0);
    bf16x8 qr[4];
#pragma unroll
    for (int d0 = 0; d0 < 4; ++d0) qr[d0] = *(const GAS bf16x8*)(Qh + (size_t)(qw0 + r32) * pitch + d0 * 16 + hi * 8);
    float qn = 0.f;
    if (MODE == 1) {
#pragma unroll
        for (int d0 = 0; d0 < 4; ++d0)
#pragma unroll
            for (int e = 0; e < 8; ++e) { const float v = bf2f((unsigned short)qr[d0][e]); qn += v * v; }
        qn += __shfl_xor(qn, 32); qn = sqrtf(qn) * 1.002f; }
    f32x16 o[NDB];
#pragma unroll
    for (int d = 0; d < NDB; ++d) o[d] = (f32x16){};
    float mhat = 0.f, l_reg = 0.f;
    asm volatile("s_waitcnt lgkmcnt(0)\n\ts_barrier" ::: "memory");
    const float farb = (MODE == 0) ? kbl[128] : 0.f;
    bool started = false, wdone = false;
    for (int it = 0; it < NT; ++it) {
        asm volatile("s_waitcnt vmcnt(0) lgkmcnt(0)\n\ts_barrier" ::: "memory");
        if (DESC) { const u32x4 f0 = *(const LAS u32x4*)doneflags, f1 = *(const LAS u32x4*)(doneflags + 4);
            if ((f0.x & f0.y & f0.z & f0.w & f1.x & f1.y & f1.z & f1.w) != 0u) break; }
        const int j = DESC ? NT - 1 - it : it;
        if (it + 1 < NT) FA_DMA(DESC ? j - 1 : j + 1, (it + 1) & 1);
        if (j < NTw && !wdone) {
            const int k0 = 64 * j;
            const LAS char* Ks = lds + (it & 1) * KSLOT + hi * 1024 + r32 * 16;
            f32x16 p0, p1;
            if (MODE == 1) {
#pragma unroll
                for (int g = 0; g < 4; ++g) { const f32x4 a = *(const LAS f32x4*)(kbl + k0 + 8 * g + 4 * hi), c = *(const LAS f32x4*)(kbl + k0 + 32 + 8 * g + 4 * hi);
                    p0[4 * g] = a.x - mhat; p0[4 * g + 1] = a.y - mhat; p0[4 * g + 2] = a.z - mhat; p0[4 * g + 3] = a.w - mhat;
                    p1[4 * g] = c.x - mhat; p1[4 * g + 1] = c.y - mhat; p1[4 * g + 2] = c.z - mhat; p1[4 * g + 3] = c.w - mhat; }
            } else { const float c = farb - mhat;
#pragma unroll
                for (int r = 0; r < 16; ++r) { p0[r] = c; p1[r] = c; } }
#pragma unroll
            for (int d0 = 0; d0 < 4; ++d0) { const bf16x8 b0 = *(const LAS bf16x8*)(Ks + d0 * 2048), b1 = *(const LAS bf16x8*)(Ks + d0 * 2048 + 512);
                p0 = __builtin_amdgcn_mfma_f32_32x32x16_bf16(b0, qr[d0], p0, 0, 0, 0); p1 = __builtin_amdgcn_mfma_f32_32x32x16_bf16(b1, qr[d0], p1, 0, 0, 0); }
            const int q = qw0 + r32;
            if (MODE == 0 && (k0 + 63 + 128 > qw0)) {
#pragma unroll
                for (int r = 0; r < 16; ++r) { int d0_ = q - (k0 + crow(r, hi)), d1_ = d0_ - 32; d0_ = d0_ < 0 ? 0 : (d0_ > 128 ? 128 : d0_); d1_ = d1_ < 0 ? 0 : (d1_ > 128 ? 128 : d1_);
                    p0[r] += kbl[d0_] - farb; p1[r] += kbl[d1_] - farb; } }
            if (k0 + 63 > qw0) {
#pragma unroll
                for (int r = 0; r < 16; ++r) { const int kv = k0 + crow(r, hi); if (kv > q) p0[r] = -INFINITY; if (kv + 32 > q) p1[r] = -INFINITY; } }
            float rm = fmaxf(p0[0], p1[0]);
#pragma unroll
            for (int r = 1; r < 16; ++r) rm = fmaxf(rm, fmaxf(p0[r], p1[r]));
            rm = fmaxf(rm, __shfl_xor(rm, 32));
            const bool first = !started; started = true;
            if (first || __any(rm > (float)THR)) {
                const float dl = first ? rm : fmaxf(rm, 0.f);
                mhat += dl;
#pragma unroll
                for (int r = 0; r < 16; ++r) { p0[r] -= dl; p1[r] -= dl; }
                if (!first) { const float f = __builtin_amdgcn_exp2f(-dl); l_reg *= f; if (hi == 0) wsf[r32] = f; LDS_FENCE();
#pragma unroll
                    for (int r = 0; r < 16; ++r) { const float ff = wsf[crow(r, hi)];
#pragma unroll
                        for (int d = 0; d < NDB; ++d) o[d][r] *= ff; }
                    LDS_FENCE(); }
            }
            float sacc = 0.f;
#pragma unroll
            for (int r = 0; r < 16; ++r) { p0[r] = __builtin_amdgcn_exp2f(p0[r]); p1[r] = __builtin_amdgcn_exp2f(p1[r]); sacc += p0[r] + p1[r]; }
            l_reg += sacc;
            u32x4 pw[4];
#pragma unroll
            for (int i = 0; i < 4; ++i) { pw[0][i] = cvtpk(p0[2 * i], p0[2 * i + 1]); pw[1][i] = cvtpk(p0[8 + 2 * i], p0[8 + 2 * i + 1]); pw[2][i] = cvtpk(p1[2 * i], p1[2 * i + 1]); pw[3][i] = cvtpk(p1[8 + 2 * i], p1[8 + 2 * i + 1]); }
            const LAS char* vp = lds + L_V + (it & 1) * VSLOT + ((lane >> 4) & 1) * 32 + (lane & 3) * 8 + (4 * hi + ((lane & 15) >> 2)) * 64;
#pragma unroll
            for (int d = 0; d < NDB; ++d) {
#pragma unroll
                for (int ks = 0; ks < 4; ++ks) { const s16x4 lo = vtr(vp + d * 4096 + ks * 1024), hh = vtr(vp + d * 4096 + ks * 1024 + 512);
                    const bf16x8 vf = (bf16x8){lo[0], lo[1], lo[2], lo[3], hh[0], hh[1], hh[2], hh[3]};
                    o[d] = __builtin_amdgcn_mfma_f32_32x32x16_bf16(__builtin_bit_cast(bf16x8, pw[ks]), vf, o[d], 0, 0, 0); } }
            if (DESC) {
                if (j == 0) wdone = true;
                else { const float bnd = qn * pkn[j - 1] + kbl[64 * j - 1] - mhat; wdone = __all(bnd < -52.f); }
                if (wdone && lane == 0) doneflags[wid] = 1u; }
        }
    }
#undef FA_DMA
    l_reg += __shfl_xor(l_reg, 32);
    if (hi == 0) wsf[32 + r32] = l_reg;
    LDS_FENCE();
#pragma unroll
    for (int r = 0; r < 16; ++r) { const float rl = 1.f / wsf[32 + crow(r, hi)]; bf16* orow = Oh + (size_t)(qw0 + crow(r, hi)) * opitch + r32;
#pragma unroll
        for (int d = 0; d < NDB; ++d) orow[32 * d] = (bf16)f2bf(o[d][r] * rl); }
    asm volatile("s_waitcnt vmcnt(0) lgkmcnt(0)\n\ts_barrier" ::: "memory");
}
}
__device__ __forceinline__ void fox_phase(Frame& F) { PHASE_BEGIN(F);
    LAS char* lds = (LAS char*)F.lds;
    const bf16* P = (const bf16*)(F.ws + WS_P); bf16* AO = (bf16*)(F.ws + WS_AO);
    const float* FC = (const float*)(F.ws + WS_FCUM);
    for (int idx = F.vcu; idx < 512; idx += F.G) {
        const int bh = idx >> 3, s = idx & 7, b = bh >> 4, h = bh & 15;
        for (int half = 0; half < 2; ++half) { const int qb = half ? 15 - s : s;
            LAS float* kbl = (LAS float*)(lds + fa::L_KB);
            for (int i = F.tid; i < (qb + 1) * 256; i += NTHR) kbl[i] = FC[((size_t)b * 16 + h) * SEQ + i];
            if (F.tid < 64) { float v = ((const float*)(F.ws + WS_KN))[((size_t)b * 16 + h) * 64 + F.tid];
#pragma unroll
                for (int of = 1; of < 64; of <<= 1) { const float u = __shfl_up(v, of); if (F.tid >= of) v = fmaxf(v, u); }
                ((LAS float*)(lds + fa::L_PKN))[F.tid] = v * 1.002f; }
            const size_t rb = (size_t)b * SEQ;
            fa::unit<64, 1>(lds, P + rb * NO + OC_Q + h * 64, P + rb * NO + OC_K + h * 64, P + rb * NO + OC_V + h * 64, NO, qb * 256, AO + rb * DM + h * 64, DM, F.tid); }
    }
}
__device__ __forceinline__ void diff_phase(Frame& F) { PHASE_BEGIN(F);
    LAS char* lds = (LAS char*)F.lds;
    const bf16* P = (const bf16*)(F.ws + WS_P); bf16* DO = (bf16*)(F.ws + WS_H);
    for (int idx = F.vcu; idx < 256; idx += F.G) {
        const int bhm = idx >> 3, s = idx & 7, b = bhm >> 3, h = (bhm >> 1) & 3, mp = bhm & 1;
        for (int half = 0; half < 2; ++half) { const int qb = half ? 15 - s : s;
            LAS float* tab = (LAS float*)(lds + fa::L_KB);
            if (F.tid < 129) tab[F.tid] = F.inp(I_RELB)[t5_bucket(F.tid) * 12 + 8 + h] * LOG2E;
            const size_t rb = (size_t)b * SEQ;
            fa::unit<128, 0>(lds, P + rb * NE + EC_QB + h * 128 + mp * 64, P + rb * NE + EC_KB + h * 128 + mp * 64, P + rb * NE + EC_VB + h * 128, NE, qb * 256, DO + rb * DM + (h * 2 + mp) * 128, DM, F.tid); }
    }
}
__device__ __forceinline__ void fgate_phase(Frame& F, int o) { PHASE_BEGIN(F);
    const int lane = F.lane, c16 = lane & 15, g = lane >> 4; const int gw = F.vcu * NWAVES + F.wave, NGW = F.G * NWAVES;
    const bf16* H = (const bf16*)(F.ws + WS_H); const bf16* WT = (const bf16*)(F.ws + WS_WFT) + (size_t)o * 16 * 1024; float* FG = (float*)(F.ws + WS_FG);
    for (int task = gw; task < T / 16; task += NGW) { const int t = 16 * task + c16;
        f32x4 acc = (f32x4){0.f, 0.f, 0.f, 0.f};
#pragma unroll 16
        for (int ks = 0; ks < 32; ++ks) { const bf16x8 b = *(const GAS bf16x8*)(H + (size_t)t * DM + 32 * ks + 8 * g);
            const bf16x8 a = *(const GAS bf16x8*)(WT + (size_t)c16 * 1024 + 32 * ks + 8 * g);
            acc = __builtin_amdgcn_mfma_f32_16x16x32_bf16(a, b, acc, 0, 0, 0); }
        *(GAS f32x4*)(FG + (size_t)t * 16 + 4 * g) = acc;
    }
}
__device__ __forceinline__ void fcum_phase(Frame& F, int o) { PHASE_BEGIN(F);
    const bf16* P = (const bf16*)(F.ws + WS_P); float* FC = (float*)(F.ws + WS_FCUM);
    LAS float* wtot = (LAS float*)F.lds;
    for (int it = F.vcu; it < NB * 16; it += F.G) { const int b = it >> 4, h = it & 15; const float bfg = F.inp(I_BF)[o * 16 + h];
        const float* src = (const float*)(F.ws + WS_FG) + ((size_t)b * SEQ + 8 * F.tid) * 16 + h;
        float ls[8]; float run = 0.f;
#pragma unroll
        for (int i = 0; i < 8; ++i) { const float x = src[(size_t)i * 16] + bfg; run += fminf(x, 0.f) - log1pf(__expf(-fabsf(x))); ls[i] = run; }
        float inc = run;
#pragma unroll
        for (int of = 1; of < 64; of <<= 1) { const float v = __shfl_up(inc, of); if (F.lane >= of) inc += v; }
        __syncthreads();
        if (F.lane == 63) wtot[F.wave] = inc;
        __syncthreads();
        float base = inc - run;
        for (int w = 0; w < NWAVES; ++w) if (w < F.wave) base += wtot[w];
        float* dst = FC + ((size_t)b * 16 + h) * SEQ + 8 * F.tid;
        f32x4 o0, o1; o0.x = -(base + ls[0]) * LOG2E; o0.y = -(base + ls[1]) * LOG2E; o0.z = -(base + ls[2]) * LOG2E; o0.w = -(base + ls[3]) * LOG2E;
        o1.x = -(base + ls[4]) * LOG2E; o1.y = -(base + ls[5]) * LOG2E; o1.z = -(base + ls[6]) * LOG2E; o1.w = -(base + ls[7]) * LOG2E;
        *(GAS f32x4*)dst = o0; *(GAS f32x4*)(dst + 4) = o1;
    }
    __syncthreads();
    { const int gw = F.vcu * NWAVES + F.wave, NGW = F.G * NWAVES; float* KN = (float*)(F.ws + WS_KN);
      for (int it = gw; it < NB * 16 * 64; it += NGW) { const int bh = it >> 6, tl = it & 63, b = bh >> 4, h = bh & 15;
          const bf16* kr = P + ((size_t)b * SEQ + 64 * tl + F.lane) * NO + OC_K + h * 64; float ss = 0.f;
#pragma unroll
          for (int c = 0; c < 8; ++c) { const v4u w = *(const GAS v4u*)(kr + 8 * c);
              ss += bflo(w.x) * bflo(w.x) + bfhi(w.x) * bfhi(w.x) + bflo(w.y) * bflo(w.y) + bfhi(w.y) * bfhi(w.y) + bflo(w.z) * bflo(w.z) + bfhi(w.z) * bfhi(w.z) + bflo(w.w) * bflo(w.w) + bfhi(w.w) * bfhi(w.w); }
#pragma unroll
          for (int of = 1; of < 64; of <<= 1) ss = fmaxf(ss, __shfl_xor(ss, of));
          if (F.lane == 0) KN[it] = sqrtf(ss); } }
}
typedef float f32x4v __attribute__((ext_vector_type(4)));
__device__ __forceinline__ void qlat_phase(Frame& F, int e) { PHASE_BEGIN(F);
    const int lane = F.lane, r32 = lane & 31, hi = lane >> 5; const int gw = F.vcu * NWAVES + F.wave, NGW = F.G * NWAVES;
    const bf16* P = (const bf16*)(F.ws + WS_P); const bf16* WT = (const bf16*)(F.ws + WS_WUKB) + (size_t)e * 8 * 256 * 64; bf16* QL = (bf16*)(F.ws + WS_QL);
    for (int task = gw; task < (T / 32) * 8; task += NGW) { const int rt = task >> 3, h = task & 7; const int t = 32 * rt + r32;
        bf16x8 bq[4];
#pragma unroll
        for (int ks = 0; ks < 4; ++ks) bq[ks] = *(const GAS bf16x8*)(P + (size_t)t * NE + EC_QA + h * 64 + 16 * ks + 8 * hi);
#pragma unroll 2
        for (int ct = 0; ct < 8; ++ct) { f32x16 acc = (f32x16){};
#pragma unroll
            for (int ks = 0; ks < 4; ++ks) { const bf16x8 a = *(const GAS bf16x8*)(WT + ((size_t)h * 256 + 32 * ct + r32) * 64 + 16 * ks + 8 * hi);
                acc = __builtin_amdgcn_mfma_f32_32x32x16_bf16(a, bq[ks], acc, 0, 0, 0); }
            bf16* o = QL + (size_t)t * 2048 + h * 256 + 32 * ct + 4 * hi;
#pragma unroll
            for (int g4 = 0; g4 < 4; ++g4) { u32x2 w; w.x = pk2(acc[4 * g4], acc[4 * g4 + 1]); w.y = pk2(acc[4 * g4 + 2], acc[4 * g4 + 3]); *(GAS u32x2*)(o + 8 * g4) = w; } }
    }
}
__device__ __forceinline__ void oa_phase(Frame& F, int e) { PHASE_BEGIN(F);
    const int lane = F.lane, r32 = lane & 31, hi = lane >> 5; const int gw = F.vcu * NWAVES + F.wave, NGW = F.G * NWAVES;
    const bf16* OL = (const bf16*)(F.ws + WS_AO); const bf16* WT = (const bf16*)(F.ws + WS_WUVB) + (size_t)e * 8 * 64 * 256; bf16* AO2 = (bf16*)(F.ws + WS_AO2);
    for (int task = gw; task < (T / 32) * 8; task += NGW) { const int rt = task >> 3, h = task & 7; const int t = 32 * rt + r32;
        f32x16 acc0 = (f32x16){}, acc1 = (f32x16){};
#pragma unroll 4
        for (int ks = 0; ks < 16; ++ks) { const bf16x8 b = *(const GAS bf16x8*)(OL + (size_t)t * 2048 + h * 256 + 16 * ks + 8 * hi);
            const bf16x8 a0 = *(const GAS bf16x8*)(WT + ((size_t)h * 64 + r32) * 256 + 16 * ks + 8 * hi), a1 = *(const GAS bf16x8*)(WT + ((size_t)h * 64 + 32 + r32) * 256 + 16 * ks + 8 * hi);
            acc0 = __builtin_amdgcn_mfma_f32_32x32x16_bf16(a0, b, acc0, 0, 0, 0); acc1 = __builtin_amdgcn_mfma_f32_32x32x16_bf16(a1, b, acc1, 0, 0, 0); }
        bf16* o = AO2 + (size_t)t * DM + h * 64 + 4 * hi;
#pragma unroll
        for (int g4 = 0; g4 < 4; ++g4) { u32x2 w; w.x = pk2(acc0[4 * g4], acc0[4 * g4 + 1]); w.y = pk2(acc0[4 * g4 + 2], acc0[4 * g4 + 3]); *(GAS u32x2*)(o + 8 * g4) = w;
            u32x2 w1; w1.x = pk2(acc1[4 * g4], acc1[4 * g4 + 1]); w1.y = pk2(acc1[4 * g4 + 2], acc1[4 * g4 + 3]); *(GAS u32x2*)(o + 32 + 8 * g4) = w1; }
    }
}
__device__ __forceinline__ void sparse_phase(Frame& F, int e) { PHASE_BEGIN(F);
    const int lane = F.lane, wid = F.wave, g = lane >> 4, hd = lane & 15, hi = lane >> 5;
    LAS char* lds = (LAS char*)F.lds;
    LAS float* tabA = (LAS float*)(lds + XTRA_OFF);
    LAS int* selw = (LAS int*)(lds + XTRA_OFF + 8192 + wid * 128);
    LAS char* buf = lds + wid * 16384;
    const unsigned buf0 = (unsigned)(uintptr_t)buf;
    for (int i = F.tid; i < 8 * 129; i += NTHR) { const int h = i / 129, d = i % 129; tabA[h * 132 + d] = F.inp(I_RELB)[t5_bucket(d) * 12 + h] * LOG2E; }
    __syncthreads();
    const bf16* QL = (const bf16*)(F.ws + WS_QL); const bf16* CK = (const bf16*)(F.ws + WS_CKV); bf16* AO = (bf16*)(F.ws + WS_AO); bf16* AO2 = (bf16*)(F.ws + WS_AO2);
    const unsigned short* SEL = (const unsigned short*)(F.ws + WS_SEL);
    const int gw = F.vcu * NWAVES + wid, NGW = F.G * NWAVES;
    {
        const float* lv = F.inp(I_LAM) + (size_t)e * 256;
        const float s1 = wave_sum(lv[lane] * lv[64 + lane]), s2 = wave_sum(lv[128 + lane] * lv[192 + lane]);
        const float lam_init = (e == 0) ? 0.2f : 0.47071303836235146f;
        const float lam = __expf(s1) - __expf(s2) + lam_init;
        const bf16* DO = (const bf16*)(F.ws + WS_H);
        const int h = lane >> 4, d0 = (lane & 15) * 8;
        float sg[8];
#pragma unroll
        for (int j = 0; j < 8; ++j) sg[j] = F.inp(I_SUBLN)[(size_t)e * 128 + d0 + j] * (1.f - lam_init);
        for (int t = gw; t < T; t += NGW) {
            const v4u a = *(const GAS v4u*)(DO + (size_t)t * DM + (h * 2) * 128 + d0), b = *(const GAS v4u*)(DO + (size_t)t * DM + (h * 2 + 1) * 128 + d0);
            float o[8];
            o[0] = bflo(a.x) - lam * bflo(b.x); o[1] = bfhi(a.x) - lam * bfhi(b.x); o[2] = bflo(a.y) - lam * bflo(b.y); o[3] = bfhi(a.y) - lam * bfhi(b.y);
            o[4] = bflo(a.z) - lam * bflo(b.z); o[5] = bfhi(a.z) - lam * bfhi(b.z); o[6] = bflo(a.w) - lam * bflo(b.w); o[7] = bfhi(a.w) - lam * bfhi(b.w);
            float ss = 0.f;
#pragma unroll
            for (int j = 0; j < 8; ++j) ss += o[j] * o[j];
            ss += __shfl_xor(ss, 1); ss += __shfl_xor(ss, 2); ss += __shfl_xor(ss, 4); ss += __shfl_xor(ss, 8);
            const float rstd = 1.f / sqrtf(ss * (1.f / 128.f) + RMS_EPS);
            v4u w; w.x = pk2(o[0] * rstd * sg[0], o[1] * rstd * sg[1]); w.y = pk2(o[2] * rstd * sg[2], o[3] * rstd * sg[3]); w.z = pk2(o[4] * rstd * sg[4], o[5] * rstd * sg[5]); w.w = pk2(o[6] * rstd * sg[6], o[7] * rstd * sg[7]);
            *(GAS v4u*)(AO2 + (size_t)t * DM + 512 + h * 128 + d0) = w;
        }
    }
    for (int t = gw; t < T; t += NGW) {
        const int b = t / SEQ, tl = t % SEQ;
        const int cnt = tl + 1 < 256 ? tl + 1 : 256, nch = (cnt + 31) >> 5;
        bf16x8 bq[8];
#pragma unroll
        for (int ks = 0; ks < 8; ++ks) { bq[ks] = (bf16x8){0, 0, 0, 0, 0, 0, 0, 0}; if (hd < 8) bq[ks] = *(const GAS bf16x8*)(QL + (size_t)t * 2048 + hd * 256 + 32 * ks + 8 * g); }
        f32x4v oacc[16];
#pragma unroll
        for (int ct = 0; ct < 16; ++ct) oacc[ct] = (f32x4v){0.f, 0.f, 0.f, 0.f};
        float m = 0.f, l = 0.f;
        const float* tb = nullptr; (void)tb;
        for (int ch = 0; ch < nch; ++ch) {
            const int svu = (int)SEL[(size_t)t * 256 + 32 * ch + (lane & 31)];
            const int sv = (svu == 0xffff) ? -1 : svu;
            LDS_FENCE();
            if (lane < 32) selw[lane] = sv;
#pragma unroll
            for (int i = 0; i < 16; ++i) { const int ra = __builtin_amdgcn_readlane(sv, 2 * i), rb = __builtin_amdgcn_readlane(sv, 2 * i + 1);
                int r = hi ? rb : ra; r = r < 0 ? 0 : r; const int row = 2 * i + hi;
                fa::glds16(CK + ((size_t)b * SEQ + r) * 256 + 8 * ((lane & 31) ^ (row & 15)), (unsigned)__builtin_amdgcn_readfirstlane(buf0 + i * 1024)); }
            asm volatile("s_waitcnt vmcnt(0) lgkmcnt(0)" ::: "memory");
            f32x4v s[2];
#pragma unroll
            for (int rt = 0; rt < 2; ++rt) { s[rt] = (f32x4v){0.f, 0.f, 0.f, 0.f}; const int row = 16 * rt + hd; const LAS char* rp = buf + row * 512;
#pragma unroll
                for (int ks = 0; ks < 8; ++ks) { const bf16x8 a = *(const LAS bf16x8*)(rp + (((4 * ks + g) ^ (row & 15)) << 4));
                    s[rt] = __builtin_amdgcn_mfma_f32_16x16x32_bf16(a, bq[ks], s[rt], 0, 0, 0); } }
            float rm = -INFINITY;
#pragma unroll
            for (int rt = 0; rt < 2; ++rt) { const i32x4 kp = *(const LAS i32x4*)(selw + 16 * rt + 4 * g); const int kq[4] = {kp.x, kp.y, kp.z, kp.w};
#pragma unroll
                for (int r = 0; r < 4; ++r) { int d = tl - kq[r]; d = d > 128 ? 128 : (d < 0 ? 0 : d); float v = s[rt][r] + tabA[(hd & 7) * 132 + d]; v = kq[r] < 0 ? -INFINITY : v; s[rt][r] = v; rm = fmaxf(rm, v); } }
            rm = fmaxf(rm, __shfl_xor(rm, 16)); rm = fmaxf(rm, __shfl_xor(rm, 32));
            if (ch == 0) m = rm;
            else if (__any(rm - m > 8.f)) { const float mn = fmaxf(m, rm), f = __builtin_amdgcn_exp2f(m - mn); m = mn; l *= f;
#pragma unroll
                for (int ct = 0; ct < 16; ++ct) oacc[ct] = oacc[ct] * f; }
            float p[2][4]; float ps = 0.f;
#pragma unroll
            for (int rt = 0; rt < 2; ++rt)
#pragma unroll
                for (int r = 0; r < 4; ++r) { p[rt][r] = __builtin_amdgcn_exp2f(s[rt][r] - m); ps += p[rt][r]; }
            l += ps;
            u32x4 pbw; pbw.x = fa::cvtpk(p[0][0], p[0][1]); pbw.y = fa::cvtpk(p[0][2], p[0][3]); pbw.z = fa::cvtpk(p[1][0], p[1][1]); pbw.w = fa::cvtpk(p[1][2], p[1][3]);
            const bf16x8 pb = __builtin_bit_cast(bf16x8, pbw);
            const int q4 = hd >> 2, p4 = hd & 3; const int r0 = 4 * g + q4;
            const LAS char* v0 = buf + r0 * 512 + 8 * (p4 & 1); const LAS char* v1 = v0 + 16 * 512;
#pragma unroll
            for (int ct = 0; ct < 16; ++ct) { const int co = ((2 * ct + (p4 >> 1)) ^ (r0 & 15)) << 4;
                const s16x4 lo = fa::vtr(v0 + co), hh = fa::vtr(v1 + co);
                const bf16x8 a = (bf16x8){lo[0], lo[1], lo[2], lo[3], hh[0], hh[1], hh[2], hh[3]};
                oacc[ct] = __builtin_amdgcn_mfma_f32_16x16x32_bf16(a, pb, oacc[ct], 0, 0, 0); }
        }
        l += __shfl_xor(l, 16); l += __shfl_xor(l, 32);
#ifdef DBG_ZERO_SPARSE
        const float rl = 0.f;
#else
        const float rl = 1.f / l;
#endif
        if (hd < 8) { bf16* orow = AO + (size_t)t * 2048 + hd * 256 + 4 * g;
#pragma unroll
            for (int ct = 0; ct < 16; ++ct) { u32x2 w; w.x = pk2(oacc[ct][0] * rl, oacc[ct][1] * rl); w.y = pk2(oacc[ct][2] * rl, oacc[ct][3] * rl); *(GAS u32x2*)(orow + 16 * ct) = w; } }
    }
    LDS_FENCE();
    __syncthreads();
}
template <int N> __device__ __forceinline__ void bitonic_desc(unsigned* v) {
#pragma unroll
    for (int k = 2; k <= N; k <<= 1)
#pragma unroll
        for (int j = k >> 1; j > 0; j >>= 1)
#pragma unroll
            for (int i = 0; i < N; ++i) { const int l = i ^ j; if (l > i) { const bool up = (i & k) != 0; const unsigned a = v[i], b = v[l]; const unsigned mx = a > b ? a : b, mn = a > b ? b : a; v[i] = up ? mn : mx; v[l] = up ? mx : mn; } }
}
__device__ __forceinline__ void merge16_desc(unsigned* a, const unsigned* b) {
#pragma unroll
    for (int i = 0; i < 16; ++i) { const unsigned x = a[i], y = b[15 - i]; a[i] = x > y ? x : y; }
#pragma unroll
    for (int j = 8; j > 0; j >>= 1)
#pragma unroll
        for (int i = 0; i < 16; ++i) { const int l = i ^ j; if (l > i) { const unsigned x = a[i], y = a[l]; a[i] = x > y ? x : y; a[l] = x > y ? y : x; } }
}
__device__ __forceinline__ void top16_of_64(unsigned* v) {
    bitonic_desc<16>(v); bitonic_desc<16>(v + 16); bitonic_desc<16>(v + 32); bitonic_desc<16>(v + 48);
    merge16_desc(v, v + 16); merge16_desc(v + 32, v + 48); merge16_desc(v, v + 32);
}
__device__ __forceinline__ void peer_route_phase(Frame& F, int layer) { PHASE_BEGIN(F);
    const int lane = F.lane, r32 = lane & 31, hi = lane >> 5;
    const bf16* PQ = (const bf16*)(F.ws + WS_P); const bf16* SK = (const bf16*)(F.ws + WS_WSK) + (size_t)layer * 2 * 128 * 128;
    int* PE = (int*)(F.ws + WS_PE); float* PG = (float*)(F.ws + WS_PG);
    const int gw = F.vcu * NWAVES + F.wave, NGW = F.G * NWAVES;
    LAS char* lds = (LAS char*)F.lds;
    for (int i = F.tid; i < 256 * 16; i += NTHR) { const int row = i >> 4, ch = i & 15; *(LAS v4u*)(lds + row * 272 + ch * 16) = *(const GAS v4u*)(SK + (size_t)row * 128 + ch * 8); }
    __syncthreads();
    for (int task = gw; task < T / 4; task += NGW) {
        const int t = 4 * task + (r32 >> 3), h = r32 & 7;
        unsigned top0[16], top1[16];
#pragma unroll
        for (int i = 0; i < 16; ++i) { top0[i] = 0u; top1[i] = 0u; }
#pragma unroll 1
        for (int p = 0; p < 2; ++p) {
            bf16x8 bq[8];
#pragma unroll
            for (int d0 = 0; d0 < 8; ++d0) bq[d0] = *(const GAS bf16x8*)(PQ + (size_t)t * 2048 + h * 256 + p * 128 + 16 * d0 + 8 * hi);
            unsigned v[64];
            const LAS char* ab = lds + (p * 128 + r32) * 272 + hi * 16;
#pragma unroll
            for (int kt = 0; kt < 4; ++kt) { f32x16 acc = (f32x16){};
#pragma unroll
                for (int d0 = 0; d0 < 8; ++d0) { const bf16x8 a = *(const LAS bf16x8*)(ab + kt * 32 * 272 + d0 * 32);
                    acc = __builtin_amdgcn_mfma_f32_32x32x16_bf16(a, bq[d0], acc, 0, 0, 0); }
#pragma unroll
                for (int r = 0; r < 16; ++r) { const int key = 32 * kt + (r & 3) + 8 * (r >> 2) + 4 * hi; v[16 * kt + r] = (f2sort(acc[r]) & ~127u) | (unsigned)(127 - key); } }
            top16_of_64(v);
            unsigned o[16];
#pragma unroll
            for (int i = 0; i < 16; ++i) o[i] = (unsigned)__shfl_xor((int)v[i], 32);
            merge16_desc(v, o);
#pragma unroll
            for (int i = 0; i < 16; ++i) { top0[i] = (p == 0) ? v[i] : top0[i]; top1[i] = (p == 1) ? v[i] : top1[i]; }
        }
        float s0[16], s1[16];
#pragma unroll
        for (int i = 0; i < 16; ++i) { s0[i] = sort2f(top0[i] & ~127u); s1[i] = sort2f(top1[i] & ~127u); }
        unsigned c[64]; int nc = 0;
#pragma unroll
        for (int a = 0; a < 16; ++a)
#pragma unroll
            for (int b = 0; b < 16; ++b) if ((a + 1) * (b + 1) <= 16) { c[nc] = (f2sort(s0[a] + s1[b]) & ~255u) | (unsigned)(255 - (a * 16 + b)); ++nc; }
#pragma unroll
        for (int i = nc; i < 64; ++i) c[i] = 0u;
        top16_of_64(c);
        float gsum = 0.f; float gt[16]; int ex[16];
        const float smax = sort2f(c[0] & ~255u);
#pragma unroll
        for (int j = 0; j < 16; ++j) { const float sj = sort2f(c[j] & ~255u); gt[j] = __expf(sj - smax); gsum += gt[j];
            const int id = 255 - (int)(c[j] & 255u), a = id >> 4, b = id & 15; unsigned ka = top0[0], kb = top1[0];
#pragma unroll
            for (int q = 1; q < 16; ++q) { ka = (a == q) ? top0[q] : ka; kb = (b == q) ? top1[q] : kb; }
            ex[j] = (127 - (int)(ka & 127u)) * 128 + (127 - (int)(kb & 127u)); }
        const float rg = 1.f / gsum;
        if (hi == 0) { int* d = PE + (size_t)t * 128 + h * 16;
#pragma unroll
            for (int q = 0; q < 4; ++q) *(GAS i32x4*)(d + 4 * q) = (i32x4){ex[4 * q], ex[4 * q + 1], ex[4 * q + 2], ex[4 * q + 3]}; }
        else { float* d = PG + (size_t)t * 128 + h * 16;
#pragma unroll
            for (int q = 0; q < 4; ++q) *(GAS f32x4*)(d + 4 * q) = (f32x4){gt[4 * q] * rg, gt[4 * q + 1] * rg, gt[4 * q + 2] * rg, gt[4 * q + 3] * rg}; }
    }
    __syncthreads();
}
__device__ __forceinline__ void dec16(const v4u w, float (&f)[16]) {
#pragma unroll
    for (int q = 0; q < 4; ++q) { const f32x2v a = __builtin_amdgcn_cvt_pk_f32_fp8((int)w[q], false), b = __builtin_amdgcn_cvt_pk_f32_fp8((int)w[q], true); f[4 * q] = a.x; f[4 * q + 1] = a.y; f[4 * q + 2] = b.x; f[4 * q + 3] = b.y; }
}
template <int NB> __device__ __forceinline__ void peer_u_batch(const LAS unsigned* list, int base, int total, const v4u xrow, float sxt, const unsigned char* U8, const float* SU, const float* PGt, float* ACTt, int lane) {
    v4u w[NB];
    const int rem = total - base;
    const unsigned mine = list[base + (lane & (NB - 1))];
    const bool act = lane < NB && lane < rem; const int mye = (int)(mine & 0xffffu), myj = (int)(mine >> 16);
    float su = 0.f, pg = 0.f; if (act) { su = SU[mye]; pg = PGt[myj]; }
#pragma unroll
    for (int q = 0; q < NB; ++q) { w[q] = (v4u){0u, 0u, 0u, 0u};
        if (q < rem) { const unsigned ent = (unsigned)__builtin_amdgcn_readlane((int)mine, q); w[q] = *(const GAS v4u*)(U8 + (size_t)(ent & 0xffffu) * 1024 + 16 * lane); } }
    const long xlo = (long)(((unsigned long long)xrow.y << 32) | xrow.x), xhi = (long)(((unsigned long long)xrow.w << 32) | xrow.z);
    const bool ondiag = ((lane & 15) >> 2) == (lane >> 4); const int dsel = lane & 3;
    float d[NB];
#pragma unroll
    for (int q = 0; q < NB; ++q) { d[q] = 0.f; if (q < rem) {
        f32x4 acc = (f32x4){0.f, 0.f, 0.f, 0.f};
        acc = __builtin_amdgcn_mfma_f32_16x16x32_fp8_fp8((long)(((unsigned long long)w[q].y << 32) | w[q].x), xlo, acc, 0, 0, 0);
        acc = __builtin_amdgcn_mfma_f32_16x16x32_fp8_fp8((long)(((unsigned long long)w[q].w << 32) | w[q].z), xhi, acc, 0, 0, 0);
        const float dv = dsel == 0 ? acc.x : (dsel == 1 ? acc.y : (dsel == 2 ? acc.z : acc.w));
        d[q] = ondiag ? dv : 0.f; } }
#pragma unroll
    for (int lvl = 0, n = NB; n > 1; ++lvl, n >>= 1) { const int bit = 1 << lvl;
#pragma unroll
        for (int q = 0; q < n / 2; ++q) { const float keep = (lane & bit) ? d[2 * q + 1] : d[2 * q], send = (lane & bit) ? d[2 * q] : d[2 * q + 1]; d[q] = keep + __shfl_xor(send, bit); } }
    float e1 = d[0];
#pragma unroll
    for (int o = NB; o < 64; o <<= 1) e1 += __shfl_xor(e1, o);
    if (act) ACTt[myj] = gelu_tanh(e1 * su * sxt) * pg;
}
__device__ __forceinline__ void peer_u_phase(Frame& F, int layer) { PHASE_BEGIN(F);
    const int lane = F.lane; const int per = F.G >> 3; const int k = F.vcu / per, wp = (F.vcu % per) * NWAVES + F.wave, nwp = per * NWAVES;
    const unsigned char* H8 = F.ws + WS_H8; const float* SX = (const float*)(F.ws + WS_SX); const unsigned char* U8 = F.ws + WS_U8; const float* SU = (const float*)(F.ws + WS_SU);
    const int* PE = (const int*)(F.ws + WS_PE); const float* PG = (const float*)(F.ws + WS_PG); float* ACT = (float*)(F.ws + WS_ACT);
    LAS unsigned* list = (LAS unsigned*)(F.lds + F.wave * 1024);
    v4u xn = *(const GAS v4u*)(H8 + (size_t)wp * DM + 16 * lane); float sxn = SX[wp];
    int ea = PE[(size_t)wp * 128 + lane], eb = PE[(size_t)wp * 128 + 64 + lane];
    for (int t = wp; t < T; t += nwp) {
        const v4u xrow = xn; const float sxt = sxn;
        const bool ia = (ea >> 11) == k, ib = (eb >> 11) == k;
        const unsigned long long ma = __ballot(ia), mb = __ballot(ib);
        const int na = __builtin_popcountll(ma), total = na + __builtin_popcountll(mb);
        LDS_FENCE();
        if (ia) list[mbcnt64(ma)] = (unsigned)ea | ((unsigned)lane << 16);
        if (ib) list[na + mbcnt64(mb)] = (unsigned)eb | ((unsigned)(64 + lane) << 16);
        const int tn = (t + nwp < T) ? t + nwp : t;
        xn = *(const GAS v4u*)(H8 + (size_t)tn * DM + 16 * lane); sxn = SX[tn];
        ea = PE[(size_t)tn * 128 + lane]; eb = PE[(size_t)tn * 128 + 64 + lane];
        LDS_FENCE();
        for (int base = 0; base < total; ) {
            if (total - base > 8) { peer_u_batch<16>(list, base, total, xrow, sxt, U8, SU, PG + (size_t)t * 128, ACT + (size_t)t * 128, lane); base += 16; }
            else { peer_u_batch<8>(list, base, total, xrow, sxt, U8, SU, PG + (size_t)t * 128, ACT + (size_t)t * 128, lane); base += 8; }
        }
    }
    LDS_FENCE();
}
__device__ __forceinline__ void peer_v_phase(Frame& F, int layer) { PHASE_BEGIN(F);
    const int lane = F.lane; const int per = F.G >> 3; const int k = F.vcu / per, wp = (F.vcu % per) * NWAVES + F.wave, nwp = per * NWAVES;
    const unsigned char* V8 = F.ws + WS_V8 + (size_t)k * (16384 * 128) + (lane & 7) * 16; const float* SV = (const float*)(F.ws + WS_SV);
    const int* PE = (const int*)(F.ws + WS_PE); const float* ACT = (const float*)(F.ws + WS_ACT);
    float* X = (float*)(F.ws + WS_X); const float* mod = (const float*)(F.ws + WS_MOD);
    const int c16 = ((lane >> 3) & 1) * 8 + ((lane >> 4) & 1) * 4 + ((lane >> 5) & 1) * 2;
    const int col = 128 * k + 16 * (lane & 7) + c16;
    int ea = PE[(size_t)wp * 128 + lane], eb = PE[(size_t)wp * 128 + 64 + lane];
    float ca = ACT[(size_t)wp * 128 + lane], cb = ACT[(size_t)wp * 128 + 64 + lane];
    for (int t = wp; t < T; t += nwp) {
        int e[16]; float cf[16]; v4u w[16];
#pragma unroll
        for (int s = 0; s < 16; ++s) { const int sl = (8 * s + (lane >> 3)) & 63;
            e[s] = __shfl(s < 8 ? ea : eb, sl); cf[s] = __shfl(s < 8 ? ca : cb, sl);
            w[s] = *(const GAS v4u*)(V8 + (size_t)e[s] * 128); }
#pragma unroll
        for (int s = 0; s < 16; ++s) cf[s] *= SV[e[s]];
        __builtin_amdgcn_sched_barrier(0);
        const int tn = (t + nwp < T) ? t + nwp : t;
        ea = PE[(size_t)tn * 128 + lane]; eb = PE[(size_t)tn * 128 + 64 + lane]; ca = ACT[(size_t)tn * 128 + lane]; cb = ACT[(size_t)tn * 128 + 64 + lane];
        int ln2 = lane; asm volatile("" : "+v"(ln2));
        const int col2 = 128 * k + 16 * (ln2 & 7) + ((ln2 >> 3) & 1) * 8 + ((ln2 >> 4) & 1) * 4 + ((ln2 >> 5) & 1) * 2;
        const float* g2 = mod + ((size_t)layer * 4 + t / SEQ) * 6144 + 5 * DM + col2;
        GAS f32x2v* xp = (GAS f32x2v*)(X + (size_t)t * DM + col2); f32x2v xv = *xp; const float g2a = g2[0], g2b = g2[1];
        float acc[16];
#pragma unroll
        for (int i = 0; i < 16; ++i) acc[i] = 0.f;
#pragma unroll
        for (int s = 0; s < 16; ++s) { float f[16]; dec16(w[s], f);
#pragma unroll
            for (int i = 0; i < 16; ++i) acc[i] += cf[s] * f[i];
            if ((s & 1) == 1) __builtin_amdgcn_sched_barrier(0); }
        float r8[8], r4[4], r2[2];
#pragma unroll
        for (int i = 0; i < 8; ++i) { const float keep = (lane & 8) ? acc[8 + i] : acc[i], send = (lane & 8) ? acc[i] : acc[8 + i]; r8[i] = keep + __shfl_xor(send, 8); }
#pragma unroll
        for (int i = 0; i < 4; ++i) { const float keep = (lane & 16) ? r8[4 + i] : r8[i], send = (lane & 16) ? r8[i] : r8[4 + i]; r4[i] = keep + __shfl_xor(send, 16); }
#pragma unroll
        for (int i = 0; i < 2; ++i) { const float keep = (lane & 32) ? r4[2 + i] : r4[i], send = (lane & 32) ? r4[i] : r4[2 + i]; r2[i] = keep + __shfl_xor(send, 32); }
        xv.x += g2a * r2[0]; xv.y += g2b * r2[1]; *xp = xv;
    }
}
namespace pg8 {
struct EpiResid {
    static constexpr bool PERM = false, AFTER_DRAIN = false;
    const float* xin; float* xout; const float* gate; float mul;
    __device__ __forceinline__ void operator()(const f32x4 (&acc)[2][2][4][2], const Unit& u, int wr, int wc, int fr, int fq) const {
        const int col0 = u.pn * BM + wc * 32 + 4 * fq; const float* gb = gate + (size_t)((u.pm * BM) / 4096) * 6144 + col0;
        f32x4 gv[2][2];
#pragma unroll
        for (int bj = 0; bj < 2; ++bj)
#pragma unroll
            for (int n = 0; n < 2; ++n) gv[bj][n] = *(const f32x4*)(gb + bj * HALF + n * 16);
#pragma unroll
        for (int ai = 0; ai < 2; ++ai)
#pragma unroll
            for (int m = 0; m < 4; ++m) { const size_t off = (size_t)(u.pm * BM + ai * HALF + wr * 64 + m * 16 + fr) * 1024 + col0;
#pragma unroll
                for (int bj = 0; bj < 2; ++bj)
#pragma unroll
                    for (int n = 0; n < 2; ++n) { const f32x4 xv = *(const f32x4*)(xin + off + bj * HALF + n * 16); *(f32x4*)(xout + off + bj * HALF + n * 16) = xv + gv[bj][n] * acc[ai][bj][m][n] * mul; } }
    }
};
}

struct Args { const float* in[22]; float* out; unsigned char* ws; int stop_after; int pad; };
__global__ void __launch_bounds__(NTHR, 2) fwd_megakernel(Args args) {
    extern __shared__ __attribute__((aligned(16))) unsigned char lds[];
    Frame F;
    F.lds = (LAS unsigned char*)lds;
    F.MISC = (volatile LAS unsigned*)(F.lds + MISC_OFF);
    F.G = gridDim.x; { const int bx = blockIdx.x; F.vcu0 = (F.G % 8 == 0) ? (bx % 8) * (F.G / 8) + bx / 8 : bx; }
    F.ka0 = (const KAS char*)__builtin_amdgcn_kernarg_segment_ptr();
    F.wave0 = __builtin_amdgcn_readfirstlane((int)threadIdx.x >> 6);
    PHASE_BEGIN(F);
    for (int u = F.tid; u < (LDS_BYTES - MISC_OFF) / 4; u += NTHR) ((LAS unsigned*)(F.lds + MISC_OFF))[u] = 0u;
    __syncthreads();
    (void)xcd_barrier_post((unsigned*)(F.ctl + CW_BAR), F.MISC + 8);
    if (F.tid == 0) { const unsigned x_ = xb_xcc_id(); F.MISC[20] = x_; F.MISC[21] = atomicAdd((unsigned*)(F.ws + WS_CTL) + CW_RANK + 64 * x_, 1u); }
#define GRID_BAR() do { XcdBarrier b_; unsigned* p_ = (unsigned*)(F.ws + WS_CTL) + CW_BAR; asm volatile("" : "+s"(p_)); b_.bar = p_; b_.x = xb_xcc_id(); b_.st = F.MISC + 8; xcd_barrier(b_); } while (0)
#ifdef DBG_TIME_MASK
    unsigned long long tacc_ = 0, tst_ = 0;
#define TS_BEGIN(id) do { if ((DBG_TIME_MASK >> (id)) & 1) tst_ = __builtin_amdgcn_s_memrealtime(); } while (0)
#define TS_END(id) do { if ((DBG_TIME_MASK >> (id)) & 1) tacc_ += __builtin_amdgcn_s_memrealtime() - tst_; } while (0)
#else
#define TS_BEGIN(id) do {} while (0)
#define TS_END(id) do {} while (0)
#endif

    TS_BEGIN(1);
    p0_transposes(F);
    p0_fused_weights(F);
    p0_mod(F);
    conv_peer_tables(F, 0);
    GRID_BAR();
    if (F.tid == 0) { unsigned off_ = 0; const unsigned x_ = F.MISC[20];
        for (unsigned j = 0; j < 16; ++j) { const unsigned c_ = __hip_atomic_load((unsigned*)(F.ws + WS_CTL) + CW_RANK + 64 * j, __ATOMIC_RELAXED, __HIP_MEMORY_SCOPE_AGENT); if (j < x_) off_ += c_; }
        F.MISC[22] = off_ + F.MISC[21]; }
    __syncthreads();
    F.vcu0 = __builtin_amdgcn_readfirstlane((int)F.MISC[22]);
    norm_mod_phase(F, 0, 0, 0);
    GRID_BAR();
    TS_END(1);

    for (int layer = 0; layer < DEPTH; ++layer) {
        const int half = layer >> 1; const bool even = (layer & 1) == 0;
        PHASE_BEGIN(F);
        bf16* Hb = (bf16*)(F.ws + WS_H); bf16* Pb = (bf16*)(F.ws + WS_P);
        TS_BEGIN(2);
        if (even) { pg8::Gemm g{Hb, (const bf16*)(F.ws + WS_WEIN) + (size_t)half * NE * DM, T, NE, DM, DM, 0, 0}; pg8::StaticOrder S; S.init(T, NE, F.G, (int)blockIdx.x);
            pg8::EpiBf16<0> E{Pb, NE, nullptr, 0, 0, 1.f}; pg8::gemm_phase<pg8::EpiBf16<0>, pg8::StaticOrder, true, true>(F.lds, g, S, E, F.tid); }
        else { pg8::Gemm g{Hb, (const bf16*)(F.ws + WS_WOIN) + (size_t)half * NO * DM, T, NO, DM, DM, 0, 0}; pg8::StaticOrder S; S.init(T, NO, F.G, (int)blockIdx.x);
            pg8::EpiBf16<0> E{Pb, NO, nullptr, 0, 0, 1.f}; pg8::gemm_phase<pg8::EpiBf16<0>, pg8::StaticOrder, true, true>(F.lds, g, S, E, F.tid); }
        if (!even) fgate_phase(F, half);
        GRID_BAR();
        TS_END(2);
        if (even) {
            TS_BEGIN(3);
            TS_BEGIN(14);
            qlat_phase(F, half);
            ckv_norm_phase(F, half);
            topk_phase(F);
            TS_END(14);
            TS_BEGIN(15);
            diff_phase(F);
            TS_END(15);
            TS_BEGIN(16);
#ifdef DBG_REP_DIFF
            diff_phase(F);
#endif
#ifdef DBG_REP_TOPK
            topk_phase(F);
#endif
            GRID_BAR();
            TS_END(16);
            TS_END(3);
            TS_BEGIN(4);
            sparse_phase(F, half);
            GRID_BAR();
            oa_phase(F, half);
#ifdef DBG_REP_SPARSE
            sparse_phase(F, half);
#endif
        } else {
            TS_BEGIN(5);
            fcum_phase(F, half);
            GRID_BAR();
            TS_END(5);
            TS_BEGIN(6);
            fox_phase(F);
#ifdef DBG_REP_FOX
            fox_phase(F);
#endif
        }
        GRID_BAR();
        if (even) TS_END(4); else TS_END(6);
        TS_BEGIN(7);
        { PHASE_BEGIN(F); bf16* AOb = (bf16*)(F.ws + WS_AO); float* Xb = (float*)(F.ws + WS_X); const float* mod = (const float*)(F.ws + WS_MOD);
          const float* xin = (layer == 0) ? F.inp(I_X) : Xb; const float* g1 = mod + (size_t)layer * 4 * 6144 + 2 * DM;
          pg8::EpiResid E{xin, Xb, g1, 1.f};
#ifdef DBG_SKIP_EVEN_MIX
          if (even) E.mul = 0.f;
#endif
#ifdef DBG_SKIP_ODD_MIX
          if (!even) E.mul = 0.f;
#endif
          if (even) { pg8::Gemm g{(const bf16*)(F.ws + WS_AO2), (const bf16*)(F.ws + WS_WEOUT) + (size_t)half * DM * DM, T, DM, DM, DM, 0, 0}; pg8::StaticOrder S; S.init(T, DM, F.G, (int)blockIdx.x);
              pg8::gemm_phase<pg8::EpiResid, pg8::StaticOrder, false, true>(F.lds, g, S, E, F.tid); }
          else { pg8::Gemm g{AOb, (const bf16*)(F.ws + WS_WOOUT) + (size_t)half * DM * DM, T, DM, DM, DM, 0, 0}; pg8::StaticOrder S; S.init(T, DM, F.G, (int)blockIdx.x);
              pg8::gemm_phase<pg8::EpiResid, pg8::StaticOrder, false, true>(F.lds, g, S, E, F.tid); } }
        GRID_BAR();
        TS_END(7);
        TS_BEGIN(8);
        norm_mod_phase(F, 1, layer, 1);
        if (layer > 0) conv_peer_tables(F, layer);
        GRID_BAR();
        TS_END(8);
        TS_BEGIN(9);
        { PHASE_BEGIN(F); bf16* Hb = (bf16*)(F.ws + WS_H); bf16* Pb = (bf16*)(F.ws + WS_P);
          pg8::Gemm g{Hb, (const bf16*)(F.ws + WS_WPQ) + (size_t)layer * 2048 * DM, T, 2048, DM, DM, 0, 0}; pg8::StaticOrder S; S.init(T, 2048, F.G, (int)blockIdx.x);
          pg8::EpiBf16<0> E{Pb, 2048, nullptr, 0, 0, 1.f}; pg8::gemm_phase<pg8::EpiBf16<0>, pg8::StaticOrder, true, true>(F.lds, g, S, E, F.tid); }
        GRID_BAR();
        TS_END(9);
        TS_BEGIN(10);
        peer_route_phase(F, layer);
#ifdef DBG_REP_ROUTE
        peer_route_phase(F, layer);
#endif
        GRID_BAR();
        TS_END(10);
        TS_BEGIN(11);
        peer_u_phase(F, layer);
        GRID_BAR();
        TS_END(11);
        TS_BEGIN(12);
        peer_v_phase(F, layer);
        GRID_BAR();
        TS_END(12);
        TS_BEGIN(13);
        if (layer + 1 < DEPTH) { norm_mod_phase(F, 1, layer + 1, 0); GRID_BAR(); } else final_norm_phase(F);
        TS_END(13);
    }
#ifdef DBG_TIME_MASK
#ifndef DBG_VCU
#define DBG_VCU 0
#endif
#ifdef DBG_MAXMODE
    PHASE_BEGIN(F); if (F.tid == 0) atomicMax((unsigned*)(F.ws + WS_CTL) + 8192, (unsigned)tacc_); GRID_BAR(); { const unsigned mx_ = __hip_atomic_load((unsigned*)(F.ws + WS_CTL) + 8192, __ATOMIC_RELAXED, __HIP_MEMORY_SCOPE_AGENT);
#ifdef DBG_ARGMAX
      if (F.tid == 0 && (unsigned)tacc_ == mx_) __hip_atomic_store((unsigned*)(F.ws + WS_CTL) + 8256, (unsigned)F.vcu0, __ATOMIC_RELAXED, __HIP_MEMORY_SCOPE_AGENT);
      GRID_BAR(); tacc_ = 2500ull * __hip_atomic_load((unsigned*)(F.ws + WS_CTL) + 8256, __ATOMIC_RELAXED, __HIP_MEMORY_SCOPE_AGENT);
#else
      tacc_ = mx_;
#endif
    }
#endif
    if (F.vcu0 == DBG_VCU) { const unsigned long long t0_ = __builtin_amdgcn_s_memrealtime(); while (__builtin_amdgcn_s_memrealtime() - t0_ < 4ull * tacc_) __builtin_amdgcn_s_sleep(8); }
#endif
#undef GRID_BAR
}

extern "C" void kernel_launch(void* const* d_in, const int* in_sizes, int n_in, void* d_out, int out_size, void* d_ws, size_t ws_size, hipStream_t stream) {
    static int grid = 0;
    if (grid == 0) {
        if (n_in != 22 || in_sizes[0] != T * DM || out_size != T * DM || ws_size < WS_END) { fprintf(stderr, "kernel_launch: unexpected problem (n_in %d, in0 %d, out %d, ws %zu)\n", n_in, n_in > 0 ? in_sizes[0] : -1, out_size, ws_size); grid = -1; return; }
        int dev = 0, cus = 0, per_cu = 0;
        if (hipGetDevice(&dev) != hipSuccess || hipDeviceGetAttribute(&cus, hipDeviceAttributeMultiprocessorCount, dev) != hipSuccess) { grid = -1; return; }
        if (hipFuncSetAttribute((const void*)fwd_megakernel, hipFuncAttributeMaxDynamicSharedMemorySize, LDS_BYTES) != hipSuccess) { fprintf(stderr, "kernel_launch: hipFuncSetAttribute failed\n"); grid = -1; return; }
        if (hipOccupancyMaxActiveBlocksPerMultiprocessor(&per_cu, (const void*)fwd_megakernel, NTHR, LDS_BYTES) != hipSuccess || per_cu < 1) fprintf(stderr, "kernel_launch: occupancy query says %d\n", per_cu);
        (void)hipGetLastError();
        grid = cus;
    }
    if (grid < 0) return;
    if (hipMemsetAsync((char*)d_ws + WS_CTL, 0, CTL_ZERO_BYTES, stream) != hipSuccess) return;
    Args a{};
    for (int i = 0; i < 22; ++i) a.in[i] = (const float*)d_in[i];
    a.out = (float*)d_out; a.ws = (unsigned char*)d_ws; a.stop_after = 0; a.pad = 0;
    hipLaunchKernelGGL(fwd_megakernel, dim3(grid), dim3(NTHR), LDS_BYTES, stream, a);
}
```
